# Optimizing an MI355X kernel written in HIP

```python
import math
import jax, jax.numpy as jnp
from jax import lax
import numpy as np

D_MODEL = 2048
BATCH = 2
SEQ = 4096
DEPTH = 4

CHUNK = 64
Q_BLOCK = 128
HEAD_DIM = 128
ROPE_THETA = 10000.0
LN_EPS = 1e-5
RMS_EPS = 1e-6
NEG_INF = -1e30

H_FOX = 8
H_CHK = 8
LEFT_CHUNKS = 8
BAND = (LEFT_CHUNKS + 1) * CHUNK
REL_MAX = 128

H_MLA = 8
Q_LORA = 512
KV_LORA = 512
MLA_NOPE = 128
MLA_ROPE = 64
MLA_V = 128
H_DIFF = 4
DIFF_DIM = 128

N_KEYS = 128
N_EXPERTS = N_KEYS * N_KEYS
PEER_HEADS = 8
PEER_TOPK = 16
PEER_DK = 256
PEER_TOKEN_BLOCK = 128

N_EVEN = (DEPTH + 1) // 2
N_ODD = DEPTH // 2
ALPHA = (2 * DEPTH) ** 0.25
BETA = (8 * DEPTH) ** -0.25

EVEN_SPLITS = (H_FOX * HEAD_DIM, H_FOX * HEAD_DIM, H_FOX * HEAD_DIM, H_FOX,
               H_CHK * HEAD_DIM, H_CHK * HEAD_DIM, H_CHK * HEAD_DIM)
ODD_SPLITS = (Q_LORA, KV_LORA, MLA_ROPE,
              H_DIFF * 2 * DIFF_DIM, H_DIFF * 2 * DIFF_DIM, H_DIFF * 2 * DIFF_DIM)
IN_EVEN = sum(EVEN_SPLITS)
IN_ODD = sum(ODD_SPLITS)
MIX_WIDTH_EVEN = (H_FOX + H_CHK) * HEAD_DIM
MIX_WIDTH_ODD = H_MLA * MLA_V + H_DIFF * 2 * DIFF_DIM

kernel_name = 'hybrid_chunk_causal_encoder'


def _split(a, sizes):
    return jnp.split(a, np.cumsum(sizes)[:-1].tolist(), axis=-1)


def layer_norm(x, g, b):
    xf = x.astype(jnp.float32)
    mu = jnp.mean(xf, axis=-1, keepdims=True)
    var = jnp.mean(jnp.square(xf - mu), axis=-1, keepdims=True)
    return ((xf - mu) * lax.rsqrt(var + LN_EPS) * g + b).astype(x.dtype)


def rms_norm(x, g):
    xf = x.astype(jnp.float32)
    return (xf * lax.rsqrt(jnp.mean(jnp.square(xf), axis=-1, keepdims=True) + RMS_EPS) * g).astype(x.dtype)


def rope(x, pos):
    d = x.shape[-1]
    inv = ROPE_THETA ** (-jnp.arange(0, d, 2, dtype=jnp.float32) / d)
    ang = pos.astype(jnp.float32)[:, None] * inv[None, :]
    cos = jnp.cos(ang)[:, None, :]
    sin = jnp.sin(ang)[:, None, :]
    xf = x.astype(jnp.float32)
    x1, x2 = xf[..., : d // 2], xf[..., d // 2:]
    return jnp.concatenate([x1 * cos - x2 * sin, x2 * cos + x1 * sin], axis=-1).astype(x.dtype)


def sweep_attention(q, k, v, scale, per_frame, log_decay=None):
    B, S, H, dk = q.shape
    nb = S // Q_BLOCK
    k_pos = jnp.arange(S)
    qb = jnp.moveaxis(q.reshape(B, nb, Q_BLOCK, H, dk), 1, 0)
    xs = (jnp.arange(nb), qb)
    if log_decay is not None:
        cum_k = jnp.transpose(log_decay, (0, 2, 1))
        xs = xs + (jnp.moveaxis(log_decay.reshape(B, nb, Q_BLOCK, H), 1, 0),)

    def block(xs_i):
        i, qi = xs_i[0], xs_i[1]
        q_pos = i * Q_BLOCK + jnp.arange(Q_BLOCK)
        s = jnp.einsum('bqhd,bkhd->bhqk', qi, k, preferred_element_type=jnp.float32) * scale
        if per_frame:
            allowed = k_pos[None, :] <= q_pos[:, None]
        else:
            allowed = (k_pos[None, :] // CHUNK) <= (q_pos[:, None] // CHUNK)
        if log_decay is not None:
            ci = jnp.transpose(xs_i[2], (0, 2, 1))
            s = s + ci[..., None] - cum_k[:, :, None, :]
        s = jnp.where(allowed, s, NEG_INF)
        p = jax.nn.softmax(s, axis=-1)
        return jnp.einsum('bhqk,bkhd->bqhd', p.astype(v.dtype), v)

    out = lax.map(block, xs)
    return jnp.moveaxis(out, 0, 1).reshape(B, S, H, v.shape[-1])


def chunk_band_attention(q, k, v, rel_bias):
    B, S, H, d = q.shape
    nc = S // CHUNK
    pad = LEFT_CHUNKS * CHUNK
    kp = jnp.pad(k, ((0, 0), (pad, 0), (0, 0), (0, 0)))
    vp = jnp.pad(v, ((0, 0), (pad, 0), (0, 0), (0, 0)))
    band_idx = jnp.arange(nc)[:, None] * CHUNK + jnp.arange(BAND)[None, :]
    kb = kp[:, band_idx]
    vb = vp[:, band_idx]
    valid = band_idx >= pad
    qc = q.reshape(B, nc, CHUNK, H, d)
    s = jnp.einsum('bcqhd,bckhd->bhcqk', qc, kb, preferred_element_type=jnp.float32) * (d ** -0.5)
    rel = (jnp.arange(CHUNK)[:, None] + pad) - jnp.arange(BAND)[None, :]
    ridx = jnp.clip(rel, -REL_MAX, REL_MAX) + REL_MAX
    bias = rel_bias.astype(jnp.float32)[:, ridx]
    s = s + bias[None, :, None, :, :]
    s = jnp.where(valid[None, None, :, None, :], s, NEG_INF)
    p = jax.nn.softmax(s, axis=-1)
    o = jnp.einsum('bhcqk,bckhd->bcqhd', p.astype(v.dtype), vb)
    return o.reshape(B, S, H, d)


def even_mixer(x, w_in, b_forget, rel_bias, w_out):
    B, S, _ = x.shape
    fq, fk, fv, f_logit, cq, ck, cv = _split(x @ w_in, EVEN_SPLITS)

    def heads(t, h):
        return t.reshape(B, S, h, HEAD_DIM)

    log_f = jax.nn.log_sigmoid((f_logit + b_forget).astype(jnp.float32))
    cum_log_f = jnp.cumsum(log_f, axis=1)
    o_fox = sweep_attention(heads(fq, H_FOX), heads(fk, H_FOX), heads(fv, H_FOX),
                            HEAD_DIM ** -0.5, True, cum_log_f)
    o_chk = chunk_band_attention(heads(cq, H_CHK), heads(ck, H_CHK), heads(cv, H_CHK), rel_bias)
    o = jnp.concatenate([o_fox.reshape(B, S, -1), o_chk.reshape(B, S, -1)], axis=-1)
    return o @ w_out


def odd_mixer(x, w_in, g_q_lora, g_kv_lora, w_uq, w_ukv, diff_lambda, g_subln, w_out, pos, layer_idx):
    B, S, _ = x.shape
    cq, ckv, kpe, dq, dk, dv = _split(x @ w_in, ODD_SPLITS)

    q = (rms_norm(cq, g_q_lora) @ w_uq).reshape(B, S, H_MLA, MLA_NOPE + MLA_ROPE)
    q = jnp.concatenate([q[..., :MLA_NOPE], rope(q[..., MLA_NOPE:], pos)], axis=-1)
    kv = (rms_norm(ckv, g_kv_lora) @ w_ukv).reshape(B, S, H_MLA, MLA_NOPE + MLA_V)
    k_pe = jnp.broadcast_to(rope(kpe[:, :, None, :], pos), (B, S, H_MLA, MLA_ROPE))
    k = jnp.concatenate([kv[..., :MLA_NOPE], k_pe], axis=-1)
    v = kv[..., MLA_NOPE:]
    o_mla = sweep_attention(q, k, v, (MLA_NOPE + MLA_ROPE) ** -0.5, False).reshape(B, S, -1)

    dq = rope(dq.reshape(B, S, H_DIFF * 2, DIFF_DIM), pos).reshape(B, S, H_DIFF, 2, DIFF_DIM)
    dk = rope(dk.reshape(B, S, H_DIFF * 2, DIFF_DIM), pos).reshape(B, S, H_DIFF, 2, DIFF_DIM)
    dv = dv.reshape(B, S, H_DIFF, 2 * DIFF_DIM)
    a1 = sweep_attention(dq[:, :, :, 0], dk[:, :, :, 0], dv, DIFF_DIM ** -0.5, False)
    a2 = sweep_attention(dq[:, :, :, 1], dk[:, :, :, 1], dv, DIFF_DIM ** -0.5, False)
    lam_init = 0.8 - 0.6 * math.exp(-0.3 * layer_idx)
    lf = diff_lambda.astype(jnp.float32)
    lam = jnp.exp(jnp.sum(lf[0] * lf[1])) - jnp.exp(jnp.sum(lf[2] * lf[3])) + lam_init
    o_diff = rms_norm(a1 - lam.astype(a1.dtype) * a2, g_subln) * (1.0 - lam_init)
    o_diff = o_diff.reshape(B, S, -1)

    o = jnp.concatenate([o_mla, o_diff], axis=-1)
    return o @ w_out


def peer_ffn(x, w_query, sub_keys, u_tab, v_tab):
    B, S, D = x.shape
    T = B * S
    xt = x.reshape(T, D)
    q = (xt @ w_query).reshape(T, PEER_HEADS, 2, PEER_DK // 2)
    s = jnp.einsum('thpd,hpnd->thpn', q, sub_keys, preferred_element_type=jnp.float32)
    sv, si = lax.top_k(s, PEER_TOPK)
    cand = sv[:, :, 0, :, None] + sv[:, :, 1, None, :]
    cidx = si[:, :, 0, :, None] * N_KEYS + si[:, :, 1, None, :]
    top_s, top_pos = lax.top_k(cand.reshape(T, PEER_HEADS, PEER_TOPK * PEER_TOPK), PEER_TOPK)
    idx = jnp.take_along_axis(cidx.reshape(T, PEER_HEADS, PEER_TOPK * PEER_TOPK), top_pos, axis=-1)
    g = jax.nn.softmax(top_s, axis=-1)
    E = PEER_HEADS * PEER_TOPK
    nb = T // PEER_TOKEN_BLOCK

    def block(args):
        xb, ib, gb = args
        h = jax.nn.gelu(jnp.einsum('td,ted->te', xb, u_tab[ib], preferred_element_type=jnp.float32))
        w = (gb * h).astype(v_tab.dtype)
        return jnp.einsum('te,ted->td', w, v_tab[ib])

    out = lax.map(block, (xt.reshape(nb, PEER_TOKEN_BLOCK, D),
                          idx.reshape(nb, PEER_TOKEN_BLOCK, E),
                          g.reshape(nb, PEER_TOKEN_BLOCK, E)))
    return out.reshape(B, S, D)


def setup_inputs(seed: int = 0) -> dict:
    key = jax.random.key(seed)
    ks = jax.random.split(key, 21)
    d = D_MODEL

    def nrm(k, shape, scale):
        return jax.random.normal(k, shape, jnp.float32) * scale

    return {
        'x': nrm(ks[0], (BATCH, SEQ, d), 1.0),
        'w_in_even': nrm(ks[1], (N_EVEN, d, IN_EVEN), d ** -0.5),
        'b_forget': jax.random.uniform(ks[2], (N_EVEN, H_FOX), jnp.float32, 1.0, 4.0),
        'rel_bias': nrm(ks[3], (N_EVEN, H_CHK, 2 * REL_MAX + 1), 0.1),
        'w_out_even': nrm(ks[4], (N_EVEN, MIX_WIDTH_EVEN, d), BETA * MIX_WIDTH_EVEN ** -0.5),
        'w_in_odd': nrm(ks[5], (N_ODD, d, IN_ODD), d ** -0.5),
        'g_q_lora': 1.0 + nrm(ks[6], (N_ODD, Q_LORA), 0.02),
        'g_kv_lora': 1.0 + nrm(ks[7], (N_ODD, KV_LORA), 0.02),
        'w_uq': nrm(ks[8], (N_ODD, Q_LORA, H_MLA * (MLA_NOPE + MLA_ROPE)), Q_LORA ** -0.5),
        'w_ukv': nrm(ks[9], (N_ODD, KV_LORA, H_MLA * (MLA_NOPE + MLA_V)), KV_LORA ** -0.5),
        'diff_lambda': nrm(ks[10], (N_ODD, 4, DIFF_DIM), 0.1),
        'g_subln': 1.0 + nrm(ks[11], (N_ODD, 2 * DIFF_DIM), 0.02),
        'w_out_odd': nrm(ks[12], (N_ODD, MIX_WIDTH_ODD, d), BETA * MIX_WIDTH_ODD ** -0.5),
        'peer_w_query': nrm(ks[13], (DEPTH, d, PEER_HEADS * PEER_DK), d ** -0.5),
        'peer_sub_keys': nrm(ks[14], (DEPTH, PEER_HEADS, 2, N_KEYS, PEER_DK // 2), (PEER_DK // 2) ** -0.5),
        'peer_u': nrm(ks[15], (DEPTH, N_EXPERTS, d), d ** -0.5),
        'peer_v': nrm(ks[16], (DEPTH, N_EXPERTS, d), BETA * (PEER_HEADS * PEER_TOPK) ** -0.5),
        'ln_mix_g': 1.0 + nrm(ks[17], (DEPTH, d), 0.02),
        'ln_mix_b': nrm(ks[18], (DEPTH, d), 0.02),
        'ln_ffn_g': 1.0 + nrm(ks[19], (DEPTH, d), 0.02),
        'ln_ffn_b': nrm(ks[20], (DEPTH, d), 0.02),
    }


def reference(x, w_in_even, b_forget, rel_bias, w_out_even, w_in_odd, g_q_lora, g_kv_lora,
              w_uq, w_ukv, diff_lambda, g_subln, w_out_odd, peer_w_query, peer_sub_keys,
              peer_u, peer_v, ln_mix_g, ln_mix_b, ln_ffn_g, ln_ffn_b):
    pos = jnp.arange(x.shape[1])
    for l in range(DEPTH):
        i = l // 2
        if l % 2 == 0:
            y = even_mixer(x, w_in_even[i], b_forget[i], rel_bias[i], w_out_even[i])
        else:
            y = odd_mixer(x, w_in_odd[i], g_q_lora[i], g_kv_lora[i], w_uq[i], w_ukv[i],
                          diff_lambda[i], g_subln[i], w_out_odd[i], pos, l)
        x = layer_norm(ALPHA * x + y, ln_mix_g[l], ln_mix_b[l])
        y = peer_ffn(x, peer_w_query[l], peer_sub_keys[l], peer_u[l], peer_v[l])
        x = layer_norm(ALPHA * x + y, ln_ffn_g[l], ln_ffn_b[l])
    return x
```

```cpp
#include <hip/hip_runtime.h>
#include <stdint.h>
#include <stdio.h>

namespace {
constexpr int D = 2048, NB = 2, S = 4096, T = NB * S;
constexpr int NEV = 6152, NOD = 4160;
constexpr float ALPHA = 1.681792830507429f;
constexpr float LN_EPS = 1e-5f, RMS_EPS = 1e-6f;
constexpr int NTHR = 512;
constexpr int NBLK = 256;
constexpr int LDS_BYTES = 144 * 1024;
constexpr int N_LAUNCH_SPLIT = 0;
constexpr int PROBE = 0;
constexpr bool ATT_NAIVE = false;
constexpr bool PEER_PIPE = true;
constexpr bool PEER_SPLIT = true;
constexpr bool PEER_FP4 = true;
constexpr bool PEER_FP6 = true;
constexpr bool PEER_SWEEP = false;
constexpr bool PEER_FP8 = true;

constexpr size_t SZ_TD   = (size_t)T * D * 4;
constexpr size_t OFF_BAR = 0;
constexpr size_t OFF_X   = 1 << 16;
constexpr size_t OFF_P   = OFF_X + SZ_TD;
constexpr size_t OFF_Q2  = OFF_P + (size_t)T * NEV * 4;
constexpr size_t OFF_KV2 = OFF_Q2 + (size_t)T * 1536 * 4;
constexpr size_t OFF_O   = OFF_KV2 + SZ_TD;
constexpr size_t OFF_Y   = OFF_O + SZ_TD;
constexpr size_t OFF_PQ  = OFF_Y + SZ_TD;
constexpr size_t OFF_A12 = OFF_PQ + SZ_TD;
constexpr size_t OFF_IDX = OFF_A12 + SZ_TD;
constexpr size_t OFF_G   = OFF_IDX + (size_t)T * 128 * 4;
constexpr size_t OFF_CUM = OFF_G + (size_t)T * 128 * 4;
constexpr size_t OFF_R128 = OFF_CUM + (size_t)T * 8 * 4;
constexpr size_t OFF_R64  = OFF_R128 + (size_t)S * 64 * 8;
constexpr size_t OFF_WT   = OFF_R64 + (size_t)S * 32 * 8;
constexpr size_t WT_EIN  = 0;
constexpr size_t WT_EOUT = WT_EIN + (size_t)2 * 6144 * 2048;
constexpr size_t WT_OIN  = WT_EOUT + (size_t)2 * 2048 * 2048;
constexpr size_t WT_UQ   = WT_OIN + (size_t)2 * 4096 * 2048;
constexpr size_t WT_UKV  = WT_UQ + (size_t)2 * 1536 * 512;
constexpr size_t WT_OOUT = WT_UKV + (size_t)2 * 2048 * 512;
constexpr size_t WT_PQ   = WT_OOUT + (size_t)2 * 2048 * 2048;
constexpr size_t WT_GATE = WT_PQ + (size_t)4 * 2048 * 2048;
constexpr size_t WT_KPE  = WT_GATE + (size_t)2 * 64 * 2048;
constexpr size_t WT_ELEMS = WT_KPE + (size_t)2 * 64 * 2048;
constexpr size_t OFF_XB  = OFF_WT + WT_ELEMS * 2;
constexpr size_t OFF_OB  = OFF_XB + (size_t)T * D * 2;
constexpr size_t OFF_CQB = OFF_OB + (size_t)T * D * 2;
constexpr size_t OFF_ATT = OFF_CQB + (size_t)T * 1024 * 2;
constexpr size_t OFF_GL  = OFF_ATT + (size_t)128 * 1024 * 1024;
constexpr size_t OFF_CUMH = OFF_GL + (size_t)T * 8 * 4;
constexpr size_t OFF_SSQ = OFF_CUMH + (size_t)T * 8 * 4;
constexpr size_t OFF_KPE = OFF_SSQ + (size_t)2 * T * 8 * 4;
constexpr size_t OFF_UB  = OFF_KPE + (size_t)T * 64 * 4;
constexpr size_t OFF_VB  = OFF_UB + (size_t)4 * 16384 * D * 2;
constexpr size_t OFF_SU  = OFF_VB + (size_t)4 * 16384 * D * 2;
constexpr size_t OFF_SV  = OFF_SU + (size_t)4 * 16384 * 4;
constexpr size_t OFF_PQB = OFF_SV + (size_t)4 * 16384 * 4;
constexpr size_t OFF_SKB = OFF_PQB + (size_t)T * D * 2;
constexpr size_t OFF_LNS = OFF_SKB + (size_t)4 * 8 * 2 * 128 * 128 * 2;
constexpr size_t WS_END  = OFF_LNS + (size_t)4 * T * 8 * 8;
constexpr int CTR_WORD0 = 4096;
constexpr int LNC_WORD0 = 4096 + 64 * 8;
constexpr int CTL_WORDS = LNC_WORD0 + 4 * 32 * 16;

struct Params {
    const float* in[21];
    float* out;
    unsigned char* ws;
    int ph_lo, ph_hi;
};

#define XB_TMO      128
#define XB_XCNT(j)  (256  + 64 * (j))
#define XB_XSUB(j)  (1280 + 64 * (j))
#define XB_XGEN(j)  (2304 + 64 * (j))
#define XB_TOP      3328
#define XB_TOPGEN   3392
#define XCD_BAR_WORDS 3456
#define XB_SPIN_CAP (1u << 26)
#define LAS __attribute__((address_space(3)))

__device__ __forceinline__ unsigned xb_ld(unsigned* p)              { return __hip_atomic_load(p, __ATOMIC_RELAXED, __HIP_MEMORY_SCOPE_AGENT); }
__device__ __forceinline__ unsigned xb_add(unsigned* p, unsigned v) { return __hip_atomic_fetch_add(p, v, __ATOMIC_RELAXED, __HIP_MEMORY_SCOPE_AGENT); }
__device__ __forceinline__ unsigned xb_xcc_id() { return (unsigned)__builtin_amdgcn_s_getreg((3 << 11) | 20) & 0xFu; }
#define XB_SPIN(cond, bar) do { unsigned _sp = 0; while (cond) { __builtin_amdgcn_s_sleep(1); \
    if ((++_sp & 255u) == 0u) { if (xb_ld(&(bar)[XB_TMO])) break; if (_sp > XB_SPIN_CAP) { atomicAdd(&(bar)[XB_TMO], 1u); break; } } } } while (0)

struct XcdBarrier { unsigned* bar; unsigned x; volatile LAS unsigned* st; };

__device__ __forceinline__ XcdBarrier xcd_barrier_post(unsigned* bar, volatile LAS unsigned* st) {
    XcdBarrier b; b.bar = bar; b.x = xb_xcc_id(); b.st = st;
    if (threadIdx.x == 0) (void)xb_add(&bar[XB_XCNT(b.x)], 1u);
    return b;
}
__device__ __forceinline__ void xcd_barrier_complete(unsigned* bar, unsigned x, unsigned& nloc, unsigned& nx) {
    const unsigned G = (unsigned)NBLK;
    unsigned sum, cnt, mine, sp = 0u;
    for (;;) {
        sum = 0u; cnt = 0u; mine = 0u;
#pragma unroll
        for (unsigned j = 0; j < 16; ++j) { const unsigned c = xb_ld(&bar[XB_XCNT(j)]); sum += c; cnt += (c > 0u) ? 1u : 0u; mine = (j == x) ? c : mine; }
        if (sum == G) break;
        __builtin_amdgcn_s_sleep(1);
        if ((++sp & 255u) == 0u) { if (xb_ld(&bar[XB_TMO])) break; if (sp > XB_SPIN_CAP) { atomicAdd(&bar[XB_TMO], 1u); break; } }
    }
    nloc = mine > 0u ? mine : 1u; nx = cnt > 0u ? cnt : 1u;
}
__device__ __forceinline__ void xcd_barrier(const XcdBarrier& b) {
    asm volatile("s_waitcnt vmcnt(0)" ::: "memory");
    __syncthreads();
    if (threadIdx.x == 0) {
        unsigned* bar = b.bar;
        __builtin_amdgcn_s_waitcnt(0);
        unsigned nloc = b.st[0], nx = b.st[1];
        if (nloc == 0u) { xcd_barrier_complete(bar, b.x, nloc, nx); b.st[0] = nloc; b.st[1] = nx; }
        const unsigned old = xb_add(&bar[XB_XSUB(b.x)], 1u);
        const unsigned gen = old / nloc;
        if (old + 1u == (gen + 1u) * nloc) {
            __builtin_amdgcn_fence(__ATOMIC_RELEASE, "agent");
            asm volatile("s_waitcnt vmcnt(0)" ::: "memory");
            const unsigned og = xb_add(&bar[XB_TOP], 1u);
            const unsigned tg = og / nx;
            if (og + 1u == (tg + 1u) * nx) xb_add(&bar[XB_TOPGEN], 1u);
            else XB_SPIN(xb_ld(&bar[XB_TOPGEN]) == tg, bar);
            __builtin_amdgcn_fence(__ATOMIC_ACQUIRE, "agent");
            xb_add(&bar[XB_XGEN(b.x)], 1u);
            asm volatile("s_waitcnt vmcnt(0)" ::: "memory");
        } else {
            XB_SPIN(xb_ld(&bar[XB_XGEN(b.x)]) == gen, bar);
            __builtin_amdgcn_fence(__ATOMIC_ACQUIRE, "agent");
            asm volatile("s_waitcnt vmcnt(0)" ::: "memory");
        }
    }
    __syncthreads();
}

template <int M> __device__ __forceinline__ float swz_xor(float v) { return __int_as_float(__builtin_amdgcn_ds_swizzle(__float_as_int(v), (M << 10) | 0x1f)); }
template <int M> __device__ __forceinline__ int swz_xor_i(int v) { return __builtin_amdgcn_ds_swizzle(v, (M << 10) | 0x1f); }
__device__ __forceinline__ float swap32(float v) {
    auto rr = __builtin_amdgcn_permlane32_swap(__float_as_uint(v), __float_as_uint(v), false, false);
    const float a = __uint_as_float(rr[0]), b = __uint_as_float(rr[1]);
    return (__float_as_uint(a) == __float_as_uint(v)) ? b : a;
}
__device__ __forceinline__ float wsum(float v) {
    v += swz_xor<1>(v); v += swz_xor<2>(v); v += swz_xor<4>(v); v += swz_xor<8>(v); v += swz_xor<16>(v);
    auto rr = __builtin_amdgcn_permlane32_swap(__float_as_uint(v), __float_as_uint(v), false, false);
    return __uint_as_float(rr[0]) + __uint_as_float(rr[1]);
}
__device__ __forceinline__ float wmaxf(float v) {
    v = fmaxf(v, swz_xor<1>(v)); v = fmaxf(v, swz_xor<2>(v)); v = fmaxf(v, swz_xor<4>(v)); v = fmaxf(v, swz_xor<8>(v)); v = fmaxf(v, swz_xor<16>(v));
    auto rr = __builtin_amdgcn_permlane32_swap(__float_as_uint(v), __float_as_uint(v), false, false);
    return fmaxf(__uint_as_float(rr[0]), __uint_as_float(rr[1]));
}
__device__ __forceinline__ int imax(int a, int b) { return a > b ? a : b; }
__device__ __forceinline__ int imin(int a, int b) { return a < b ? a : b; }
__device__ __forceinline__ float gelu_tanh(float h) {
    return 0.5f * h * (1.f + tanhf(0.7978845608028654f * (h + 0.044715f * h * h * h)));
}

__device__ __forceinline__ int opaque_tid() { int t = threadIdx.x; asm volatile("" : "+v"(t)); return t; }


#define GAS __attribute__((address_space(1)))
typedef unsigned short bf16_t;
using bf16x8 = __attribute__((ext_vector_type(8))) short;
using f32x4 = __attribute__((ext_vector_type(4))) float;
using f32x16 = __attribute__((ext_vector_type(16))) float;
using u32x2 = __attribute__((ext_vector_type(2))) unsigned;
using u32x4 = __attribute__((ext_vector_type(4))) unsigned;
typedef __bf16 bf16x2_cv __attribute__((ext_vector_type(2)));
typedef float f32x2_cv __attribute__((ext_vector_type(2)));
__device__ __forceinline__ unsigned cvtpk(float lo, float hi) { return __builtin_bit_cast(unsigned, __builtin_convertvector(f32x2_cv{lo, hi}, bf16x2_cv)); }
__device__ __forceinline__ bf16_t f2bf(float f) { return (bf16_t)(cvtpk(f, 0.f) & 0xffffu); }

__device__ __forceinline__ void convert_rows_bf16(const float* __restrict__ src, bf16_t* __restrict__ dst, size_t n) {
    const int tid_ = opaque_tid();
    const size_t n4 = n / 4;
    for (size_t i = (size_t)blockIdx.x * NTHR + tid_; i < n4; i += (size_t)NBLK * NTHR) {
        const float4 v = ((const float4*)src)[i];
        ((uint2*)dst)[i] = make_uint2(cvtpk(v.x, v.y), cvtpk(v.z, v.w));
    }
}

__device__ __forceinline__ int perm_pair(int p) { return (p & ~31) | ((p & 15) << 1) | ((p >> 4) & 1); }
__device__ __forceinline__ int perm_rope128(int p) { return (((p >> 4) & 1) << 6) | ((p >> 5) << 4) | (p & 15); }
struct ColId   { __device__ __forceinline__ int operator()(int n) const { return n; } };
struct ColPair { __device__ __forceinline__ int operator()(int n) const { return (n & ~127) | perm_pair(n & 127); } };
struct ColEven {
    __device__ __forceinline__ int operator()(int n) const {
        const int g = n >> 10, c = n & 1023, p = c & 127; const bool isv = (g == 2) || (g == 5);
        return g * 1024 + (c & ~127) + (isv ? p : perm_pair(p)) + (g >= 3 ? 8 : 0);
    }
};
struct ColOddIn {
    __device__ __forceinline__ int operator()(int n) const {
        if (n < 1024) return (n & ~127) | perm_pair(n & 127);
        const int m = n - 1024, g2 = m >> 10, c = m & 1023, p = c & 127;
        return 1088 + g2 * 1024 + (c & ~127) + (g2 < 2 ? perm_rope128(p) : p);
    }
};
struct ColOddTmp { __device__ __forceinline__ int operator()(int n) const { return n + (n >= 1024 ? 64 : 0); } };
struct ColUq {
    __device__ __forceinline__ int operator()(int n) const {
        if (n < 1024) return (n >> 7) * 192 + perm_pair(n & 127);
        const int m = n - 1024, tidx = m >> 8, p = m & 255, bj = p >> 7, wc = (p >> 5) & 3, nn = (p >> 4) & 1, fr = p & 15;
        return (tidx * 4 + bj * 2 + (wc >> 1)) * 192 + 128 + nn * 32 + (wc & 1) * 16 + fr;
    }
};
struct ColUkv {
    __device__ __forceinline__ int operator()(int n) const { const int p = n & 255; return (n & ~255) + (p < 128 ? perm_pair(p) : p); }
};
template <class SrcCol>
__device__ __forceinline__ void transpose_convert(const float* __restrict__ W, int ldw, int K, int Nout, SrcCol srccol, const float* __restrict__ kgain,
                                                  bf16_t* __restrict__ Wt, int& gbase) {
    const int tid = opaque_tid(); const int wave = tid >> 6, lane = tid & 63;
    const int nk = K / 64, ntile = (Nout / 64) * nk, G = NBLK * 8;
    const int me = blockIdx.x * 8 + wave;
    const int first = gbase + ((me - gbase % G) + G) % G;
    for (int g = first; g < gbase + ntile; g += G) {
        const int v = g - gbase, n0 = (v / nk) * 64, k0 = (v % nk) * 64;
        const int sc = srccol(n0 + lane);
        const GAS float* wp = (const GAS float*)W + (size_t)k0 * ldw + (sc >= 0 ? sc : 0);
        float f[64];
#pragma unroll
        for (int k = 0; k < 64; ++k) f[k] = wp[(size_t)k * ldw];
        if (sc < 0) {
#pragma unroll
            for (int k = 0; k < 64; ++k) f[k] = 0.f;
        }
        if (kgain) {
#pragma unroll
            for (int k = 0; k < 64; ++k) f[k] *= kgain[k0 + k];
        }
        extern __shared__ __attribute__((aligned(16))) unsigned char tc_lds[];
        LAS unsigned char* tl = (LAS unsigned char*)tc_lds + wave * (64 * 144);
#pragma unroll
        for (int q = 0; q < 8; ++q)
            *(LAS u32x4*)(tl + lane * 144 + q * 16) = u32x4{cvtpk(f[8 * q], f[8 * q + 1]), cvtpk(f[8 * q + 2], f[8 * q + 3]), cvtpk(f[8 * q + 4], f[8 * q + 5]), cvtpk(f[8 * q + 6], f[8 * q + 7])};
#pragma unroll
        for (int q = 0; q < 8; ++q) {
            const int nr = q * 8 + (lane >> 3);
            const u32x4 t = *(const LAS u32x4*)(tl + nr * 144 + (lane & 7) * 16);
            *(GAS u32x4*)((GAS bf16_t*)Wt + (size_t)(n0 + nr) * K + k0 + (lane & 7) * 8) = t;
        }
    }
    gbase += ntile;
}

constexpr int G_HT = 128 * 64;
__device__ __forceinline__ int g_lds_byte(int r, int c) { const int st = (r >> 4) * 2 + (c >> 5), rr = r & 15, cc = c & 31, ob = rr * 64 + cc * 2; return st * 1024 + (ob ^ (((ob >> 9) & 1) << 5)); }
__device__ __forceinline__ void g_stage_rc(int b, int& R, int& C) { const int st = b / 1024, sb = b % 1024, swz = sb ^ (((sb >> 9) & 1) << 5); R = (st >> 1) * 16 + swz / 64; C = (st & 1) * 32 + (swz % 64) / 2; }

struct EpiF32 {
    float* C; int ldc; int split; int skip;
    __device__ __forceinline__ void operator()(const f32x4 (&acc)[2][2][4][2], int brow, int bcol, int wr, int wc, int fr, int fq) const {
        __attribute__((address_space(1))) float* Cg = (__attribute__((address_space(1))) float*)C;
#pragma unroll
        for (int ai = 0; ai < 2; ++ai)
#pragma unroll
            for (int bj = 0; bj < 2; ++bj)
#pragma unroll
                for (int m = 0; m < 4; ++m)
#pragma unroll
                    for (int n = 0; n < 2; ++n) {
                        int col = bcol + bj * 128 + wc * 32 + n * 16 + fr; col += (col >= split) ? skip : 0;
#pragma unroll
                        for (int j = 0; j < 4; ++j)
                            Cg[(size_t)(brow + ai * 128 + wr * 64 + m * 16 + fq * 4 + j) * ldc + col] = acc[ai][bj][m][n][j];
                    }
    }
};

template <class Epi>
__device__ __forceinline__ void gemm_tile_256(const bf16_t* __restrict__ A, const bf16_t* __restrict__ Bt, int K, int brow, int bcol, const Epi& epi) {
    extern __shared__ __attribute__((aligned(16))) bf16_t g_shm[];
#define SA(b,h) (g_shm+((b)*2+(h))*G_HT)
#define SB(b,h) (g_shm+(4+(b)*2+(h))*G_HT)
#define STAGE_X(P,BASE,br,kt) do{ const char* _gb=(const char*)(BASE)+((size_t)(br)*(size_t)K+(size_t)(kt)*64)*2; \
      __builtin_amdgcn_global_load_lds((const unsigned*)(_gb+so0),(unsigned*)((char*)(P)+tid*16),16,0,0); \
      __builtin_amdgcn_global_load_lds((const unsigned*)(_gb+so1),(unsigned*)((char*)(P)+tid*16+8192),16,0,0); }while(0)
#define STAGE_A(P,br,kt) STAGE_X(P,A,br,kt)
#define STAGE_B(P,br,kt) STAGE_X(P,Bt,br,kt)
#define LDA(dst,b,h) for(int m=0;m<4;++m)for(int k=0;k<2;++k) dst[m][k]=*reinterpret_cast<const bf16x8*>((char*)SA(b,h)+g_lds_byte(wr*64+m*16+fr,k*32+fq*8))
#define LDB(dst,b,h) for(int n=0;n<2;++n)for(int k=0;k<2;++k) dst[n][k]=*reinterpret_cast<const bf16x8*>((char*)SB(b,h)+g_lds_byte(wc*32+n*16+fr,k*32+fq*8))
#define MMA(ai,bj,At_,Bt_) do{__builtin_amdgcn_s_setprio(1); \
    for(int m=0;m<4;++m)for(int n=0;n<2;++n)for(int k=0;k<2;++k) \
      acc[ai][bj][m][n]=__builtin_amdgcn_mfma_f32_16x16x32_bf16(At_[m][k],Bt_[n][k],acc[ai][bj][m][n],0,0,0); \
    __builtin_amdgcn_s_setprio(0);}while(0)
#define WAIT_V(n) asm volatile("s_waitcnt vmcnt(" #n ")":::"memory")
#define WAIT_L(n) asm volatile("s_waitcnt lgkmcnt(" #n ")":::"memory")
#define BAR __builtin_amdgcn_s_barrier()
#define SCHED __builtin_amdgcn_sched_barrier(0)
    int tid = opaque_tid();
    int wid = tid >> 6, lane = tid & 63, wr = wid >> 2, wc = wid & 3, fr = lane & 15, fq = lane >> 4;
    unsigned so0, so1;
    { int r_, c_; g_stage_rc(tid * 16, r_, c_); so0 = (unsigned)(r_ * K + c_) * 2u; g_stage_rc(tid * 16 + 8192, r_, c_); so1 = (unsigned)(r_ * K + c_) * 2u; }
    f32x4 acc[2][2][4][2];
#pragma unroll
    for (int a0 = 0; a0 < 2; ++a0)
#pragma unroll
        for (int a1 = 0; a1 < 2; ++a1)
#pragma unroll
            for (int a2 = 0; a2 < 4; ++a2)
#pragma unroll
                for (int a3 = 0; a3 < 2; ++a3) acc[a0][a1][a2][a3] = f32x4{0.f, 0.f, 0.f, 0.f};
    bf16x8 At[4][2], B0[2][2], B1[2][2];
    const int nt = K / 64;
    STAGE_B(SB(0,0),bcol,0); STAGE_A(SA(0,0),brow,0);
    STAGE_B(SB(0,1),bcol+128,0); STAGE_A(SA(0,1),brow+128,0);
    if(wr==1)BAR;
    WAIT_V(4); BAR;
    STAGE_B(SB(1,0),bcol,1); STAGE_A(SA(1,0),brow,1); STAGE_B(SB(1,1),bcol+128,1);
    WAIT_V(6); BAR;
    for(int t=0;t<nt-2;t+=2){
        LDB(B0,0,0); SCHED; LDA(At,0,0); STAGE_A(SA(1,1),brow+128,t+1);
        WAIT_L(8); BAR; WAIT_L(0); MMA(0,0,At,B0); BAR; SCHED;
        LDB(B1,0,1); STAGE_B(SB(0,0),bcol,t+2);
        BAR; WAIT_L(0); MMA(0,1,At,B1); BAR;
        LDA(At,0,1); STAGE_A(SA(0,0),brow,t+2);
        BAR; WAIT_L(0); MMA(1,0,At,B0); BAR; SCHED;
        STAGE_B(SB(0,1),bcol+128,t+2);
        WAIT_V(6); BAR; MMA(1,1,At,B1); BAR;
        LDB(B0,1,0); SCHED; LDA(At,1,0); STAGE_A(SA(0,1),brow+128,t+2);
        WAIT_L(8); BAR; WAIT_L(0); MMA(0,0,At,B0); BAR; SCHED;
        LDB(B1,1,1); STAGE_B(SB(1,0),bcol,t+3);
        BAR; WAIT_L(0); MMA(0,1,At,B1); BAR;
        LDA(At,1,1); STAGE_A(SA(1,0),brow,t+3);
        BAR; WAIT_L(0); MMA(1,0,At,B0); BAR; SCHED;
        STAGE_B(SB(1,1),bcol+128,t+3);
        WAIT_V(6); BAR; MMA(1,1,At,B1); BAR;
    }
    { int tz = threadIdx.x; asm volatile("":"+v"(tz)); tid = tz; wid=tz>>6; lane=tz&63; wr=wid>>2; wc=wid&3; fr=lane&15; fq=lane>>4;
      int r_, c_; g_stage_rc(tid * 16, r_, c_); so0 = (unsigned)(r_ * K + c_) * 2u; g_stage_rc(tid * 16 + 8192, r_, c_); so1 = (unsigned)(r_ * K + c_) * 2u; }
    { LDB(B0,0,0); WAIT_V(0); LDA(At,0,0); STAGE_A(SA(1,1),brow+128,nt-1);
      BAR; WAIT_L(0); MMA(0,0,At,B0); BAR;
      LDB(B1,0,1); BAR; WAIT_L(0); MMA(0,1,At,B1); BAR;
      LDA(At,0,1); WAIT_V(4); BAR; WAIT_L(0); MMA(1,0,At,B0); MMA(1,1,At,B1); BAR; }
    { LDB(B0,1,0); LDA(At,1,0); WAIT_V(2); BAR; WAIT_L(0); MMA(0,0,At,B0); BAR;
      LDB(B1,1,1); WAIT_V(0); BAR; WAIT_L(0); MMA(0,1,At,B1); BAR;
      LDA(At,1,1); BAR; WAIT_L(0); MMA(1,0,At,B0); MMA(1,1,At,B1); BAR; }
    if(wr==0)BAR;
    epi(acc, brow, bcol, wr, wc, fr, fq);
#undef SA
#undef SB
#undef STAGE_X
#undef STAGE_A
#undef STAGE_B
#undef LDA
#undef LDB
#undef MMA
#undef WAIT_V
#undef WAIT_L
#undef BAR
#undef SCHED
}

template <class Epi>
__device__ __forceinline__ void gemm_phase(const bf16_t* __restrict__ A, const bf16_t* __restrict__ Bt, int M, int N, int K, int goff, const Epi& epi) {
    const int nM = M / 256, nN = N / 256, ntile = nM * nN, G = NBLK;
    const int first = goff + (((int)blockIdx.x - goff % G) + G) % G;
    const bool super = ((nN & 7) == 0) && ((nM & 3) == 0) && (G == 256) && (goff == 0);
    for (int g = first; g < goff + ntile; g += G) {
        const int v = g - goff;
        int pm, pn;
        if (super) { const int r = v >> 8, slot = v & 255, xcd = slot & 7, j = slot >> 3, st = r * 8 + xcd, nSN = nN >> 3; pm = (st / nSN) * 4 + (j >> 3); pn = (st % nSN) * 8 + (j & 7); }
        else { pm = v / nN; pn = v % nN; }
        gemm_tile_256(A, Bt, K, pm * 256, pn * 256, epi);
    }
}

constexpr float LOG2E = 1.4426950408889634f;
constexpr size_t EHSZ = (size_t)NB * 8 * S * 128;
constexpr size_t MHSZ = (size_t)NB * 8 * S * 192;
__device__ __forceinline__ float bf2f(bf16_t v) { return __uint_as_float((unsigned)v << 16); }

template <int BJ_LO, int BJ_HI>
__device__ __forceinline__ void vt_store_lds(const f32x4 (&acc)[2][2][4][2], int brow, int wr, int wc, int fr, int fq, const float* __restrict__ ssq, bf16_t* dst0) {
    extern __shared__ __attribute__((aligned(16))) unsigned char vt_lds[];
    constexpr int PITCH = 528;
    LAS unsigned char* L = (LAS unsigned char*)vt_lds;
#pragma unroll
    for (int ai = 0; ai < 2; ++ai)
#pragma unroll
        for (int m = 0; m < 4; ++m) {
            const int r0 = ai * 128 + wr * 64 + m * 16 + fq * 4;
            float rs[4] = {1.f, 1.f, 1.f, 1.f};
            if (ssq) {
#pragma unroll
                for (int j = 0; j < 4; ++j) {
                    const f32x4 a = *(const GAS f32x4*)(ssq + (size_t)(brow + r0 + j) * 8), c = *(const GAS f32x4*)(ssq + (size_t)(brow + r0 + j) * 8 + 4);
                    rs[j] = rsqrtf(((a[0] + a[1]) + (a[2] + a[3]) + (c[0] + c[1]) + (c[2] + c[3])) * (1.f / 512.f) + RMS_EPS);
                }
            }
#pragma unroll
            for (int bj = BJ_LO; bj < BJ_HI; ++bj)
#pragma unroll
                for (int n = 0; n < 2; ++n) {
                    const f32x4 a = acc[ai][bj][m][n];
                    const int col = (bj - BJ_LO) * 128 + wc * 32 + n * 16 + fr;
                    *(LAS u32x2*)(L + col * PITCH + r0 * 2) = u32x2{cvtpk(a[0] * rs[0], a[1] * rs[1]), cvtpk(a[2] * rs[2], a[3] * rs[3])};
                }
        }
    __syncthreads();
    const int tid = (wr * 4 + wc) * 64 + fq * 16 + fr;
    constexpr int NCH = (BJ_HI - BJ_LO) * 128 * 32;
#pragma unroll
    for (int ch = 0; ch < NCH; ch += NTHR) {
        const int col = (ch + tid) >> 5, tc = (ch + tid) & 31;
        const u32x4 t = *(const LAS u32x4*)(L + col * PITCH + tc * 16);
        *(GAS u32x4*)((GAS bf16_t*)dst0 + (size_t)col * S + tc * 8) = t;
    }
    __syncthreads();
}
struct EpiEven {
    bf16_t* base;
    __device__ __forceinline__ void operator()(const f32x4 (&acc)[2][2][4][2], int brow, int bcol, int wr, int wc, int fr, int fq) const {
        const int g = bcol >> 10, h0 = (bcol & 1023) >> 7;
        bf16_t* dst = base + (size_t)g * EHSZ;
        const int b = brow >> 12;
        if (g != 2 && g != 5) {
#pragma unroll
            for (int ai = 0; ai < 2; ++ai)
#pragma unroll
                for (int m = 0; m < 4; ++m)
#pragma unroll
                    for (int j = 0; j < 4; ++j) {
                        const int sq = (brow & 4095) + ai * 128 + wr * 64 + m * 16 + fq * 4 + j;
#pragma unroll
                        for (int bj = 0; bj < 2; ++bj)
                            *(GAS unsigned*)(dst + ((size_t)(b * 8 + h0 + bj) * S + sq) * 128 + wc * 32 + 2 * fr) = cvtpk(acc[ai][bj][m][0][j], acc[ai][bj][m][1][j]);
                    }
        } else {
            vt_store_lds<0, 2>(acc, brow, wr, wc, fr, fq, nullptr, dst + ((size_t)(b * 8 + h0) * 128) * S + (brow & 4095));
        }
    }
};

struct EpiOddIn {
    bf16_t* cq; float* ssq; bf16_t* att; const float2* r128;
    __device__ __forceinline__ void operator()(const f32x4 (&acc)[2][2][4][2], int brow, int bcol, int wr, int wc, int fr, int fq) const {
        const int b = brow >> 12;
        if (bcol < 1024) {
            const int g = bcol >> 9, tg = (bcol >> 8) & 1;
#pragma unroll
            for (int ai = 0; ai < 2; ++ai)
#pragma unroll
                for (int m = 0; m < 4; ++m)
#pragma unroll
                    for (int j = 0; j < 4; ++j) {
                        const int row = brow + ai * 128 + wr * 64 + m * 16 + fq * 4 + j;
                        float ss = 0.f;
#pragma unroll
                        for (int bj = 0; bj < 2; ++bj) {
                            const float v0 = acc[ai][bj][m][0][j], v1 = acc[ai][bj][m][1][j];
                            ss = fmaf(v0, v0, ss); ss = fmaf(v1, v1, ss);
                            *(GAS unsigned*)(cq + ((size_t)g * T + row) * 512 + tg * 256 + bj * 128 + wc * 32 + 2 * fr) = cvtpk(v0, v1);
                        }
                        ss += swz_xor<1>(ss); ss += swz_xor<2>(ss); ss += swz_xor<4>(ss); ss += swz_xor<8>(ss);
                        if (fr == 0) *(GAS float*)(ssq + ((size_t)g * T + row) * 8 + tg * 4 + wc) = ss;
                    }
        } else if (bcol < 3072) {
            const int g2 = (bcol - 1024) >> 10, vh0 = ((bcol - 1024) & 1023) >> 7, i = wc * 16 + fr;
            bf16_t* dst = att + 2 * MHSZ + EHSZ + (size_t)g2 * EHSZ;
#pragma unroll
            for (int ai = 0; ai < 2; ++ai)
#pragma unroll
                for (int m = 0; m < 4; ++m)
#pragma unroll
                    for (int j = 0; j < 4; ++j) {
                        const int sq = (brow & 4095) + ai * 128 + wr * 64 + m * 16 + fq * 4 + j;
                        const float2 cs = r128[sq * 64 + i];
#pragma unroll
                        for (int bj = 0; bj < 2; ++bj) {
                            const float x1 = acc[ai][bj][m][0][j], x2 = acc[ai][bj][m][1][j];
                            GAS bf16_t* p = (GAS bf16_t*)(dst + ((size_t)(b * 8 + vh0 + bj) * S + sq) * 128);
                            p[i] = f2bf(x1 * cs.x - x2 * cs.y); p[64 + i] = f2bf(x2 * cs.x + x1 * cs.y);
                        }
                    }
        } else {
            const int c0 = bcol - 3072, hd = c0 >> 8;
            bf16_t* dst = att + 2 * MHSZ + 3 * EHSZ;
            vt_store_lds<0, 2>(acc, brow, wr, wc, fr, fq, nullptr, dst + ((size_t)(b * 4 + hd) * 256 + (c0 & 255)) * S + (brow & 4095));
        }
    }
};
__device__ __forceinline__ float rstd_from_ssq(const float* __restrict__ ssq, int row) {
    const f32x4 a = *(const GAS f32x4*)(ssq + (size_t)row * 8), c = *(const GAS f32x4*)(ssq + (size_t)row * 8 + 4);
    return rsqrtf(((a[0] + a[1]) + (a[2] + a[3]) + (c[0] + c[1]) + (c[2] + c[3])) * (1.f / 512.f) + RMS_EPS);
}
struct EpiUq {
    const float* ssq; bf16_t* qm; const float2* r64;
    __device__ __forceinline__ void operator()(const f32x4 (&acc)[2][2][4][2], int brow, int bcol, int wr, int wc, int fr, int fq) const {
        const int b = brow >> 12;
#pragma unroll
        for (int ai = 0; ai < 2; ++ai)
#pragma unroll
            for (int m = 0; m < 4; ++m)
#pragma unroll
                for (int j = 0; j < 4; ++j) {
                    const int row = brow + ai * 128 + wr * 64 + m * 16 + fq * 4 + j, sq = row & 4095;
                    const float rs = rstd_from_ssq(ssq, row);
                    if (bcol < 1024) {
#pragma unroll
                        for (int bj = 0; bj < 2; ++bj)
                            *(GAS unsigned*)(qm + ((size_t)(b * 8 + (bcol >> 7) + bj) * S + sq) * 192 + wc * 32 + 2 * fr) = cvtpk(acc[ai][bj][m][0][j] * rs, acc[ai][bj][m][1][j] * rs);
                    } else {
                        const int i = (wc & 1) * 16 + fr;
                        const float2 cs = r64[sq * 32 + i];
#pragma unroll
                        for (int bj = 0; bj < 2; ++bj) {
                            const int head = ((bcol - 1024) >> 8) * 4 + bj * 2 + (wc >> 1);
                            const float x1 = acc[ai][bj][m][0][j] * rs, x2 = acc[ai][bj][m][1][j] * rs;
                            GAS bf16_t* p = (GAS bf16_t*)(qm + ((size_t)(b * 8 + head) * S + sq) * 192 + 128);
                            p[i] = f2bf(x1 * cs.x - x2 * cs.y); p[32 + i] = f2bf(x2 * cs.x + x1 * cs.y);
                        }
                    }
                }
    }
};
struct EpiUkv {
    const float* ssq; bf16_t* km; bf16_t* vtm;
    __device__ __forceinline__ void operator()(const f32x4 (&acc)[2][2][4][2], int brow, int bcol, int wr, int wc, int fr, int fq) const {
        const int b = brow >> 12, head = bcol >> 8;
#pragma unroll
        for (int ai = 0; ai < 2; ++ai)
#pragma unroll
            for (int m = 0; m < 4; ++m) {
                const int row0 = brow + ai * 128 + wr * 64 + m * 16 + fq * 4, s0 = row0 & 4095;
                float rs[4];
#pragma unroll
                for (int j = 0; j < 4; ++j) rs[j] = rstd_from_ssq(ssq, row0 + j);
#pragma unroll
                for (int j = 0; j < 4; ++j)
                    *(GAS unsigned*)(km + ((size_t)(b * 8 + head) * S + s0 + j) * 192 + wc * 32 + 2 * fr) = cvtpk(acc[ai][0][m][0][j] * rs[j], acc[ai][0][m][1][j] * rs[j]);
            }
        vt_store_lds<1, 2>(acc, brow, wr, wc, fr, fq, ssq, vtm + ((size_t)(b * 8 + head) * 128) * S + (brow & 4095));
    }
};
__device__ __forceinline__ void kpe_finish(const float* __restrict__ KPE, const float2* __restrict__ R64, bf16_t* __restrict__ km) {
    const int tid_ = opaque_tid(); const int wave = tid_ >> 6, lane = tid_ & 63;
    for (int row = blockIdx.x * 8 + wave; row < T; row += NBLK * 8) {
        const int sq = row & 4095, b = row >> 12, i = lane & 31;
        const float2 cs = R64[sq * 32 + i];
        const float x1 = KPE[(size_t)row * 64 + i], x2 = KPE[(size_t)row * 64 + 32 + i];
        const bf16_t o = (lane < 32) ? f2bf(x1 * cs.x - x2 * cs.y) : f2bf(x2 * cs.x + x1 * cs.y);
#pragma unroll
        for (int h = 0; h < 8; ++h) km[((size_t)(b * 8 + h) * S + sq) * 192 + 128 + lane] = o;
    }
}

typedef __bf16 bf16x2_t __attribute__((ext_vector_type(2)));
__device__ __forceinline__ float dot2bf(unsigned w, unsigned x, float acc) { return __builtin_amdgcn_fdot2_f32_bf16(__builtin_bit_cast(bf16x2_t, w), __builtin_bit_cast(bf16x2_t, x), acc, false); }
template <int DK, int MODE, bool OUTF32>
__device__ __forceinline__ void attn_item(const bf16_t* __restrict__ Qh, const bf16_t* __restrict__ Kh, const bf16_t* __restrict__ Vth,
                                          void* __restrict__ outp, int out_ld, int q0,
                                          const float* __restrict__ cumh, const float* __restrict__ relb, float sc2) {
    extern __shared__ __attribute__((aligned(16))) unsigned char a_lds[];
    constexpr int KP = DK * 2 + 16, KBUF = 64 * KP, VP = 136, VBUF = 128 * VP;
    constexpr int OFF_V = 2 * 25600, OFF_CK = OFF_V + 2 * VBUF, OFF_RB = OFF_CK + 512;
    constexpr int NKS = DK / 16, KCH = DK / 8, NKL = (64 * KCH) / NTHR;
    const int tid = opaque_tid(), wave = tid >> 6, lane = tid & 63, c = lane & 31, hi = lane >> 5;
    const int rg = wave >> 1, kh = wave & 1;
    const int qw0 = q0 + 32 * rg, qrow = qw0 + c, cw = qw0 >> 6;
    int t_lo = 0;
    if (MODE == 1) { t_lo = (q0 >> 6) - 8; if (t_lo < 0) t_lo = 0; }
    const int t_hi = ((q0 + 127) >> 6) + 1;
    bf16x8 qf[NKS];
#pragma unroll
    for (int s = 0; s < NKS; ++s) qf[s] = *(const bf16x8*)(Qh + (size_t)qrow * DK + 16 * s + 8 * hi);
    float cq = 0.f;
    if (MODE == 0) cq = cumh[qrow];
#pragma unroll
    for (int s = 0; s < NKS; ++s) asm volatile("" : "+v"(qf[s]));
    asm volatile("" : "+v"(cq));
    if (MODE == 1) { for (int i = tid; i < 257; i += NTHR) ((float*)(a_lds + OFF_RB))[i] = relb[i] * LOG2E; }
    float cso = 0.f;
    const float* offs = (const float*)(a_lds + OFF_RB);
    if (MODE == 0) {
        if (wave == 0) {
            const float v0 = relb[lane], v1 = relb[64 + lane];
            float s0 = v0, s1 = v1;
#pragma unroll
            for (int d_ = 1; d_ < 64; d_ <<= 1) {
                const float t0 = __int_as_float(__builtin_amdgcn_ds_bpermute((lane - d_) * 4, __float_as_int(s0)));
                const float t1 = __int_as_float(__builtin_amdgcn_ds_bpermute((lane - d_) * 4, __float_as_int(s1)));
                if (lane >= d_) { s0 += t0; s1 += t1; }
            }
            const float tot0 = __int_as_float(__builtin_amdgcn_readlane(__float_as_int(s0), 63));
            ((float*)(a_lds + OFF_RB))[lane] = s0 - v0; ((float*)(a_lds + OFF_RB))[64 + lane] = s1 - v1 + tot0;
        }
        __syncthreads();
        cq += offs[qrow >> 5];
    }
    u32x4 kst0, kst1, kst2 = u32x4{0u, 0u, 0u, 0u}, vst0, vst1; f32x4 cst = f32x4{0.f, 0.f, 0.f, 0.f};
    const int kr0 = tid / KCH, kc0 = tid % KCH, kr1 = (tid + NTHR) / KCH, kc1 = (tid + NTHR) % KCH, kr2 = (tid + 2 * NTHR) / KCH, kc2 = (tid + 2 * NTHR) % KCH;
    const int vd0 = tid >> 3, vc0 = tid & 7, vd1 = vd0 + 64;
    const GAS bf16_t* Kg = (const GAS bf16_t*)Kh; const GAS bf16_t* Vg = (const GAS bf16_t*)Vth; const GAS float* cumg = (const GAS float*)cumh;
#define A_ISSUE(tt) do { const int key0_ = 64 * (tt); \
        kst0 = *(const GAS u32x4*)(Kg + (size_t)(key0_ + kr0) * DK + kc0 * 8); \
        kst1 = *(const GAS u32x4*)(Kg + (size_t)(key0_ + kr1) * DK + kc1 * 8); \
        if (NKL == 3) kst2 = *(const GAS u32x4*)(Kg + (size_t)(key0_ + kr2) * DK + kc2 * 8); \
        vst0 = *(const GAS u32x4*)(Vg + (size_t)vd0 * S + key0_ + vc0 * 8); \
        vst1 = *(const GAS u32x4*)(Vg + (size_t)vd1 * S + key0_ + vc0 * 8); \
        if (MODE == 0) { if (tid < 16) { cst = *(const GAS f32x4*)(cumg + key0_ + 4 * tid); cso = offs[(key0_ + 4 * tid) >> 5]; } } } while (0)
#define A_WRITE(bf) do { \
        *(u32x4*)(a_lds + (bf) * KBUF + kr0 * KP + kc0 * 16) = kst0; \
        *(u32x4*)(a_lds + (bf) * KBUF + kr1 * KP + kc1 * 16) = kst1; \
        if (NKL == 3) *(u32x4*)(a_lds + (bf) * KBUF + kr2 * KP + kc2 * 16) = kst2; \
        { unsigned char* vp_ = a_lds + OFF_V + (bf) * VBUF + vd0 * VP + vc0 * 16; *(u32x2*)vp_ = u32x2{vst0[0], vst0[1]}; *(u32x2*)(vp_ + 8) = u32x2{vst0[2], vst0[3]}; } \
        { unsigned char* vp_ = a_lds + OFF_V + (bf) * VBUF + vd1 * VP + vc0 * 16; *(u32x2*)vp_ = u32x2{vst1[0], vst1[1]}; *(u32x2*)(vp_ + 8) = u32x2{vst1[2], vst1[3]}; } \
        if (MODE == 0) { if (tid < 16) *(f32x4*)(a_lds + OFF_CK + (bf) * 256 + tid * 16) = f32x4{cst[0] + cso, cst[1] + cso, cst[2] + cso, cst[3] + cso}; } } while (0)
    A_ISSUE(t_lo); A_WRITE(0);
    __syncthreads();
    float m = -1e30f, l = 0.f;
    f32x16 o[4];
#pragma unroll
    for (int db = 0; db < 4; ++db)
#pragma unroll
        for (int r = 0; r < 16; ++r) o[db][r] = 0.f;
    const float NEGINF = -__builtin_inff();
    for (int t = t_lo; t < t_hi; ++t) {
        const int cur = (t - t_lo) & 1;
        if (t + 1 < t_hi) A_ISSUE(t + 1);
        bool act;
        if (MODE == 0) act = (64 * t + 32 * kh) <= (qw0 + 31);
        else if (MODE == 1) act = (t <= cw) && (t >= cw - 8);
        else act = (t <= cw);
        if (act) {
            f32x16 p;
#pragma unroll
            for (int r = 0; r < 16; ++r) p[r] = 0.f;
            const unsigned char* kb = a_lds + cur * KBUF + (32 * kh + c) * KP + hi * 16;
            constexpr bool HOISTK = true;
            bf16x8 kf[NKS];
            if (HOISTK) {
#pragma unroll
                for (int s = 0; s < NKS; ++s) kf[s] = *(const bf16x8*)(kb + s * 32);
            }
            const unsigned char* vb = a_lds + OFF_V + cur * VBUF + c * VP + (32 * kh + 4 * hi) * 2;
            bf16x8 vf[8];
#define A_VREADS(D0, D1) do { _Pragma("unroll") for (int dq_ = (D0); dq_ < (D1); ++dq_) _Pragma("unroll") for (int s2 = 0; s2 < 2; ++s2) { \
                    const uint2 v0 = *(const uint2*)(vb + dq_ * 32 * VP + s2 * 32), v1 = *(const uint2*)(vb + dq_ * 32 * VP + s2 * 32 + 16); \
                    const uint4 u = make_uint4(v0.x, v0.y, v1.x, v1.y); vf[2 * dq_ + s2] = *reinterpret_cast<const bf16x8*>(&u); } } while (0)
            constexpr bool HOISTV = (DK == 128) && (MODE == 2 || MODE == 1);
            if (HOISTV) A_VREADS(0, 3);
            if (HOISTK) __builtin_amdgcn_sched_barrier(0);
            __builtin_amdgcn_s_setprio(1);
#pragma unroll
            for (int s = 0; s < NKS; ++s) p = __builtin_amdgcn_mfma_f32_32x32x16_bf16(HOISTK ? kf[s] : *(const bf16x8*)(kb + s * 32), qf[s], p, 0, 0, 0);
            __builtin_amdgcn_s_setprio(0);
            if (HOISTV) { A_VREADS(3, 4); __builtin_amdgcn_sched_barrier(0); }
            if (MODE == 0) {
                const float* ckp = (const float*)(a_lds + OFF_CK + cur * 256) + 32 * kh + 4 * hi;
#pragma unroll
                for (int g = 0; g < 4; ++g) {
                    const float4 ck = *(const float4*)(ckp + 8 * g);
                    p[4 * g + 0] = fmaf(p[4 * g + 0], sc2, cq - ck.x); p[4 * g + 1] = fmaf(p[4 * g + 1], sc2, cq - ck.y);
                    p[4 * g + 2] = fmaf(p[4 * g + 2], sc2, cq - ck.z); p[4 * g + 3] = fmaf(p[4 * g + 3], sc2, cq - ck.w);
                }
                if (64 * t + 32 * kh + 31 > qw0) {
                    const int kbase = 64 * t + 32 * kh + 4 * hi;
#pragma unroll
                    for (int r = 0; r < 16; ++r) if (kbase + (r & 3) + 8 * (r >> 2) > qrow) p[r] = NEGINF;
                }
            } else if (MODE == 1) {
                const float* rb = (const float*)(a_lds + OFF_RB);
                if (t <= cw - 3) {
                    const float bb = rb[256];
#pragma unroll
                    for (int r = 0; r < 16; ++r) p[r] = fmaf(p[r], sc2, bb);
                } else {
                    const int kbase = 64 * t + 32 * kh + 4 * hi;
#pragma unroll
                    for (int r = 0; r < 16; ++r) { int rel = qrow - (kbase + (r & 3) + 8 * (r >> 2)); rel = rel > 128 ? 128 : rel; p[r] = fmaf(p[r], sc2, rb[rel + 128]); }
                }
            }
            float mx = p[0];
#pragma unroll
            for (int r = 1; r < 16; ++r) mx = fmaxf(mx, p[r]);
            if (MODE == 2) mx *= sc2;
            { auto rr = __builtin_amdgcn_permlane32_swap(__float_as_uint(mx), __float_as_uint(mx), false, false); mx = fmaxf(__uint_as_float(rr[0]), __uint_as_float(rr[1])); }
            if (!__all(mx - m <= 8.f)) {
                const float mn = fmaxf(m, mx), alpha = __builtin_amdgcn_exp2f(m - mn);
                m = mn; l *= alpha;
#pragma unroll
                for (int db = 0; db < 4; ++db)
#pragma unroll
                    for (int r = 0; r < 16; ++r) o[db][r] *= alpha;
            }
#pragma unroll
            for (int r = 0; r < 16; ++r) p[r] = __builtin_amdgcn_exp2f((MODE == 2) ? fmaf(p[r], sc2, -m) : (p[r] - m));
            bf16x8 pb0, pb1;
            { const unsigned w0 = cvtpk(p[0], p[1]), w1 = cvtpk(p[2], p[3]), w2 = cvtpk(p[4], p[5]), w3 = cvtpk(p[6], p[7]);
              const uint4 u = make_uint4(w0, w1, w2, w3); pb0 = *reinterpret_cast<const bf16x8*>(&u); }
            { const unsigned w0 = cvtpk(p[8], p[9]), w1 = cvtpk(p[10], p[11]), w2 = cvtpk(p[12], p[13]), w3 = cvtpk(p[14], p[15]);
              const uint4 u = make_uint4(w0, w1, w2, w3); pb1 = *reinterpret_cast<const bf16x8*>(&u); }
            {
                const uint4 ua = *reinterpret_cast<const uint4*>(&pb0), ub = *reinterpret_cast<const uint4*>(&pb1);
                float ps = 0.f, ps2 = 0.f;
                ps = dot2bf(ua.x, 0x3f803f80u, ps); ps2 = dot2bf(ua.y, 0x3f803f80u, ps2); ps = dot2bf(ua.z, 0x3f803f80u, ps); ps2 = dot2bf(ua.w, 0x3f803f80u, ps2);
                ps = dot2bf(ub.x, 0x3f803f80u, ps); ps2 = dot2bf(ub.y, 0x3f803f80u, ps2); ps = dot2bf(ub.z, 0x3f803f80u, ps); ps2 = dot2bf(ub.w, 0x3f803f80u, ps2);
                l += ps + ps2;
            }
            if (HOISTK && !HOISTV) A_VREADS(0, 4);
            if (HOISTK) __builtin_amdgcn_sched_barrier(0);
            __builtin_amdgcn_s_setprio(1);
#pragma unroll
            for (int db = 0; db < 4; ++db) {
                if (!HOISTK) { A_VREADS(db, db + 1); }
                o[db] = __builtin_amdgcn_mfma_f32_32x32x16_bf16(vf[2 * db], pb0, o[db], 0, 0, 0);
                o[db] = __builtin_amdgcn_mfma_f32_32x32x16_bf16(vf[2 * db + 1], pb1, o[db], 0, 0, 0);
            }
            __builtin_amdgcn_s_setprio(0);
#undef A_VREADS
        }
        if (t + 1 < t_hi) A_WRITE(cur ^ 1);
        __syncthreads();
    }
#undef A_ISSUE
#undef A_WRITE
    { auto rr = __builtin_amdgcn_permlane32_swap(__float_as_uint(l), __float_as_uint(l), false, false); l = __uint_as_float(rr[0]) + __uint_as_float(rr[1]); }
    float* xo = (float*)a_lds + wave * 2176;
    if (kh == 0) {
#pragma unroll
        for (int r = 0; r < 16; ++r) { xo[r * 64 + lane] = o[2][r]; xo[(16 + r) * 64 + lane] = o[3][r]; }
    } else {
#pragma unroll
        for (int r = 0; r < 16; ++r) { xo[r * 64 + lane] = o[0][r]; xo[(16 + r) * 64 + lane] = o[1][r]; }
    }
    xo[2048 + lane] = m; xo[2112 + lane] = l;
    __syncthreads();
    const float* xp = (const float*)a_lds + (wave ^ 1) * 2176;
    const float mp = xp[2048 + lane], lp = xp[2112 + lane];
    const float M = fmaxf(m, mp), ea = __builtin_amdgcn_exp2f(m - M), eb = __builtin_amdgcn_exp2f(mp - M);
    const float inv = 1.f / (l * ea + lp * eb), fa = ea * inv, fb = eb * inv;
#define A_OUT(OA, OB, dbase) do { \
        _Pragma("unroll") for (int x_ = 0; x_ < 2; ++x_) { \
            _Pragma("unroll") for (int g_ = 0; g_ < 4; ++g_) { \
                float v_[4]; \
                _Pragma("unroll") for (int e_ = 0; e_ < 4; ++e_) { const int r_ = 4 * g_ + e_; v_[e_] = (x_ ? OB[r_] : OA[r_]) * fa + xp[(x_ * 16 + r_) * 64 + lane] * fb; } \
                const int d_ = (dbase + x_) * 32 + 8 * g_ + 4 * hi; \
                if (OUTF32) *(GAS f32x4*)((float*)outp + (size_t)qrow * out_ld + d_) = f32x4{v_[0], v_[1], v_[2], v_[3]}; \
                else *(GAS u32x2*)((bf16_t*)outp + (size_t)qrow * out_ld + d_) = u32x2{cvtpk(v_[0], v_[1]), cvtpk(v_[2], v_[3])}; } } } while (0)
    if (kh == 0) A_OUT(o[0], o[1], 0); else A_OUT(o[2], o[3], 2);
#undef A_OUT
    __syncthreads();
}

template <int MODE>
__device__ __forceinline__ void attn_naive_b(const bf16_t* __restrict__ Qh, const bf16_t* __restrict__ Kh, const bf16_t* __restrict__ Vth, int dk,
                                             float* __restrict__ Of, bf16_t* __restrict__ Ob, int ldo, int t8,
                                             const float* __restrict__ cumh, const float* __restrict__ relb, float sc2, float* lds) {
    const int tid_ = opaque_tid(); const int wave = tid_ >> 6, lane = tid_ & 63;
    float* qs = lds + wave * 4352;
    float* sc = qs + 256;
    const int t = t8 * 8 + wave;
    for (int d = lane; d < dk; d += 64) qs[d] = bf2f(Qh[(size_t)t * dk + d]);
    int klo, khi;
    if (MODE == 0) { klo = 0; khi = t + 1; }
    else if (MODE == 1) { const int c = t >> 6; klo = (c - 8) * 64; if (klo < 0) klo = 0; khi = (c + 1) * 64; }
    else { klo = 0; khi = ((t >> 6) + 1) * 64; }
    __syncthreads();
    float mx = -3e38f;
    const float cq = (MODE == 0) ? cumh[t] : 0.f;
    for (int s = klo + lane; s < khi; s += 64) {
        const bf16_t* kp = Kh + (size_t)s * dk;
        float a = 0.f;
        for (int d = 0; d < dk; d += 8) {
            const uint4 kv = *(const uint4*)(kp + d);
            a = fmaf(qs[d], __uint_as_float(kv.x << 16), a); a = fmaf(qs[d + 1], __uint_as_float(kv.x & 0xffff0000u), a);
            a = fmaf(qs[d + 2], __uint_as_float(kv.y << 16), a); a = fmaf(qs[d + 3], __uint_as_float(kv.y & 0xffff0000u), a);
            a = fmaf(qs[d + 4], __uint_as_float(kv.z << 16), a); a = fmaf(qs[d + 5], __uint_as_float(kv.z & 0xffff0000u), a);
            a = fmaf(qs[d + 6], __uint_as_float(kv.w << 16), a); a = fmaf(qs[d + 7], __uint_as_float(kv.w & 0xffff0000u), a);
        }
        a *= sc2;
        if (MODE == 0) a += cq - cumh[s];
        if (MODE == 1) { int rel = t - s; rel = rel < -128 ? -128 : (rel > 128 ? 128 : rel); a += relb[rel + 128] * LOG2E; }
        sc[s - klo] = a; mx = fmaxf(mx, a);
    }
    mx = wmaxf(mx);
    float sum = 0.f;
    for (int s = klo + lane; s < khi; s += 64) { const float p = exp2f(sc[s - klo] - mx); sc[s - klo] = p; sum += p; }
    sum = wsum(sum);
    const float inv = 1.f / sum;
    __syncthreads();
    for (int d0 = 0; d0 < 128; d0 += 64) {
        const int d = d0 + lane;
        const bf16_t* vp = Vth + (size_t)d * S;
        float a0 = 0.f, a1 = 0.f;
        int s = klo;
        for (; s + 1 < khi; s += 2) { a0 = fmaf(sc[s - klo], bf2f(vp[s]), a0); a1 = fmaf(sc[s + 1 - klo], bf2f(vp[s + 1]), a1); }
        for (; s < khi; ++s) a0 = fmaf(sc[s - klo], bf2f(vp[s]), a0);
        const float ov = (a0 + a1) * inv;
        if (Ob) Ob[(size_t)t * ldo + d] = f2bf(ov); else Of[(size_t)t * ldo + d] = ov;
    }
    __syncthreads();
}

template <bool NAIVE>
__device__ __forceinline__ void attn_even_phase(const bf16_t* __restrict__ att, const float* __restrict__ cumh, const float* __restrict__ relb,
                                                bf16_t* __restrict__ Ob, unsigned* ctr, float* lds, const float* __restrict__ tot) {
    extern __shared__ __attribute__((aligned(16))) unsigned char ae_lds[];
    volatile int* slot = (volatile int*)(ae_lds + 140 * 1024);
    constexpr float SC2 = 0.08838834764831845f * LOG2E;
    if (NAIVE) {
        for (int item = blockIdx.x; item < 2 * 16 * (S / 8); item += NBLK) {
            const int kind = item / (16 * (S / 8)), r = item % (16 * (S / 8)), bh = r / (S / 8), t8 = r % (S / 8), b = bh >> 3, h = bh & 7;
            if (kind == 0) attn_naive_b<0>(att + (size_t)bh * S * 128, att + EHSZ + (size_t)bh * S * 128, att + 2 * EHSZ + (size_t)bh * 128 * S, 128,
                                           nullptr, Ob + (size_t)b * S * D + h * 128, D, t8, cumh + (size_t)bh * S, nullptr, SC2, lds);
            else attn_naive_b<1>(att + 3 * EHSZ + (size_t)bh * S * 128, att + 4 * EHSZ + (size_t)bh * S * 128, att + 5 * EHSZ + (size_t)bh * 128 * S, 128,
                                 nullptr, Ob + (size_t)b * S * D + 1024 + h * 128, D, t8, nullptr, relb + h * 257, SC2, lds);
        }
    } else {
        int item = blockIdx.x;
        while (item < 1024) {
            if (item < 512) {
                const int j = 31 - (item >> 4), bh = item & 15, b = bh >> 3, h = bh & 7;
                attn_item<128, 0, false>(att + (size_t)bh * S * 128, att + EHSZ + (size_t)bh * S * 128, att + 2 * EHSZ + (size_t)bh * 128 * S,
                                         Ob + (size_t)b * S * D + h * 128, D, j * 128, cumh + (size_t)bh * S, tot + bh * 128, SC2);
            } else {
                const int r = item - 512, j = r >> 4, bh = r & 15, b = bh >> 3, h = bh & 7;
                attn_item<128, 1, false>(att + 3 * EHSZ + (size_t)bh * S * 128, att + 4 * EHSZ + (size_t)bh * S * 128, att + 5 * EHSZ + (size_t)bh * 128 * S,
                                         Ob + (size_t)b * S * D + 1024 + h * 128, D, j * 128, nullptr, relb + h * 257, SC2);
            }
            if (opaque_tid() == 0) *slot = NBLK + (int)atomicAdd(ctr, 1u);
            __syncthreads();
            item = *slot;
        }
    }
}

__device__ __forceinline__ void attn_odd_phase(const bf16_t* __restrict__ att, bf16_t* __restrict__ Ob, float* __restrict__ A12, unsigned* ctr) {
    extern __shared__ __attribute__((aligned(16))) unsigned char ao_lds[];
    volatile int* slot = (volatile int*)(ao_lds + 140 * 1024);
    constexpr float SC128 = 0.08838834764831845f * LOG2E, SC192 = 0.07216878364870323f * LOG2E;
    int item = blockIdx.x;
    while (item < 48 * 32) {
        const int j = 31 - item / 48, r = item % 48;
        if (r < 16) {
            const int bh = r, b = bh >> 3, h = bh & 7;
            attn_item<192, 2, false>(att + (size_t)bh * S * 192, att + MHSZ + (size_t)bh * S * 192, att + 2 * MHSZ + (size_t)bh * 128 * S,
                                     Ob + (size_t)b * S * D + h * 128, D, j * 128, nullptr, nullptr, SC192);
        } else {
            const int v = r - 16, b = v >> 4, vh2 = v & 15, vh = vh2 >> 1, half = vh2 & 1, hd = vh >> 1, comp = vh & 1;
            attn_item<128, 2, true>(att + 2 * MHSZ + EHSZ + (size_t)(b * 8 + vh) * S * 128, att + 2 * MHSZ + 2 * EHSZ + (size_t)(b * 8 + vh) * S * 128,
                                    att + 2 * MHSZ + 3 * EHSZ + ((size_t)(b * 4 + hd) * 256 + half * 128) * S,
                                    A12 + (size_t)b * S * D + hd * 512 + comp * 256 + half * 128, D, j * 128, nullptr, nullptr, SC128);
        }
        if (opaque_tid() == 0) *slot = NBLK + (int)atomicAdd(ctr, 1u);
        __syncthreads();
        item = *slot;
    }
}

__device__ __forceinline__ void cumsum_b(const float* __restrict__ GL, const float* __restrict__ bf, float* __restrict__ CUMH, float* lds) {
    const int tid = opaque_tid();
    for (int seq = blockIdx.x; seq < NB * 8; seq += NBLK) {
        const int b = seq >> 3, h = seq & 7;
        float v[8]; float run = 0.f;
#pragma unroll
        for (int i = 0; i < 8; ++i) {
            const int t = tid * 8 + i;
            const float z = GL[((size_t)b * S + t) * 8 + h] + bf[h];
            const float ls = fminf(z, 0.f) - log1pf(expf(-fabsf(z)));
            run += ls; v[i] = run;
        }
        float incl = run;
        lds[tid] = incl;
        __syncthreads();
#pragma unroll 1
        for (int d_ = 1; d_ < NTHR; d_ <<= 1) {
            const float add = (tid >= d_) ? lds[tid - d_] : 0.f;
            __syncthreads();
            incl += add; lds[tid] = incl;
            __syncthreads();
        }
        const float off = incl - run;
#pragma unroll
        for (int i = 0; i < 8; ++i) CUMH[(size_t)seq * S + tid * 8 + i] = (v[i] + off) * LOG2E;
        __syncthreads();
    }
}

__device__ __forceinline__ void copy_f4(const float* __restrict__ src, float* __restrict__ dst, size_t n) {
    const size_t n4 = n / 4;
    const int tid_ = opaque_tid();
    for (size_t i = (size_t)blockIdx.x * NTHR + tid_; i < n4; i += (size_t)NBLK * NTHR)
        ((float4*)dst)[i] = ((const float4*)src)[i];
}

__device__ __forceinline__ void copy_convert_f4(const float* __restrict__ src, float* __restrict__ dst, bf16_t* __restrict__ dstb, size_t n) {
    const size_t n4 = n / 4;
    const int tid_ = opaque_tid();
    for (size_t i = (size_t)blockIdx.x * NTHR + tid_; i < n4; i += (size_t)NBLK * NTHR) {
        const float4 v = ((const float4*)src)[i];
        ((float4*)dst)[i] = v;
        ((uint2*)dstb)[i] = make_uint2(cvtpk(v.x, v.y), cvtpk(v.z, v.w));
    }
}

__device__ __forceinline__ void rope_tables(float2* __restrict__ R128, float2* __restrict__ R64) {
    const int tid_ = opaque_tid();
    for (int e = blockIdx.x * NTHR + tid_; e < S * 96; e += NBLK * NTHR) {
        const int t = e / 96, j = e % 96;
        const bool big = j < 64;
        const int i = big ? j : j - 64;
        const double inv = pow(10000.0, -(2.0 * i) / (big ? 128.0 : 64.0)), ang = (double)t * inv;
        const float2 cs = make_float2((float)cos(ang), (float)sin(ang));
        if (big) R128[t * 64 + i] = cs; else R64[t * 32 + i] = cs;
    }
}

__device__ __forceinline__ void gemm_naive(const float* __restrict__ A, int lda, const float* __restrict__ W, int ldw,
                           float* __restrict__ C, int ldc, int M, int N, int K, float* lds) {
    float* As = lds;
    float* Bs = lds + 16 * 132;
    const int tid = opaque_tid(), ty = tid >> 5, tx = tid & 31;
    const int ntn = (N + 127) / 128, ntiles = (M / 128) * ntn;
    for (int tile = blockIdx.x; tile < ntiles; tile += NBLK) {
        const int m0 = (tile / ntn) * 128, n0 = (tile % ntn) * 128;
        float acc[8][4];
#pragma unroll
        for (int i = 0; i < 8; ++i)
#pragma unroll
            for (int j = 0; j < 4; ++j) acc[i][j] = 0.f;
        for (int k0 = 0; k0 < K; k0 += 16) {
            {
                const int r = tid >> 2, kq = (tid & 3) * 4;
                const float4 a = *(const float4*)(A + (size_t)(m0 + r) * lda + k0 + kq);
                As[(kq + 0) * 132 + r] = a.x; As[(kq + 1) * 132 + r] = a.y; As[(kq + 2) * 132 + r] = a.z; As[(kq + 3) * 132 + r] = a.w;
            }
            {
                const int k = tid >> 5, n = (tid & 31) * 4;
                float4 b = make_float4(0.f, 0.f, 0.f, 0.f);
                if (n0 + n < N) b = *(const float4*)(W + (size_t)(k0 + k) * ldw + n0 + n);
                *(float4*)(Bs + k * 128 + n) = b;
            }
            __syncthreads();
#pragma unroll
            for (int k = 0; k < 16; ++k) {
                const float4 a0 = *(const float4*)(As + k * 132 + ty * 8), a1 = *(const float4*)(As + k * 132 + ty * 8 + 4);
                const float4 b = *(const float4*)(Bs + k * 128 + tx * 4);
                const float av[8] = {a0.x, a0.y, a0.z, a0.w, a1.x, a1.y, a1.z, a1.w};
                const float bv[4] = {b.x, b.y, b.z, b.w};
#pragma unroll
                for (int i = 0; i < 8; ++i)
#pragma unroll
                    for (int j = 0; j < 4; ++j) acc[i][j] = fmaf(av[i], bv[j], acc[i][j]);
            }
            __syncthreads();
        }
        if (n0 + tx * 4 < N) {
#pragma unroll
            for (int i = 0; i < 8; ++i)
                *(float4*)(C + (size_t)(m0 + ty * 8 + i) * ldc + n0 + tx * 4) = make_float4(acc[i][0], acc[i][1], acc[i][2], acc[i][3]);
        }
    }
}

__device__ __forceinline__ void cumsum_naive(const float* __restrict__ P, const float* __restrict__ bf, float* __restrict__ CUM, float* lds) {
    const int tid = opaque_tid();
    for (int seq = blockIdx.x; seq < NB * 8; seq += NBLK) {
        const int b = seq >> 3, h = seq & 7;
        float v[8]; float run = 0.f;
#pragma unroll
        for (int i = 0; i < 8; ++i) {
            const int t = tid * 8 + i;
            const float z = P[((size_t)b * S + t) * NEV + 3072 + h] + bf[h];
            const float ls = fminf(z, 0.f) - log1pf(expf(-fabsf(z)));
            run += ls; v[i] = run;
        }
        lds[tid] = run;
        __syncthreads();
        if (tid == 0) { float a = 0.f; for (int i = 0; i < NTHR; ++i) { const float x = lds[i]; lds[i] = a; a += x; } }
        __syncthreads();
        const float off = lds[tid];
#pragma unroll
        for (int i = 0; i < 8; ++i) CUM[((size_t)b * S + tid * 8 + i) * 8 + h] = v[i] + off;
        __syncthreads();
    }
}

template <int MODE>
__device__ __forceinline__ void attn_naive(const float* __restrict__ Q, int ldq, int qoff, int qhs,
                           const float* __restrict__ K1, int ldk1, int k1off, int k1hs, int dk1,
                           const float* __restrict__ K2, int ldk2, int k2off, int dk2,
                           const float* __restrict__ V, int ldv, int voff, int vhs, int vshift, int dv,
                           float* __restrict__ O, bf16_t* __restrict__ Ob, int ldo, int ooff, int ohs,
                           float scale, int nheads, const float* __restrict__ cum, const float* __restrict__ relb, float* lds) {
    const int tid_ = opaque_tid(); const int wave = tid_ >> 6, lane = tid_ & 63;
    float* qs = lds + wave * 4352;
    float* sc = qs + 256;
    const int nitems = nheads * NB * (S / 8);
    for (int item = blockIdx.x; item < nitems; item += NBLK) {
        const int t8 = item % (S / 8), bh = item / (S / 8), h = bh % nheads, b = bh / nheads;
        const int t = t8 * 8 + wave;
        const size_t row = (size_t)b * S + t;
        const float* qp = Q + row * ldq + qoff + h * qhs;
        for (int d = lane; d < dk1 + dk2; d += 64) qs[d] = qp[d];
        int klo, khi;
        if (MODE == 0) { klo = 0; khi = t + 1; }
        else if (MODE == 1) { const int c = t >> 6; klo = (c - 8) * 64; if (klo < 0) klo = 0; khi = (c + 1) * 64; }
        else { klo = 0; khi = ((t >> 6) + 1) * 64; }
        __syncthreads();
        float mx = -3e38f;
        const float cq = (MODE == 0) ? cum[row * 8 + h] : 0.f;
        for (int s = klo + lane; s < khi; s += 64) {
            const size_t krow = (size_t)b * S + s;
            const float* kp = K1 + krow * ldk1 + k1off + h * k1hs;
            float a = 0.f;
            for (int d = 0; d < dk1; d += 4) {
                const float4 kv = *(const float4*)(kp + d);
                a = fmaf(qs[d], kv.x, a); a = fmaf(qs[d + 1], kv.y, a); a = fmaf(qs[d + 2], kv.z, a); a = fmaf(qs[d + 3], kv.w, a);
            }
            if (dk2 > 0) {
                const float* kp2 = K2 + krow * ldk2 + k2off;
                for (int d = 0; d < dk2; d += 4) {
                    const float4 kv = *(const float4*)(kp2 + d);
                    a = fmaf(qs[dk1 + d], kv.x, a); a = fmaf(qs[dk1 + d + 1], kv.y, a); a = fmaf(qs[dk1 + d + 2], kv.z, a); a = fmaf(qs[dk1 + d + 3], kv.w, a);
                }
            }
            a *= scale;
            if (MODE == 0) a += cq - cum[krow * 8 + h];
            if (MODE == 1) { int rel = t - s; rel = rel < -128 ? -128 : (rel > 128 ? 128 : rel); a += relb[h * 257 + rel + 128]; }
            sc[s - klo] = a; mx = fmaxf(mx, a);
        }
        mx = wmaxf(mx);
        float sum = 0.f;
        for (int s = klo + lane; s < khi; s += 64) { const float p = expf(sc[s - klo] - mx); sc[s - klo] = p; sum += p; }
        sum = wsum(sum);
        const float inv = 1.f / sum;
        __syncthreads();
        const int vh = h >> vshift;
        for (int d0 = 0; d0 < dv; d0 += 64) {
            const int d = d0 + lane;
            const float* vp = V + (size_t)b * S * ldv + voff + vh * vhs + d;
            float a0 = 0.f, a1 = 0.f, a2 = 0.f, a3 = 0.f;
            int s = klo;
            for (; s + 3 < khi; s += 4) {
                a0 = fmaf(sc[s - klo], vp[(size_t)s * ldv], a0);
                a1 = fmaf(sc[s + 1 - klo], vp[(size_t)(s + 1) * ldv], a1);
                a2 = fmaf(sc[s + 2 - klo], vp[(size_t)(s + 2) * ldv], a2);
                a3 = fmaf(sc[s + 3 - klo], vp[(size_t)(s + 3) * ldv], a3);
            }
            for (; s < khi; ++s) a0 = fmaf(sc[s - klo], vp[(size_t)s * ldv], a0);
            const float ov = ((a0 + a1) + (a2 + a3)) * inv;
            if (Ob) Ob[row * ldo + ooff + h * ohs + d] = f2bf(ov); else O[row * ldo + ooff + h * ohs + d] = ov;
        }
        __syncthreads();
    }
}

__device__ __forceinline__ void ln_res_naive(const float* X, const float* __restrict__ Y, const float* __restrict__ g, const float* __restrict__ bb, float* dst, bf16_t* __restrict__ xb) {
    const int tid_ = opaque_tid(); const int wave = tid_ >> 6, lane = tid_ & 63;
    for (int row = blockIdx.x * 8 + wave; row < T; row += NBLK * 8) {
        float4 z[8]; float s = 0.f;
#pragma unroll
        for (int i = 0; i < 8; ++i) {
            const float4 x = ((const float4*)(X + (size_t)row * D))[i * 64 + lane];
            const float4 y = ((const float4*)(Y + (size_t)row * D))[i * 64 + lane];
            z[i] = make_float4(ALPHA * x.x + y.x, ALPHA * x.y + y.y, ALPHA * x.z + y.z, ALPHA * x.w + y.w);
            s += (z[i].x + z[i].y) + (z[i].z + z[i].w);
        }
        const float mu = wsum(s) * (1.f / D);
        float v = 0.f;
#pragma unroll
        for (int i = 0; i < 8; ++i) { const float a = z[i].x - mu, b = z[i].y - mu, c = z[i].z - mu, d = z[i].w - mu; v += (a * a + b * b) + (c * c + d * d); }
        const float rstd = rsqrtf(wsum(v) * (1.f / D) + LN_EPS);
#pragma unroll
        for (int i = 0; i < 8; ++i) {
            const float4 gg = ((const float4*)g)[i * 64 + lane], b4 = ((const float4*)bb)[i * 64 + lane];
            const float4 o4 = make_float4((z[i].x - mu) * rstd * gg.x + b4.x, (z[i].y - mu) * rstd * gg.y + b4.y,
                                          (z[i].z - mu) * rstd * gg.z + b4.z, (z[i].w - mu) * rstd * gg.w + b4.w);
            ((float4*)(dst + (size_t)row * D))[i * 64 + lane] = o4;
            ((uint2*)(xb + (size_t)row * D))[i * 64 + lane] = make_uint2(cvtpk(o4.x, o4.y), cvtpk(o4.z, o4.w));
        }
    }
}

__device__ __forceinline__ void odd_prep_naive(float* __restrict__ P, const float* __restrict__ gq, const float* __restrict__ gkv, const float2* __restrict__ R128, const float2* __restrict__ R64, bf16_t* __restrict__ CQb) {
    const int tid_ = opaque_tid(); const int wave = tid_ >> 6, lane = tid_ & 63;
    for (int row = blockIdx.x * 8 + wave; row < T; row += NBLK * 8) {
        float* p = P + (size_t)row * NOD;
        const int t = row % S;
        for (int part = 0; part < 2; ++part) {
            float* c = p + part * 512; const float* g = part ? gkv : gq;
            float v[8]; float ss = 0.f;
#pragma unroll
            for (int i = 0; i < 8; ++i) { v[i] = c[i * 64 + lane]; ss += v[i] * v[i]; }
            const float r = rsqrtf(wsum(ss) * (1.f / 512.f) + RMS_EPS);
#pragma unroll
            for (int i = 0; i < 8; ++i) CQb[((size_t)part * T + row) * 512 + i * 64 + lane] = f2bf(v[i] * r * g[i * 64 + lane]);
        }
        if (lane < 32) {
            const float2 cs = R64[t * 32 + lane];
            const float x1 = p[1024 + lane], x2 = p[1024 + 32 + lane];
            p[1024 + lane] = x1 * cs.x - x2 * cs.y; p[1024 + 32 + lane] = x2 * cs.x + x1 * cs.y;
        }
        {
            const float2 cs = R128[t * 64 + lane];
            for (int sl = 0; sl < 16; ++sl) {
                float* c = p + 1088 + sl * 128;
                const float x1 = c[lane], x2 = c[64 + lane];
                c[lane] = x1 * cs.x - x2 * cs.y; c[64 + lane] = x2 * cs.x + x1 * cs.y;
            }
        }
    }
}

__device__ __forceinline__ void q2_rope_naive(float* __restrict__ Q2, const float2* __restrict__ R64) {
    const int tid_ = opaque_tid(); const int wave = tid_ >> 6, lane = tid_ & 63;
    for (int row = blockIdx.x * 8 + wave; row < T; row += NBLK * 8) {
        const int t = row % S;
        const int i = lane & 31;
        const float2 cs = R64[t * 32 + i];
        for (int hh = 0; hh < 4; ++hh) {
            const int h = hh * 2 + (lane >> 5);
            float* c = Q2 + (size_t)row * 1536 + h * 192 + 128;
            const float x1 = c[i], x2 = c[32 + i];
            c[i] = x1 * cs.x - x2 * cs.y; c[32 + i] = x2 * cs.x + x1 * cs.y;
        }
    }
}

__device__ __forceinline__ void diff_combine_naive(const float* __restrict__ A12, const float* __restrict__ dl, const float* __restrict__ gs, float lam_init, bf16_t* __restrict__ O) {
    const int tid_ = opaque_tid(); const int wave = tid_ >> 6, lane = tid_ & 63;
    float s1 = dl[lane] * dl[128 + lane] + dl[64 + lane] * dl[128 + 64 + lane];
    float s2 = dl[256 + lane] * dl[384 + lane] + dl[256 + 64 + lane] * dl[384 + 64 + lane];
    s1 = wsum(s1); s2 = wsum(s2);
    const float lam = expf(s1) - expf(s2) + lam_init;
    float4 gsv = *(const float4*)(gs + lane * 4);
    gsv.x *= (1.f - lam_init); gsv.y *= (1.f - lam_init); gsv.z *= (1.f - lam_init); gsv.w *= (1.f - lam_init);
    for (int row = blockIdx.x * 8 + wave; row < T; row += NBLK * 8) {
        f32x4 a1[4], a2[4];
#pragma unroll
        for (int hd = 0; hd < 4; ++hd) {
            a1[hd] = *(const GAS f32x4*)((const GAS float*)A12 + (size_t)row * D + hd * 512 + lane * 4);
            a2[hd] = *(const GAS f32x4*)((const GAS float*)A12 + (size_t)row * D + hd * 512 + 256 + lane * 4);
        }
#pragma unroll
        for (int hd = 0; hd < 4; ++hd) {
            float d[4]; float ss = 0.f;
#pragma unroll
            for (int i = 0; i < 4; ++i) { d[i] = a1[hd][i] - lam * a2[hd][i]; ss += d[i] * d[i]; }
            const float r = rsqrtf(wsum(ss) * (1.f / 256.f) + RMS_EPS);
            *(GAS u32x2*)((GAS bf16_t*)O + (size_t)row * D + 1024 + hd * 256 + lane * 4) = u32x2{cvtpk(d[0] * r * gsv.x, d[1] * r * gsv.y), cvtpk(d[2] * r * gsv.z, d[3] * r * gsv.w)};
        }
    }
}

__device__ __forceinline__ void wargmax(float& v, int& ix) {
#define WAM_STEP(M) { const float ov = swz_xor<M>(v); const int oi = swz_xor_i<M>(ix); if (ov > v || (ov == v && oi < ix)) { v = ov; ix = oi; } }
    WAM_STEP(1) WAM_STEP(2) WAM_STEP(4) WAM_STEP(8) WAM_STEP(16)
#undef WAM_STEP
    {
        auto rv = __builtin_amdgcn_permlane32_swap(__float_as_uint(v), __float_as_uint(v), false, false);
        auto ri = __builtin_amdgcn_permlane32_swap((unsigned)ix, (unsigned)ix, false, false);
        const float v0 = __uint_as_float(rv[0]), v1 = __uint_as_float(rv[1]); const int i0 = (int)ri[0], i1 = (int)ri[1];
        if (v0 > v1 || (v0 == v1 && i0 < i1)) { v = v0; ix = i0; } else { v = v1; ix = i1; }
    }
}

__device__ __forceinline__ void route_naive(const float* __restrict__ PQ, const float* __restrict__ SK  , int* __restrict__ IDX, float* __restrict__ G, float* lds) {
    const int tid_ = opaque_tid(); const int wave = tid_ >> 6, lane = tid_ & 63;
    float* qs = lds + wave * 512;
    float* svs = qs + 256;
    int* sis = (int*)(qs + 288);
    const float NEG = -3.0e38f;
    for (int item = blockIdx.x * 8 + wave; item < T * 8; item += NBLK * 8) {
        const int tok = item >> 3, h = item & 7;
        const float* q = PQ + (size_t)tok * D + h * 256;
#pragma unroll
        for (int i = 0; i < 4; ++i) qs[i * 64 + lane] = q[i * 64 + lane];
        __syncthreads();
        for (int p = 0; p < 2; ++p) {
            const float* k0 = SK + ((size_t)(h * 2 + p) * 128 + lane) * 128;
            const float* k1 = k0 + 64 * 128;
            float v0 = 0.f, v1 = 0.f;
            for (int d = 0; d < 128; d += 4) {
                const float4 a = *(const float4*)(k0 + d), b = *(const float4*)(k1 + d);
                const float q0 = qs[p * 128 + d], q1 = qs[p * 128 + d + 1], q2 = qs[p * 128 + d + 2], q3 = qs[p * 128 + d + 3];
                v0 = fmaf(q0, a.x, v0); v0 = fmaf(q1, a.y, v0); v0 = fmaf(q2, a.z, v0); v0 = fmaf(q3, a.w, v0);
                v1 = fmaf(q0, b.x, v1); v1 = fmaf(q1, b.y, v1); v1 = fmaf(q2, b.z, v1); v1 = fmaf(q3, b.w, v1);
            }
            for (int r = 0; r < 16; ++r) {
                float bv; int bi;
                if (v0 >= v1) { bv = v0; bi = lane; } else { bv = v1; bi = lane + 64; }
                wargmax(bv, bi);
                if (bi == lane) v0 = NEG;
                if (bi == lane + 64) v1 = NEG;
                if (lane == 0) { svs[p * 16 + r] = bv; sis[p * 16 + r] = bi; }
            }
        }
        __syncthreads();
        float c[4];
#pragma unroll
        for (int j = 0; j < 4; ++j) { const int cc = lane + 64 * j; c[j] = svs[cc >> 4] + svs[16 + (cc & 15)]; }
        float myv = 0.f; int myc = 0;
        for (int r = 0; r < 16; ++r) {
            float bv = c[0]; int bi = lane;
#pragma unroll
            for (int j = 1; j < 4; ++j) if (c[j] > bv) { bv = c[j]; bi = lane + 64 * j; }
            wargmax(bv, bi);
#pragma unroll
            for (int j = 0; j < 4; ++j) if (bi == lane + 64 * j) c[j] = NEG;
            if (lane == r) { myv = bv; myc = bi; }
        }
        const float mx = __uint_as_float(__builtin_amdgcn_readfirstlane(__float_as_uint(myv)));
        const float e = (lane < 16) ? expf(myv - mx) : 0.f;
        const float sum = wsum(e);
        if (lane < 16) {
            IDX[(size_t)tok * 128 + h * 16 + lane] = sis[myc >> 4] * 128 + sis[16 + (myc & 15)];
            G[(size_t)tok * 128 + h * 16 + lane] = e / sum;
        }
        __syncthreads();
    }
}

__device__ __forceinline__ void peer_gather_naive(const float* X, const int* __restrict__ IDX, const float* __restrict__ G,
                                  const float* __restrict__ U, const float* __restrict__ Vt,
                                  const float* __restrict__ g, const float* __restrict__ bb, float* dst, bf16_t* __restrict__ xb) {
    const int tid_ = opaque_tid(); const int wave = tid_ >> 6, lane = tid_ & 63;
    for (int row = blockIdx.x * 8 + wave; row < T; row += NBLK * 8) {
        float4 x[8], acc[8];
#pragma unroll
        for (int i = 0; i < 8; ++i) { x[i] = ((const float4*)(X + (size_t)row * D))[i * 64 + lane]; acc[i] = make_float4(0.f, 0.f, 0.f, 0.f); }
#pragma unroll 1
        for (int e = 0; e < 128; ++e) {
            const int ix = IDX[(size_t)row * 128 + e];
            const float ge = G[(size_t)row * 128 + e];
            const float4* u = (const float4*)(U + (size_t)ix * D);
            float s = 0.f;
#pragma unroll
            for (int i = 0; i < 8; ++i) { const float4 uu = u[i * 64 + lane]; s += (x[i].x * uu.x + x[i].y * uu.y) + (x[i].z * uu.z + x[i].w * uu.w); }
            s = wsum(s);
            const float w = ge * gelu_tanh(s);
            const float4* v = (const float4*)(Vt + (size_t)ix * D);
#pragma unroll
            for (int i = 0; i < 8; ++i) { const float4 vv = v[i * 64 + lane]; acc[i].x = fmaf(w, vv.x, acc[i].x); acc[i].y = fmaf(w, vv.y, acc[i].y); acc[i].z = fmaf(w, vv.z, acc[i].z); acc[i].w = fmaf(w, vv.w, acc[i].w); }
        }
        float s = 0.f;
#pragma unroll
        for (int i = 0; i < 8; ++i) {
            acc[i] = make_float4(ALPHA * x[i].x + acc[i].x, ALPHA * x[i].y + acc[i].y, ALPHA * x[i].z + acc[i].z, ALPHA * x[i].w + acc[i].w);
            s += (acc[i].x + acc[i].y) + (acc[i].z + acc[i].w);
        }
        const float mu = wsum(s) * (1.f / D);
        float v = 0.f;
#pragma unroll
        for (int i = 0; i < 8; ++i) { const float a = acc[i].x - mu, b = acc[i].y - mu, c = acc[i].z - mu, d = acc[i].w - mu; v += (a * a + b * b) + (c * c + d * d); }
        const float rstd = rsqrtf(wsum(v) * (1.f / D) + LN_EPS);
#pragma unroll
        for (int i = 0; i < 8; ++i) {
            const float4 gg = ((const float4*)g)[i * 64 + lane], b4 = ((const float4*)bb)[i * 64 + lane];
            const float4 o4 = make_float4((acc[i].x - mu) * rstd * gg.x + b4.x, (acc[i].y - mu) * rstd * gg.y + b4.y,
                                          (acc[i].z - mu) * rstd * gg.z + b4.z, (acc[i].w - mu) * rstd * gg.w + b4.w);
            ((float4*)(dst + (size_t)row * D))[i * 64 + lane] = o4;
            ((uint2*)(xb + (size_t)row * D))[i * 64 + lane] = make_uint2(cvtpk(o4.x, o4.y), cvtpk(o4.z, o4.w));
        }
    }
}

__device__ __forceinline__ void peer_gather_b(const float* X, const bf16_t* __restrict__ Xbin, const int* __restrict__ IDX, const float* __restrict__ G,
                                              const bf16_t* __restrict__ Ub, const bf16_t* __restrict__ Vb,
                                              const float* __restrict__ g, const float* __restrict__ bb, float* dst, bf16_t* xbout) {
    const int tid_ = opaque_tid(); const int wave = tid_ >> 6, lane = tid_ & 63;
    const GAS unsigned char* Ug = (const GAS unsigned char*)Ub; const GAS unsigned char* Vg = (const GAS unsigned char*)Vb;
    for (int row = blockIdx.x * 8 + wave; row < T; row += NBLK * 8) {
        u32x4 xb[4];
#pragma unroll
        for (int i = 0; i < 4; ++i) xb[i] = *(const GAS u32x4*)((const GAS bf16_t*)Xbin + (size_t)row * D + i * 512 + lane * 8);
        float acc[32];
#pragma unroll
        for (int k = 0; k < 32; ++k) acc[k] = 0.f;
#pragma unroll 1
        for (int bt = 0; bt < 8; ++bt) {
            const int idxv = IDX[(size_t)row * 128 + bt * 16 + (lane & 15)];
            const float gv = G[(size_t)row * 128 + bt * 16 + (lane & 15)];
            float part[16];
#pragma unroll
            for (int e = 0; e < 16; ++e) {
                const int ix = __builtin_amdgcn_readlane(idxv, e);
                const GAS unsigned char* up = Ug + (size_t)ix * (D * 2) + lane * 16;
                const u32x4 u0 = *(const GAS u32x4*)(up), u1 = *(const GAS u32x4*)(up + 1024), u2 = *(const GAS u32x4*)(up + 2048), u3 = *(const GAS u32x4*)(up + 3072);
                float a0 = 0.f, a1 = 0.f, a2 = 0.f, a3 = 0.f;
                a0 = dot2bf(u0[0], xb[0][0], a0); a1 = dot2bf(u0[1], xb[0][1], a1); a2 = dot2bf(u0[2], xb[0][2], a2); a3 = dot2bf(u0[3], xb[0][3], a3);
                a0 = dot2bf(u1[0], xb[1][0], a0); a1 = dot2bf(u1[1], xb[1][1], a1); a2 = dot2bf(u1[2], xb[1][2], a2); a3 = dot2bf(u1[3], xb[1][3], a3);
                a0 = dot2bf(u2[0], xb[2][0], a0); a1 = dot2bf(u2[1], xb[2][1], a1); a2 = dot2bf(u2[2], xb[2][2], a2); a3 = dot2bf(u2[3], xb[2][3], a3);
                a0 = dot2bf(u3[0], xb[3][0], a0); a1 = dot2bf(u3[1], xb[3][1], a1); a2 = dot2bf(u3[2], xb[3][2], a2); a3 = dot2bf(u3[3], xb[3][3], a3);
                part[e] = (a0 + a1) + (a2 + a3);
            }
            float r8[8], r4[4], r2[2], h;
            { const bool hb = (lane & 8) != 0;
#pragma unroll
              for (int k = 0; k < 8; ++k) { const float keep = hb ? part[8 + k] : part[k], send = hb ? part[k] : part[8 + k]; r8[k] = keep + swz_xor<8>(send); } }
            { const bool hb = (lane & 4) != 0;
#pragma unroll
              for (int k = 0; k < 4; ++k) { const float keep = hb ? r8[4 + k] : r8[k], send = hb ? r8[k] : r8[4 + k]; r4[k] = keep + swz_xor<4>(send); } }
            { const bool hb = (lane & 2) != 0;
#pragma unroll
              for (int k = 0; k < 2; ++k) { const float keep = hb ? r4[2 + k] : r4[k], send = hb ? r4[k] : r4[2 + k]; r2[k] = keep + swz_xor<2>(send); } }
            { const bool hb = (lane & 1) != 0; const float keep = hb ? r2[1] : r2[0], send = hb ? r2[0] : r2[1]; h = keep + swz_xor<1>(send); }
            h += swz_xor<16>(h);
            { auto rr = __builtin_amdgcn_permlane32_swap(__float_as_uint(h), __float_as_uint(h), false, false); h = __uint_as_float(rr[0]) + __uint_as_float(rr[1]); }
            const float w = gv * gelu_tanh(h);
            const unsigned wb = cvtpk(w, 0.f);
#pragma unroll
            for (int e = 0; e < 16; ++e) {
                const int ix = __builtin_amdgcn_readlane(idxv, e);
                const unsigned wlo = (unsigned)__builtin_amdgcn_readlane((int)wb, e), whi = wlo << 16;
                const GAS unsigned char* vp = Vg + (size_t)ix * (D * 2) + lane * 16;
                const u32x4 v0 = *(const GAS u32x4*)(vp), v1 = *(const GAS u32x4*)(vp + 1024), v2 = *(const GAS u32x4*)(vp + 2048), v3 = *(const GAS u32x4*)(vp + 3072);
#pragma unroll
                for (int k = 0; k < 4; ++k) {
                    acc[2 * k] = dot2bf(v0[k], wlo, acc[2 * k]);           acc[2 * k + 1] = dot2bf(v0[k], whi, acc[2 * k + 1]);
                    acc[8 + 2 * k] = dot2bf(v1[k], wlo, acc[8 + 2 * k]);   acc[8 + 2 * k + 1] = dot2bf(v1[k], whi, acc[8 + 2 * k + 1]);
                    acc[16 + 2 * k] = dot2bf(v2[k], wlo, acc[16 + 2 * k]); acc[16 + 2 * k + 1] = dot2bf(v2[k], whi, acc[16 + 2 * k + 1]);
                    acc[24 + 2 * k] = dot2bf(v3[k], wlo, acc[24 + 2 * k]); acc[24 + 2 * k + 1] = dot2bf(v3[k], whi, acc[24 + 2 * k + 1]);
                }
            }
        }
        float s1 = 0.f;
#pragma unroll
        for (int i = 0; i < 4; ++i) {
            const f32x4 xa = *(const GAS f32x4*)((const GAS float*)X + (size_t)row * D + i * 512 + lane * 8), xc = *(const GAS f32x4*)((const GAS float*)X + (size_t)row * D + i * 512 + lane * 8 + 4);
#pragma unroll
            for (int k = 0; k < 4; ++k) { acc[8 * i + k] = fmaf(ALPHA, xa[k], acc[8 * i + k]); acc[8 * i + 4 + k] = fmaf(ALPHA, xc[k], acc[8 * i + 4 + k]); }
        }
#pragma unroll
        for (int k = 0; k < 32; ++k) s1 += acc[k];
        const float mu = wsum(s1) * (1.f / D);
        float s2 = 0.f;
#pragma unroll
        for (int k = 0; k < 32; ++k) { const float d_ = acc[k] - mu; s2 = fmaf(d_, d_, s2); }
        const float rstd = rsqrtf(wsum(s2) * (1.f / D) + LN_EPS);
        const float* gl_ = g; const float* bl_ = bb;
        asm volatile("" : "+s"(gl_), "+s"(bl_));
#pragma unroll
        for (int i = 0; i < 4; ++i) {
            const int col = i * 512 + lane * 8;
            const f32x4 g0 = *(const GAS f32x4*)((const GAS float*)gl_ + col), g1 = *(const GAS f32x4*)((const GAS float*)gl_ + col + 4);
            const f32x4 b0 = *(const GAS f32x4*)((const GAS float*)bl_ + col), b1 = *(const GAS f32x4*)((const GAS float*)bl_ + col + 4);
            f32x4 o0, o1;
#pragma unroll
            for (int k = 0; k < 4; ++k) { o0[k] = (acc[8 * i + k] - mu) * rstd * g0[k] + b0[k]; o1[k] = (acc[8 * i + 4 + k] - mu) * rstd * g1[k] + b1[k]; }
            *(GAS f32x4*)((GAS float*)dst + (size_t)row * D + col) = o0; *(GAS f32x4*)((GAS float*)dst + (size_t)row * D + col + 4) = o1;
            *(GAS u32x4*)((GAS bf16_t*)xbout + (size_t)row * D + col) = u32x4{cvtpk(o0[0], o0[1]), cvtpk(o0[2], o0[3]), cvtpk(o1[0], o1[1]), cvtpk(o1[2], o1[3])};
        }
    }
}

typedef float f32x2 __attribute__((ext_vector_type(2)));
__device__ __forceinline__ void convert_rows_fp8(const float* __restrict__ src, unsigned char* __restrict__ dst, float* __restrict__ scale, int nrows) {
    const int tid_ = opaque_tid(); const int wave = tid_ >> 6, lane = tid_ & 63;
    for (int row = blockIdx.x * 8 + wave; row < nrows; row += NBLK * 8) {
        f32x4 v[8]; float m = 0.f;
#pragma unroll
        for (int i = 0; i < 2; ++i)
#pragma unroll
            for (int q = 0; q < 4; ++q) {
                v[4 * i + q] = *(const GAS f32x4*)((const GAS float*)src + (size_t)row * D + i * 1024 + 256 * q + lane * 4);
#pragma unroll
                for (int k = 0; k < 4; ++k) m = fmaxf(m, fabsf(v[4 * i + q][k]));
            }
        m = wmaxf(m);
        int E = (int)((__float_as_uint(m) >> 23) & 0xffu) - 127;
        if (E < -100) E = -100;
        const float inv_s = __uint_as_float((unsigned)(127 + 7 - E) << 23), sc = __uint_as_float((unsigned)(127 + E - 7) << 23);
#pragma unroll
        for (int i = 0; i < 2; ++i) {
            unsigned w[4];
#pragma unroll
            for (int q = 0; q < 4; ++q) {
                int pk = __builtin_amdgcn_cvt_pk_fp8_f32(v[4 * i + q][0] * inv_s, v[4 * i + q][1] * inv_s, 0, false);
                pk = __builtin_amdgcn_cvt_pk_fp8_f32(v[4 * i + q][2] * inv_s, v[4 * i + q][3] * inv_s, pk, true);
                w[q] = (unsigned)pk;
            }
            *(GAS u32x4*)((GAS unsigned char*)dst + (size_t)row * D + i * 1024 + lane * 16) = u32x4{w[0], w[1], w[2], w[3]};
        }
        if (lane == 0) scale[row] = sc;
    }
}
#define F8_CVT_LO(dst, src) asm volatile("v_cvt_pk_f32_fp8_e32 %0, %1" : "=v"(dst) : "v"(src))
#define F8_CVT_HI(dst, src) asm volatile("v_cvt_pk_f32_fp8_sdwa %0, %1 src0_sel:WORD_1" : "=v"(dst) : "v"(src))
#define F8_PKFMA(acc, a, b) asm volatile("v_pk_fma_f32 %0, %1, %2, %0" : "+v"(acc) : "v"(a), "v"(b))
#define F8_PKFMA_S(acc, w, b) asm volatile("v_pk_fma_f32 %0, %1, %2, %0" : "+v"(acc) : "s"(w), "v"(b))
__device__ __forceinline__ void peer_gather_f8(const float* X, const int* __restrict__ IDX, const float* __restrict__ G,
                                               const unsigned char* __restrict__ U8, const unsigned char* __restrict__ V8,
                                               const float* __restrict__ SU, const float* __restrict__ SV,
                                               const float* __restrict__ g, const float* __restrict__ bb, float* dst, bf16_t* xbout) {
    const int tid_ = opaque_tid(); const int wave = tid_ >> 6;
    const GAS unsigned char* Ug = (const GAS unsigned char*)U8; const GAS unsigned char* Vg = (const GAS unsigned char*)V8;
    for (int row = blockIdx.x * 8 + wave; row < T; row += NBLK * 8) {
        int lane = tid_ & 63; asm volatile("" : "+v"(lane));
        f32x2 xr[16], acc[16];
#pragma unroll
        for (int i = 0; i < 2; ++i)
#pragma unroll
            for (int q = 0; q < 4; ++q) {
                const f32x4 t4 = *(const GAS f32x4*)((const GAS float*)X + (size_t)row * D + i * 1024 + 256 * q + lane * 4);
                xr[8 * i + 2 * q] = f32x2{t4[0], t4[1]}; xr[8 * i + 2 * q + 1] = f32x2{t4[2], t4[3]};
            }
#pragma unroll
        for (int k = 0; k < 16; ++k) acc[k] = f32x2{0.f, 0.f};
        int k0 = (IDX[(size_t)row * 128 + lane] << 7) | lane, k1 = (IDX[(size_t)row * 128 + 64 + lane] << 7) | (64 + lane);
#define GS_STEP(SIZE, STRIDE) do { const int p0_ = swz_xor_i<STRIDE>(k0), p1_ = swz_xor_i<STRIDE>(k1); const bool lo_ = (lane & STRIDE) == 0; \
            const bool up0_ = (SIZE == 128) ? true : ((SIZE == 64) ? true : ((lane & SIZE) == 0)), up1_ = (SIZE == 128) ? true : ((SIZE == 64) ? false : ((lane & SIZE) == 0)); \
            k0 = (up0_ == lo_) ? imin(k0, p0_) : imax(k0, p0_); k1 = (up1_ == lo_) ? imin(k1, p1_) : imax(k1, p1_); } while (0)
#define GS_STEP32(SIZE) do { auto r0_ = __builtin_amdgcn_permlane32_swap((unsigned)k0, (unsigned)k0, false, false); auto r1_ = __builtin_amdgcn_permlane32_swap((unsigned)k1, (unsigned)k1, false, false); \
            const bool lo_ = (lane & 32) == 0; const int p0_ = lo_ ? (int)r0_[1] : (int)r0_[0], p1_ = lo_ ? (int)r1_[1] : (int)r1_[0]; \
            const bool up0_ = true, up1_ = (SIZE == 128); \
            k0 = (up0_ == lo_) ? imin(k0, p0_) : imax(k0, p0_); k1 = (up1_ == lo_) ? imin(k1, p1_) : imax(k1, p1_); } while (0)
        GS_STEP(2, 1);
        GS_STEP(4, 2); GS_STEP(4, 1);
        GS_STEP(8, 4); GS_STEP(8, 2); GS_STEP(8, 1);
        GS_STEP(16, 8); GS_STEP(16, 4); GS_STEP(16, 2); GS_STEP(16, 1);
        GS_STEP(32, 16); GS_STEP(32, 8); GS_STEP(32, 4); GS_STEP(32, 2); GS_STEP(32, 1);
        GS_STEP32(64); GS_STEP(64, 16); GS_STEP(64, 8); GS_STEP(64, 4); GS_STEP(64, 2); GS_STEP(64, 1);
        { const int a_ = imin(k0, k1), b_ = imax(k0, k1); k0 = a_; k1 = b_; }
        GS_STEP32(128); GS_STEP(128, 16); GS_STEP(128, 8); GS_STEP(128, 4); GS_STEP(128, 2); GS_STEP(128, 1);
#undef GS_STEP
#undef GS_STEP32
#pragma unroll 1
        for (int bt = 0; bt < 8; ++bt) {
            const int ksel = (bt & 4) ? k1 : k0;
            const int key = __builtin_amdgcn_ds_bpermute(4 * (16 * (bt & 3) + (lane & 15)), ksel);
            const int idxv = key >> 7;
            const float gv = G[(size_t)row * 128 + (key & 127)];
            const float suv = SU[idxv], svv = SV[idxv];
            float part[16];
            u32x4 ra[8], rb[8];
#define F8_LOADG(buf, base, gq) do { _Pragma("unroll") for (int e_ = 0; e_ < 4; ++e_) { \
                const int ix_ = __builtin_amdgcn_readlane(idxv, 4 * (gq) + e_); const GAS unsigned char* p_ = (base) + (size_t)ix_ * D + lane * 16; \
                buf[2 * e_] = *(const GAS u32x4*)(p_); buf[2 * e_ + 1] = *(const GAS u32x4*)(p_ + 1024); } } while (0)
#define F8_DOTG(buf, gq) do { _Pragma("unroll") for (int e_ = 0; e_ < 4; ++e_) { \
                f32x2 s0_ = f32x2{0.f, 0.f}, s1_ = f32x2{0.f, 0.f}; \
                _Pragma("unroll") for (int i_ = 0; i_ < 2; ++i_) { \
                    f32x2 c0_, c1_, c2_, c3_, c4_, c5_, c6_, c7_; const u32x4 w_ = buf[2 * e_ + i_]; \
                    F8_CVT_LO(c0_, w_[0]); F8_CVT_HI(c1_, w_[0]); F8_CVT_LO(c2_, w_[1]); F8_CVT_HI(c3_, w_[1]); \
                    F8_CVT_LO(c4_, w_[2]); F8_CVT_HI(c5_, w_[2]); F8_CVT_LO(c6_, w_[3]); F8_CVT_HI(c7_, w_[3]); \
                    F8_PKFMA(s0_, c0_, xr[8 * i_ + 0]); F8_PKFMA(s1_, c1_, xr[8 * i_ + 1]); F8_PKFMA(s0_, c2_, xr[8 * i_ + 2]); F8_PKFMA(s1_, c3_, xr[8 * i_ + 3]); \
                    F8_PKFMA(s0_, c4_, xr[8 * i_ + 4]); F8_PKFMA(s1_, c5_, xr[8 * i_ + 5]); F8_PKFMA(s0_, c6_, xr[8 * i_ + 6]); F8_PKFMA(s1_, c7_, xr[8 * i_ + 7]); } \
                part[4 * (gq) + e_] = (s0_[0] + s0_[1]) + (s1_[0] + s1_[1]); } } while (0)
#define F8_ACCG(buf, gq) do { _Pragma("unroll") for (int e_ = 0; e_ < 4; ++e_) { \
                const unsigned wu_ = (unsigned)__builtin_amdgcn_readlane((int)__float_as_uint(w), 4 * (gq) + e_); \
                const unsigned long long wp_ = ((unsigned long long)wu_ << 32) | wu_; \
                _Pragma("unroll") for (int i_ = 0; i_ < 2; ++i_) { \
                    f32x2 c0_, c1_, c2_, c3_, c4_, c5_, c6_, c7_; const u32x4 w_ = buf[2 * e_ + i_]; \
                    F8_CVT_LO(c0_, w_[0]); F8_CVT_HI(c1_, w_[0]); F8_CVT_LO(c2_, w_[1]); F8_CVT_HI(c3_, w_[1]); \
                    F8_CVT_LO(c4_, w_[2]); F8_CVT_HI(c5_, w_[2]); F8_CVT_LO(c6_, w_[3]); F8_CVT_HI(c7_, w_[3]); \
                    F8_PKFMA_S(acc[8 * i_ + 0], wp_, c0_); F8_PKFMA_S(acc[8 * i_ + 1], wp_, c1_); F8_PKFMA_S(acc[8 * i_ + 2], wp_, c2_); F8_PKFMA_S(acc[8 * i_ + 3], wp_, c3_); \
                    F8_PKFMA_S(acc[8 * i_ + 4], wp_, c4_); F8_PKFMA_S(acc[8 * i_ + 5], wp_, c5_); F8_PKFMA_S(acc[8 * i_ + 6], wp_, c6_); F8_PKFMA_S(acc[8 * i_ + 7], wp_, c7_); } } } while (0)
            F8_LOADG(ra, Ug, 0);
            F8_LOADG(rb, Ug, 1); F8_DOTG(ra, 0);
            F8_LOADG(ra, Ug, 2); F8_DOTG(rb, 1);
            F8_LOADG(rb, Ug, 3); F8_DOTG(ra, 2);
            F8_LOADG(ra, Vg, 0); F8_DOTG(rb, 3);
            float r8[8], r4[4], r2[2], h;
            { const bool hb = (lane & 8) != 0;
#pragma unroll
              for (int k = 0; k < 8; ++k) { const float keep = hb ? part[8 + k] : part[k], send = hb ? part[k] : part[8 + k]; r8[k] = keep + swz_xor<8>(send); } }
            { const bool hb = (lane & 4) != 0;
#pragma unroll
              for (int k = 0; k < 4; ++k) { const float keep = hb ? r8[4 + k] : r8[k], send = hb ? r8[k] : r8[4 + k]; r4[k] = keep + swz_xor<4>(send); } }
            { const bool hb = (lane & 2) != 0;
#pragma unroll
              for (int k = 0; k < 2; ++k) { const float keep = hb ? r4[2 + k] : r4[k], send = hb ? r4[k] : r4[2 + k]; r2[k] = keep + swz_xor<2>(send); } }
            { const bool hb = (lane & 1) != 0; const float keep = hb ? r2[1] : r2[0], send = hb ? r2[0] : r2[1]; h = keep + swz_xor<1>(send); }
            h += swz_xor<16>(h);
            { auto rr = __builtin_amdgcn_permlane32_swap(__float_as_uint(h), __float_as_uint(h), false, false); h = __uint_as_float(rr[0]) + __uint_as_float(rr[1]); }
            const float w = gv * gelu_tanh(h * suv) * svv;
            F8_LOADG(rb, Vg, 1); F8_ACCG(ra, 0);
            F8_LOADG(ra, Vg, 2); F8_ACCG(rb, 1);
            F8_LOADG(rb, Vg, 3); F8_ACCG(ra, 2);
            F8_ACCG(rb, 3);
#undef F8_LOADG
#undef F8_DOTG
#undef F8_ACCG
        }
        asm volatile("" : "+v"(lane));
        float s1 = 0.f;
#pragma unroll
        for (int k = 0; k < 16; ++k) { acc[k][0] = fmaf(ALPHA, xr[k][0], acc[k][0]); acc[k][1] = fmaf(ALPHA, xr[k][1], acc[k][1]); s1 += acc[k][0] + acc[k][1]; }
        const float mu = wsum(s1) * (1.f / D);
        float s2 = 0.f;
#pragma unroll
        for (int k = 0; k < 16; ++k) { const float d0 = acc[k][0] - mu, d1 = acc[k][1] - mu; s2 = fmaf(d0, d0, s2); s2 = fmaf(d1, d1, s2); }
        const float rstd = rsqrtf(wsum(s2) * (1.f / D) + LN_EPS);
        const float* gl_ = g; const float* bl_ = bb;
        asm volatile("" : "+s"(gl_), "+s"(bl_));
#pragma unroll
        for (int i = 0; i < 2; ++i) {
#pragma unroll
            for (int q = 0; q < 4; ++q) {
                const int col = i * 1024 + 256 * q + lane * 4;
                const f32x4 g4 = *(const GAS f32x4*)((const GAS float*)gl_ + col), b4 = *(const GAS f32x4*)((const GAS float*)bl_ + col);
                f32x4 o4;
                o4[0] = (acc[8 * i + 2 * q][0] - mu) * rstd * g4[0] + b4[0]; o4[1] = (acc[8 * i + 2 * q][1] - mu) * rstd * g4[1] + b4[1];
                o4[2] = (acc[8 * i + 2 * q + 1][0] - mu) * rstd * g4[2] + b4[2]; o4[3] = (acc[8 * i + 2 * q + 1][1] - mu) * rstd * g4[3] + b4[3];
                *(GAS f32x4*)((GAS float*)dst + (size_t)row * D + col) = o4;
                *(GAS u32x2*)((GAS bf16_t*)xbout + (size_t)row * D + col) = u32x2{cvtpk(o4[0], o4[1]), cvtpk(o4[2], o4[3])};
            }
        }
    }
}

typedef unsigned u32x6 __attribute__((ext_vector_type(6)));
typedef float f32x32 __attribute__((ext_vector_type(32)));
constexpr int F6_ROW = 1536;
__device__ __forceinline__ void convert_rows_fp6(const float* __restrict__ src, unsigned char* __restrict__ dst, float* __restrict__ scale, int nrows) {
    const int tid_ = opaque_tid(); const int wave = __builtin_amdgcn_readfirstlane(tid_ >> 6), lane = tid_ & 63;
    for (int row = blockIdx.x * 8 + wave; row < nrows; row += NBLK * 8) {
        f32x4 v[8]; float m = 0.f;
#pragma unroll
        for (int i = 0; i < 2; ++i)
#pragma unroll
            for (int q = 0; q < 4; ++q) {
                v[4 * i + q] = *(const GAS f32x4*)((const GAS float*)src + (size_t)row * D + i * 1024 + 256 * q + lane * 4);
#pragma unroll
                for (int k = 0; k < 4; ++k) m = fmaxf(m, fabsf(v[4 * i + q][k]));
            }
        m = wmaxf(m);
        int E = (int)((__float_as_uint(m) >> 23) & 0xffu) - 127;
        if (E < -100) E = -100;
        const float inv_s = __uint_as_float((unsigned)(127 + 2 - E) << 23), sc = __uint_as_float((unsigned)(127 + E - 2) << 23);
        unsigned long long W0 = 0ull, W1 = 0ull, W2 = 0ull;
#pragma unroll
        for (int e = 0; e < 32; ++e) {
            const float xv = v[e >> 2][e & 3] * inv_s, a = fabsf(xv);
            float cf;
            if (a < 1.f) cf = a * 8.f; else if (a < 2.f) cf = 8.f + (a - 1.f) * 8.f; else if (a < 4.f) cf = 16.f + (a - 2.f) * 4.f; else cf = 24.f + (a - 4.f) * 2.f;
            unsigned code = (unsigned)__float2int_rn(cf); if (code > 31u) code = 31u;
            code |= (xv < 0.f) ? 32u : 0u;
            const int bp = 6 * e, wi = bp >> 6, sh = bp & 63;
            const unsigned long long c64 = (unsigned long long)code;
            if (wi == 0) W0 |= c64 << sh; else if (wi == 1) W1 |= c64 << sh; else W2 |= c64 << sh;
            if (sh > 58) { if (wi == 0) W1 |= c64 >> (64 - sh); else if (wi == 1) W2 |= c64 >> (64 - sh); }
        }
        const u32x6 w = u32x6{(unsigned)W0, (unsigned)(W0 >> 32), (unsigned)W1, (unsigned)(W1 >> 32), (unsigned)W2, (unsigned)(W2 >> 32)};
        *(GAS u32x4*)((GAS unsigned char*)dst + (size_t)row * F6_ROW + lane * 16) = u32x4{w[0], w[1], w[2], w[3]};
        *(GAS u32x2*)((GAS unsigned char*)dst + (size_t)row * F6_ROW + 1024 + lane * 8) = u32x2{w[4], w[5]};
        if (lane == 0) scale[row] = sc;
    }
}
#define F6_CVT(dst, src) asm volatile("v_cvt_scalef32_pk32_f32_fp6 %0, %1, 1.0" : "=&v"(dst) : "v"(src))
__device__ __forceinline__ void peer_gather_f6(const float* X, const int* __restrict__ IDX, const float* __restrict__ G,
                                               const unsigned char* __restrict__ U6, const unsigned char* __restrict__ V6,
                                               const float* __restrict__ SU, const float* __restrict__ SV,
                                               const float* __restrict__ g, const float* __restrict__ bb, float* dst, bf16_t* xbout) {
    const int tid_ = opaque_tid(); const int wave = __builtin_amdgcn_readfirstlane(tid_ >> 6);
    const GAS unsigned char* Ug = (const GAS unsigned char*)U6; const GAS unsigned char* Vg = (const GAS unsigned char*)V6;
    for (int row = blockIdx.x * 8 + wave; row < T; row += NBLK * 8) {
        int lane = tid_ & 63; asm volatile("" : "+v"(lane));
        f32x2 xr[16], acc[16];
#pragma unroll
        for (int i = 0; i < 2; ++i)
#pragma unroll
            for (int q = 0; q < 4; ++q) {
                const f32x4 t4 = *(const GAS f32x4*)((const GAS float*)X + (size_t)row * D + i * 1024 + 256 * q + lane * 4);
                xr[8 * i + 2 * q] = f32x2{t4[0], t4[1]}; xr[8 * i + 2 * q + 1] = f32x2{t4[2], t4[3]};
            }
#pragma unroll
        for (int k = 0; k < 16; ++k) acc[k] = f32x2{0.f, 0.f};
        int k0 = (IDX[(size_t)row * 128 + lane] << 7) | lane, k1 = (IDX[(size_t)row * 128 + 64 + lane] << 7) | (64 + lane);
#define GS_STEP(SIZE, STRIDE) do { const int p0_ = swz_xor_i<STRIDE>(k0), p1_ = swz_xor_i<STRIDE>(k1); const bool lo_ = (lane & STRIDE) == 0; \
            const bool up0_ = (SIZE == 128) ? true : ((SIZE == 64) ? true : ((lane & SIZE) == 0)), up1_ = (SIZE == 128) ? true : ((SIZE == 64) ? false : ((lane & SIZE) == 0)); \
            k0 = (up0_ == lo_) ? imin(k0, p0_) : imax(k0, p0_); k1 = (up1_ == lo_) ? imin(k1, p1_) : imax(k1, p1_); } while (0)
#define GS_STEP32(SIZE) do { auto r0_ = __builtin_amdgcn_permlane32_swap((unsigned)k0, (unsigned)k0, false, false); auto r1_ = __builtin_amdgcn_permlane32_swap((unsigned)k1, (unsigned)k1, false, false); \
            const bool lo_ = (lane & 32) == 0; const int p0_ = lo_ ? (int)r0_[1] : (int)r0_[0], p1_ = lo_ ? (int)r1_[1] : (int)r1_[0]; \
            const bool up0_ = true, up1_ = (SIZE == 128); \
            k0 = (up0_ == lo_) ? imin(k0, p0_) : imax(k0, p0_); k1 = (up1_ == lo_) ? imin(k1, p1_) : imax(k1, p1_); } while (0)
        GS_STEP(2, 1);
        GS_STEP(4, 2); GS_STEP(4, 1);
        GS_STEP(8, 4); GS_STEP(8, 2); GS_STEP(8, 1);
        GS_STEP(16, 8); GS_STEP(16, 4); GS_STEP(16, 2); GS_STEP(16, 1);
        GS_STEP(32, 16); GS_STEP(32, 8); GS_STEP(32, 4); GS_STEP(32, 2); GS_STEP(32, 1);
        GS_STEP32(64); GS_STEP(64, 16); GS_STEP(64, 8); GS_STEP(64, 4); GS_STEP(64, 2); GS_STEP(64, 1);
        { const int a_ = imin(k0, k1), b_ = imax(k0, k1); k0 = a_; k1 = b_; }
        GS_STEP32(128); GS_STEP(128, 16); GS_STEP(128, 8); GS_STEP(128, 4); GS_STEP(128, 2); GS_STEP(128, 1);
#undef GS_STEP
#undef GS_STEP32
#pragma unroll 1
        for (int bt = 0; bt < 8; ++bt) {
            const int ksel = (bt & 4) ? k1 : k0;
            const int key = __builtin_amdgcn_ds_bpermute(4 * (16 * (bt & 3) + (lane & 15)), ksel);
            const int idxv = key >> 7;
            const float gv = G[(size_t)row * 128 + (key & 127)];
            const float suv = SU[idxv], svv = SV[idxv];
            float part[16];
            u32x6 ra[4], rb[4];
#define F6_LOADG(buf, base, gq) do { _Pragma("unroll") for (int e_ = 0; e_ < 4; ++e_) { \
                const int ix_ = __builtin_amdgcn_readlane(idxv, 4 * (gq) + e_); const GAS unsigned char* p_ = (base) + (size_t)ix_ * F6_ROW; \
                const u32x4 a_ = *(const GAS u32x4*)(p_ + lane * 16); const u32x2 b_ = *(const GAS u32x2*)(p_ + 1024 + lane * 8); \
                buf[e_] = u32x6{a_[0], a_[1], a_[2], a_[3], b_[0], b_[1]}; } } while (0)
#define F6_DOTG(buf, gq) do { _Pragma("unroll") for (int e_ = 0; e_ < 4; ++e_) { \
                f32x32 c_; F6_CVT(c_, buf[e_]); f32x2 s0_ = f32x2{0.f, 0.f}, s1_ = f32x2{0.f, 0.f}; \
                _Pragma("unroll") for (int k_ = 0; k_ < 16; k_ += 2) { \
                    const f32x2 ca_ = f32x2{c_[2 * k_], c_[2 * k_ + 1]}, cb_ = f32x2{c_[2 * k_ + 2], c_[2 * k_ + 3]}; \
                    F8_PKFMA(s0_, ca_, xr[k_]); F8_PKFMA(s1_, cb_, xr[k_ + 1]); } \
                part[4 * (gq) + e_] = (s0_[0] + s0_[1]) + (s1_[0] + s1_[1]); } } while (0)
#define F6_ACCG(buf, gq) do { _Pragma("unroll") for (int e_ = 0; e_ < 4; ++e_) { \
                const unsigned wu_ = (unsigned)__builtin_amdgcn_readlane((int)__float_as_uint(w), 4 * (gq) + e_); \
                const unsigned long long wp_ = ((unsigned long long)wu_ << 32) | wu_; \
                f32x32 c_; F6_CVT(c_, buf[e_]); \
                _Pragma("unroll") for (int k_ = 0; k_ < 16; ++k_) { const f32x2 ca_ = f32x2{c_[2 * k_], c_[2 * k_ + 1]}; F8_PKFMA_S(acc[k_], wp_, ca_); } } } while (0)
            F6_LOADG(ra, Ug, 0);
            F6_LOADG(rb, Ug, 1); F6_DOTG(ra, 0);
            F6_LOADG(ra, Ug, 2); F6_DOTG(rb, 1);
            F6_LOADG(rb, Ug, 3); F6_DOTG(ra, 2);
            F6_LOADG(ra, Vg, 0); F6_DOTG(rb, 3);
            float r8[8], r4[4], r2[2], h;
            { const bool hb = (lane & 8) != 0;
#pragma unroll
              for (int k = 0; k < 8; ++k) { const float keep = hb ? part[8 + k] : part[k], send = hb ? part[k] : part[8 + k]; r8[k] = keep + swz_xor<8>(send); } }
            { const bool hb = (lane & 4) != 0;
#pragma unroll
              for (int k = 0; k < 4; ++k) { const float keep = hb ? r8[4 + k] : r8[k], send = hb ? r8[k] : r8[4 + k]; r4[k] = keep + swz_xor<4>(send); } }
            { const bool hb = (lane & 2) != 0;
#pragma unroll
              for (int k = 0; k < 2; ++k) { const float keep = hb ? r4[2 + k] : r4[k], send = hb ? r4[k] : r4[2 + k]; r2[k] = keep + swz_xor<2>(send); } }
            { const bool hb = (lane & 1) != 0; const float keep = hb ? r2[1] : r2[0], send = hb ? r2[0] : r2[1]; h = keep + swz_xor<1>(send); }
            h += swz_xor<16>(h);
            { auto rr = __builtin_amdgcn_permlane32_swap(__float_as_uint(h), __float_as_uint(h), false, false); h = __uint_as_float(rr[0]) + __uint_as_float(rr[1]); }
            const float w = gv * gelu_tanh(h * suv) * svv;
            F6_LOADG(rb, Vg, 1); F6_ACCG(ra, 0);
            F6_LOADG(ra, Vg, 2); F6_ACCG(rb, 1);
            F6_LOADG(rb, Vg, 3); F6_ACCG(ra, 2);
            F6_ACCG(rb, 3);
#undef F6_LOADG
#undef F6_DOTG
#undef F6_ACCG
        }
        asm volatile("" : "+v"(lane));
        float s1 = 0.f;
#pragma unroll
        for (int k = 0; k < 16; ++k) { acc[k][0] = fmaf(ALPHA, xr[k][0], acc[k][0]); acc[k][1] = fmaf(ALPHA, xr[k][1], acc[k][1]); s1 += acc[k][0] + acc[k][1]; }
        const float mu = wsum(s1) * (1.f / D);
        float s2 = 0.f;
#pragma unroll
        for (int k = 0; k < 16; ++k) { const float d0 = acc[k][0] - mu, d1 = acc[k][1] - mu; s2 = fmaf(d0, d0, s2); s2 = fmaf(d1, d1, s2); }
        const float rstd = rsqrtf(wsum(s2) * (1.f / D) + LN_EPS);
        const float* gl_ = g; const float* bl_ = bb;
        asm volatile("" : "+s"(gl_), "+s"(bl_));
#pragma unroll
        for (int i = 0; i < 2; ++i) {
#pragma unroll
            for (int q = 0; q < 4; ++q) {
                const int col = i * 1024 + 256 * q + lane * 4;
                const f32x4 g4 = *(const GAS f32x4*)((const GAS float*)gl_ + col), b4 = *(const GAS f32x4*)((const GAS float*)bl_ + col);
                f32x4 o4;
                o4[0] = (acc[8 * i + 2 * q][0] - mu) * rstd * g4[0] + b4[0]; o4[1] = (acc[8 * i + 2 * q][1] - mu) * rstd * g4[1] + b4[1];
                o4[2] = (acc[8 * i + 2 * q + 1][0] - mu) * rstd * g4[2] + b4[2]; o4[3] = (acc[8 * i + 2 * q + 1][1] - mu) * rstd * g4[3] + b4[3];
                *(GAS f32x4*)((GAS float*)dst + (size_t)row * D + col) = o4;
                *(GAS u32x2*)((GAS bf16_t*)xbout + (size_t)row * D + col) = u32x2{cvtpk(o4[0], o4[1]), cvtpk(o4[2], o4[3])};
            }
        }
    }
}

constexpr int F4_ROW = 1024;
constexpr float F4_CLIP = 0.8f;
__device__ __forceinline__ void convert_rows_fp4(const float* __restrict__ src, unsigned char* __restrict__ dst, float* __restrict__ scale, int nrows) {
    const int tid_ = opaque_tid(); const int wave = __builtin_amdgcn_readfirstlane(tid_ >> 6), lane = tid_ & 63;
    f32x4 v[8], vn[8];
    {
        const int row = blockIdx.x * 8 + wave;
#pragma unroll
        for (int j = 0; j < 8; ++j) vn[j] = __builtin_nontemporal_load((const GAS f32x4*)((const GAS float*)src + (size_t)row * D + 256 * j + lane * 4));
    }
    for (int row = blockIdx.x * 8 + wave; row < nrows; row += NBLK * 8) {
        float m = 0.f;
        const int rown = (row + NBLK * 8 < nrows) ? row + NBLK * 8 : row;
#pragma unroll
        for (int j = 0; j < 8; ++j) {
            v[j] = vn[j];
            vn[j] = __builtin_nontemporal_load((const GAS f32x4*)((const GAS float*)src + (size_t)rown * D + 256 * j + lane * 4));
#pragma unroll
            for (int k = 0; k < 4; ++k) m = fmaxf(m, fabsf(v[j][k]));
        }
        m = fmaxf(wmaxf(m), 1e-30f);
        const float sc = m * (F4_CLIP / 6.f), inv_s = 1.f / sc;
        unsigned w[4];
#pragma unroll
        for (int j = 0; j < 4; ++j) w[j] = 0u;
#pragma unroll
        for (int e = 0; e < 32; e += 2) {
            const float x0 = v[e >> 2][e & 3] * inv_s, x1 = v[(e + 1) >> 2][(e + 1) & 3] * inv_s;
            switch ((e & 7) >> 1) {
                case 0: w[e >> 3] = __builtin_amdgcn_cvt_scalef32_pk_fp4_f32(w[e >> 3], x0, x1, 1.0f, 0); break;
                case 1: w[e >> 3] = __builtin_amdgcn_cvt_scalef32_pk_fp4_f32(w[e >> 3], x0, x1, 1.0f, 1); break;
                case 2: w[e >> 3] = __builtin_amdgcn_cvt_scalef32_pk_fp4_f32(w[e >> 3], x0, x1, 1.0f, 2); break;
                default: w[e >> 3] = __builtin_amdgcn_cvt_scalef32_pk_fp4_f32(w[e >> 3], x0, x1, 1.0f, 3); break;
            }
        }
        *(GAS u32x4*)((GAS unsigned char*)dst + (size_t)row * F4_ROW + lane * 16) = u32x4{w[0], w[1], w[2], w[3]};
        if (lane == 0) scale[row] = sc;
    }
}
#define F4_CVT0(dst, src) asm volatile("v_cvt_scalef32_pk_f32_fp4 %0, %1, 1.0" : "=v"(dst) : "v"(src))
#define F4_CVT1(dst, src) asm volatile("v_cvt_scalef32_pk_f32_fp4 %0, %1, 1.0 op_sel:[1,0,0]" : "=v"(dst) : "v"(src))
#define F4_CVT2(dst, src) asm volatile("v_cvt_scalef32_pk_f32_fp4 %0, %1, 1.0 op_sel:[0,1,0]" : "=v"(dst) : "v"(src))
#define F4_CVT3(dst, src) asm volatile("v_cvt_scalef32_pk_f32_fp4 %0, %1, 1.0 op_sel:[1,1,0]" : "=v"(dst) : "v"(src))
__device__ __forceinline__ void peer_gather_f4(const float* X, const int* __restrict__ IDX, const float* __restrict__ G,
                                               const unsigned char* __restrict__ U4, const unsigned char* __restrict__ V4,
                                               const float* __restrict__ SU, const float* __restrict__ SV,
                                               const float* __restrict__ g, const float* __restrict__ bb, float* dst, bf16_t* xbout) {
    const int tid_ = opaque_tid(); const int wave = __builtin_amdgcn_readfirstlane(tid_ >> 6);
    const GAS unsigned char* Ug = (const GAS unsigned char*)U4; const GAS unsigned char* Vg = (const GAS unsigned char*)V4;
    for (int row = blockIdx.x * 8 + wave; row < T; row += NBLK * 8) {
        int lane = tid_ & 63; asm volatile("" : "+v"(lane));
        f32x2 xr[16], acc[16];
#pragma unroll
        for (int j = 0; j < 8; ++j) {
            const f32x4 t4 = *(const GAS f32x4*)((const GAS float*)X + (size_t)row * D + 256 * j + lane * 4);
            xr[2 * j] = f32x2{t4[0], t4[1]}; xr[2 * j + 1] = f32x2{t4[2], t4[3]};
        }
#pragma unroll
        for (int k = 0; k < 16; ++k) acc[k] = f32x2{0.f, 0.f};
        int k0 = (IDX[(size_t)row * 128 + lane] << 7) | lane, k1 = (IDX[(size_t)row * 128 + 64 + lane] << 7) | (64 + lane);
#define GS_STEP(SIZE, STRIDE) do { const int p0_ = swz_xor_i<STRIDE>(k0), p1_ = swz_xor_i<STRIDE>(k1); const bool lo_ = (lane & STRIDE) == 0; \
            const bool up0_ = (SIZE == 128) ? true : ((SIZE == 64) ? true : ((lane & SIZE) == 0)), up1_ = (SIZE == 128) ? true : ((SIZE == 64) ? false : ((lane & SIZE) == 0)); \
            k0 = (up0_ == lo_) ? imin(k0, p0_) : imax(k0, p0_); k1 = (up1_ == lo_) ? imin(k1, p1_) : imax(k1, p1_); } while (0)
#define GS_STEP32(SIZE) do { auto r0_ = __builtin_amdgcn_permlane32_swap((unsigned)k0, (unsigned)k0, false, false); auto r1_ = __builtin_amdgcn_permlane32_swap((unsigned)k1, (unsigned)k1, false, false); \
            const bool lo_ = (lane & 32) == 0; const int p0_ = lo_ ? (int)r0_[1] : (int)r0_[0], p1_ = lo_ ? (int)r1_[1] : (int)r1_[0]; \
            const bool up0_ = true, up1_ = (SIZE == 128); \
            k0 = (up0_ == lo_) ? imin(k0, p0_) : imax(k0, p0_); k1 = (up1_ == lo_) ? imin(k1, p1_) : imax(k1, p1_); } while (0)
        GS_STEP(2, 1);
        GS_STEP(4, 2); GS_STEP(4, 1);
        GS_STEP(8, 4); GS_STEP(8, 2); GS_STEP(8, 1);
        GS_STEP(16, 8); GS_STEP(16, 4); GS_STEP(16, 2); GS_STEP(16, 1);
        GS_STEP(32, 16); GS_STEP(32, 8); GS_STEP(32, 4); GS_STEP(32, 2); GS_STEP(32, 1);
        GS_STEP32(64); GS_STEP(64, 16); GS_STEP(64, 8); GS_STEP(64, 4); GS_STEP(64, 2); GS_STEP(64, 1);
        { const int a_ = imin(k0, k1), b_ = imax(k0, k1); k0 = a_; k1 = b_; }
        GS_STEP32(128); GS_STEP(128, 16); GS_STEP(128, 8); GS_STEP(128, 4); GS_STEP(128, 2); GS_STEP(128, 1);
#undef GS_STEP
#undef GS_STEP32
#pragma unroll 1
        for (int bt = 0; bt < 8; ++bt) {
            const int ksel = (bt & 4) ? k1 : k0;
            const int key = __builtin_amdgcn_ds_bpermute(4 * (16 * (bt & 3) + (lane & 15)), ksel);
            const int idxv = key >> 7;
            const float gv = G[(size_t)row * 128 + (key & 127)];
            const float suv = SU[idxv], svv = SV[idxv];
            float part[16];
            u32x4 ra[4], rb[4];
#define F4_LOADG(buf, base, gq) do { _Pragma("unroll") for (int e_ = 0; e_ < 4; ++e_) { \
                const int ix_ = __builtin_amdgcn_readlane(idxv, 4 * (gq) + e_); \
                buf[e_] = *(const GAS u32x4*)((base) + (size_t)ix_ * F4_ROW + lane * 16); } } while (0)
#define F4_DOTG(buf, gq) do { _Pragma("unroll") for (int e_ = 0; e_ < 4; ++e_) { \
                f32x2 s0_ = f32x2{0.f, 0.f}, s1_ = f32x2{0.f, 0.f}; \
                _Pragma("unroll") for (int w_ = 0; w_ < 4; ++w_) { \
                    const unsigned d_ = buf[e_][w_]; f32x2 c0_, c1_, c2_, c3_; \
                    F4_CVT0(c0_, d_); F4_CVT1(c1_, d_); F4_CVT2(c2_, d_); F4_CVT3(c3_, d_); \
                    F8_PKFMA(s0_, c0_, xr[4 * w_]); F8_PKFMA(s1_, c1_, xr[4 * w_ + 1]); F8_PKFMA(s0_, c2_, xr[4 * w_ + 2]); F8_PKFMA(s1_, c3_, xr[4 * w_ + 3]); } \
                part[4 * (gq) + e_] = (s0_[0] + s0_[1]) + (s1_[0] + s1_[1]); } } while (0)
#define F4_ACCG(buf, gq) do { _Pragma("unroll") for (int e_ = 0; e_ < 4; ++e_) { \
                const unsigned wu_ = (unsigned)__builtin_amdgcn_readlane((int)__float_as_uint(w), 4 * (gq) + e_); \
                const unsigned long long wp_ = ((unsigned long long)wu_ << 32) | wu_; \
                _Pragma("unroll") for (int w_ = 0; w_ < 4; ++w_) { \
                    const unsigned d_ = buf[e_][w_]; f32x2 c0_, c1_, c2_, c3_; \
                    F4_CVT0(c0_, d_); F4_CVT1(c1_, d_); F4_CVT2(c2_, d_); F4_CVT3(c3_, d_); \
                    F8_PKFMA_S(acc[4 * w_], wp_, c0_); F8_PKFMA_S(acc[4 * w_ + 1], wp_, c1_); F8_PKFMA_S(acc[4 * w_ + 2], wp_, c2_); F8_PKFMA_S(acc[4 * w_ + 3], wp_, c3_); } } } while (0)
            F4_LOADG(ra, Ug, 0);
            F4_LOADG(rb, Ug, 1); F4_DOTG(ra, 0);
            F4_LOADG(ra, Ug, 2); F4_DOTG(rb, 1);
            F4_LOADG(rb, Ug, 3); F4_DOTG(ra, 2);
            F4_LOADG(ra, Vg, 0); F4_DOTG(rb, 3);
            float r8[8], r4[4], r2[2], h;
            { const bool hb = (lane & 8) != 0;
#pragma unroll
              for (int k = 0; k < 8; ++k) { const float keep = hb ? part[8 + k] : part[k], send = hb ? part[k] : part[8 + k]; r8[k] = keep + swz_xor<8>(send); } }
            { const bool hb = (lane & 4) != 0;
#pragma unroll
              for (int k = 0; k < 4; ++k) { const float keep = hb ? r8[4 + k] : r8[k], send = hb ? r8[k] : r8[4 + k]; r4[k] = keep + swz_xor<4>(send); } }
            { const bool hb = (lane & 2) != 0;
#pragma unroll
              for (int k = 0; k < 2; ++k) { const float keep = hb ? r4[2 + k] : r4[k], send = hb ? r4[k] : r4[2 + k]; r2[k] = keep + swz_xor<2>(send); } }
            { const bool hb = (lane & 1) != 0; const float keep = hb ? r2[1] : r2[0], send = hb ? r2[0] : r2[1]; h = keep + swz_xor<1>(send); }
            h += swz_xor<16>(h);
            { auto rr = __builtin_amdgcn_permlane32_swap(__float_as_uint(h), __float_as_uint(h), false, false); h = __uint_as_float(rr[0]) + __uint_as_float(rr[1]); }
            const float w = gv * gelu_tanh(h * suv) * svv;
            F4_LOADG(rb, Vg, 1); F4_ACCG(ra, 0);
            F4_LOADG(ra, Vg, 2); F4_ACCG(rb, 1);
            F4_LOADG(rb, Vg, 3); F4_ACCG(ra, 2);
            F4_ACCG(rb, 3);
#undef F4_LOADG
#undef F4_DOTG
#undef F4_ACCG
        }
        asm volatile("" : "+v"(lane));
        float s1 = 0.f;
#pragma unroll
        for (int k = 0; k < 16; ++k) { acc[k][0] = fmaf(ALPHA, xr[k][0], acc[k][0]); acc[k][1] = fmaf(ALPHA, xr[k][1], acc[k][1]); s1 += acc[k][0] + acc[k][1]; }
        const float mu = wsum(s1) * (1.f / D);
        float s2 = 0.f;
#pragma unroll
        for (int k = 0; k < 16; ++k) { const float d0 = acc[k][0] - mu, d1 = acc[k][1] - mu; s2 = fmaf(d0, d0, s2); s2 = fmaf(d1, d1, s2); }
        const float rstd = rsqrtf(wsum(s2) * (1.f / D) + LN_EPS);
        const float* gl_ = g; const float* bl_ = bb;
        asm volatile("" : "+s"(gl_), "+s"(bl_));
#pragma unroll
        for (int j = 0; j < 8; ++j) {
            const int col = 256 * j + lane * 4;
            const f32x4 g4 = *(const GAS f32x4*)((const GAS float*)gl_ + col), b4 = *(const GAS f32x4*)((const GAS float*)bl_ + col);
            f32x4 o4;
            o4[0] = (acc[2 * j][0] - mu) * rstd * g4[0] + b4[0]; o4[1] = (acc[2 * j][1] - mu) * rstd * g4[1] + b4[1];
            o4[2] = (acc[2 * j + 1][0] - mu) * rstd * g4[2] + b4[2]; o4[3] = (acc[2 * j + 1][1] - mu) * rstd * g4[3] + b4[3];
            *(GAS f32x4*)((GAS float*)dst + (size_t)row * D + col) = o4;
            *(GAS u32x2*)((GAS bf16_t*)xbout + (size_t)row * D + col) = u32x2{cvtpk(o4[0], o4[1]), cvtpk(o4[2], o4[3])};
        }
    }
}

__device__ __forceinline__ void peer_gather_f4s(const float* X, const int* __restrict__ IDX, const float* __restrict__ G,
                                               const unsigned char* __restrict__ U4, const unsigned char* __restrict__ V4,
                                               const float* __restrict__ SU, const float* __restrict__ SV,
                                               const float* __restrict__ g, const float* __restrict__ bb, float* dst, bf16_t* xbout) {
    const int tid_ = opaque_tid(); const int wave = __builtin_amdgcn_readfirstlane(tid_ >> 6);
    const GAS unsigned char* Ug = (const GAS unsigned char*)U4; const GAS unsigned char* Vg = (const GAS unsigned char*)V4;
    extern __shared__ __attribute__((aligned(16))) unsigned char gs_lds[];
    LAS int* kbuf = (LAS int*)((LAS unsigned char*)gs_lds + wave * 4096);
    LAS float* wbuf = (LAS float*)((LAS unsigned char*)gs_lds + wave * 4096 + 2048);
#pragma unroll 1
    for (int kt = 0; kt < 4; ++kt) {
        const int row = blockIdx.x * 8 + wave + kt * NBLK * 8;
        int lane = tid_ & 63; asm volatile("" : "+v"(lane));
        f32x2 xr[16];
#pragma unroll
        for (int j = 0; j < 8; ++j) {
            const f32x4 t4 = *(const GAS f32x4*)((const GAS float*)X + (size_t)row * D + 256 * j + lane * 4);
            xr[2 * j] = f32x2{t4[0], t4[1]}; xr[2 * j + 1] = f32x2{t4[2], t4[3]};
        }
        int k0 = (IDX[(size_t)row * 128 + lane] << 7) | lane, k1 = (IDX[(size_t)row * 128 + 64 + lane] << 7) | (64 + lane);
#define GS_STEP(SIZE, STRIDE) do { const int p0_ = swz_xor_i<STRIDE>(k0), p1_ = swz_xor_i<STRIDE>(k1); const bool lo_ = (lane & STRIDE) == 0; \
            const bool up0_ = (SIZE == 128) ? true : ((SIZE == 64) ? true : ((lane & SIZE) == 0)), up1_ = (SIZE == 128) ? true : ((SIZE == 64) ? false : ((lane & SIZE) == 0)); \
            k0 = (up0_ == lo_) ? imin(k0, p0_) : imax(k0, p0_); k1 = (up1_ == lo_) ? imin(k1, p1_) : imax(k1, p1_); } while (0)
#define GS_STEP32(SIZE) do { auto r0_ = __builtin_amdgcn_permlane32_swap((unsigned)k0, (unsigned)k0, false, false); auto r1_ = __builtin_amdgcn_permlane32_swap((unsigned)k1, (unsigned)k1, false, false); \
            const bool lo_ = (lane & 32) == 0; const int p0_ = lo_ ? (int)r0_[1] : (int)r0_[0], p1_ = lo_ ? (int)r1_[1] : (int)r1_[0]; \
            const bool up0_ = true, up1_ = (SIZE == 128); \
            k0 = (up0_ == lo_) ? imin(k0, p0_) : imax(k0, p0_); k1 = (up1_ == lo_) ? imin(k1, p1_) : imax(k1, p1_); } while (0)
        GS_STEP(2, 1);
        GS_STEP(4, 2); GS_STEP(4, 1);
        GS_STEP(8, 4); GS_STEP(8, 2); GS_STEP(8, 1);
        GS_STEP(16, 8); GS_STEP(16, 4); GS_STEP(16, 2); GS_STEP(16, 1);
        GS_STEP(32, 16); GS_STEP(32, 8); GS_STEP(32, 4); GS_STEP(32, 2); GS_STEP(32, 1);
        GS_STEP32(64); GS_STEP(64, 16); GS_STEP(64, 8); GS_STEP(64, 4); GS_STEP(64, 2); GS_STEP(64, 1);
        { const int a_ = imin(k0, k1), b_ = imax(k0, k1); k0 = a_; k1 = b_; }
        GS_STEP32(128); GS_STEP(128, 16); GS_STEP(128, 8); GS_STEP(128, 4); GS_STEP(128, 2); GS_STEP(128, 1);
#undef GS_STEP
#undef GS_STEP32
#pragma unroll 1
        for (int bt = 0; bt < 8; ++bt) {
            const int ksel = (bt & 4) ? k1 : k0;
            const int key = __builtin_amdgcn_ds_bpermute(4 * (16 * (bt & 3) + (lane & 15)), ksel);
            const int idxv = key >> 7;
            const float gv = G[(size_t)row * 128 + (key & 127)];
            const float suv = SU[idxv], svv = SV[idxv];
            float part[16];
            u32x4 ra[4], rb[4];
#define F4_LOADG(buf, base, gq) do { _Pragma("unroll") for (int e_ = 0; e_ < 4; ++e_) { \
                const int ix_ = __builtin_amdgcn_readlane(idxv, 4 * (gq) + e_); \
                buf[e_] = *(const GAS u32x4*)((base) + (size_t)ix_ * F4_ROW + lane * 16); } } while (0)
#define F4_DOTG(buf, gq) do { _Pragma("unroll") for (int e_ = 0; e_ < 4; ++e_) { \
                f32x2 s0_ = f32x2{0.f, 0.f}, s1_ = f32x2{0.f, 0.f}; \
                _Pragma("unroll") for (int w_ = 0; w_ < 4; ++w_) { \
                    const unsigned d_ = buf[e_][w_]; f32x2 c0_, c1_, c2_, c3_; \
                    F4_CVT0(c0_, d_); F4_CVT1(c1_, d_); F4_CVT2(c2_, d_); F4_CVT3(c3_, d_); \
                    F8_PKFMA(s0_, c0_, xr[4 * w_]); F8_PKFMA(s1_, c1_, xr[4 * w_ + 1]); F8_PKFMA(s0_, c2_, xr[4 * w_ + 2]); F8_PKFMA(s1_, c3_, xr[4 * w_ + 3]); } \
                part[4 * (gq) + e_] = (s0_[0] + s0_[1]) + (s1_[0] + s1_[1]); } } while (0)
#define F4_ACCG(buf, gq) do { _Pragma("unroll") for (int e_ = 0; e_ < 4; ++e_) { \
                const unsigned wu_ = (unsigned)__builtin_amdgcn_readlane((int)__float_as_uint(w), 4 * (gq) + e_); \
                const unsigned long long wp_ = ((unsigned long long)wu_ << 32) | wu_; \
                _Pragma("unroll") for (int w_ = 0; w_ < 4; ++w_) { \
                    const unsigned d_ = buf[e_][w_]; f32x2 c0_, c1_, c2_, c3_; \
                    F4_CVT0(c0_, d_); F4_CVT1(c1_, d_); F4_CVT2(c2_, d_); F4_CVT3(c3_, d_); \
                    F8_PKFMA_S(acc[4 * w_], wp_, c0_); F8_PKFMA_S(acc[4 * w_ + 1], wp_, c1_); F8_PKFMA_S(acc[4 * w_ + 2], wp_, c2_); F8_PKFMA_S(acc[4 * w_ + 3], wp_, c3_); } } } while (0)
            F4_LOADG(ra, Ug, 0);
            F4_LOADG(rb, Ug, 1); F4_DOTG(ra, 0);
            F4_LOADG(ra, Ug, 2); F4_DOTG(rb, 1);
            F4_LOADG(rb, Ug, 3); F4_DOTG(ra, 2);
            F4_DOTG(rb, 3);
            float r8[8], r4[4], r2[2], h;
            { const bool hb = (lane & 8) != 0;
#pragma unroll
              for (int k = 0; k < 8; ++k) { const float keep = hb ? part[8 + k] : part[k], send = hb ? part[k] : part[8 + k]; r8[k] = keep + swz_xor<8>(send); } }
            { const bool hb = (lane & 4) != 0;
#pragma unroll
              for (int k = 0; k < 4; ++k) { const float keep = hb ? r8[4 + k] : r8[k], send = hb ? r8[k] : r8[4 + k]; r4[k] = keep + swz_xor<4>(send); } }
            { const bool hb = (lane & 2) != 0;
#pragma unroll
              for (int k = 0; k < 2; ++k) { const float keep = hb ? r4[2 + k] : r4[k], send = hb ? r4[k] : r4[2 + k]; r2[k] = keep + swz_xor<2>(send); } }
            { const bool hb = (lane & 1) != 0; const float keep = hb ? r2[1] : r2[0], send = hb ? r2[0] : r2[1]; h = keep + swz_xor<1>(send); }
            h += swz_xor<16>(h);
            { auto rr = __builtin_amdgcn_permlane32_swap(__float_as_uint(h), __float_as_uint(h), false, false); h = __uint_as_float(rr[0]) + __uint_as_float(rr[1]); }
            const float w = gv * gelu_tanh(h * suv) * svv;
            if (lane < 16) { kbuf[kt * 128 + bt * 16 + lane] = idxv; wbuf[kt * 128 + bt * 16 + lane] = w; }
        }
    }
#pragma unroll 1
    for (int kt = 0; kt < 4; ++kt) {
        const int row = blockIdx.x * 8 + wave + kt * NBLK * 8;
        int lane = tid_ & 63; asm volatile("" : "+v"(lane));
        f32x2 acc[16];
#pragma unroll
        for (int k = 0; k < 16; ++k) acc[k] = f32x2{0.f, 0.f};
#pragma unroll 1
        for (int bt = 0; bt < 8; ++bt) {
            const int idxv = kbuf[kt * 128 + bt * 16 + (lane & 15)];
            const float w = wbuf[kt * 128 + bt * 16 + (lane & 15)];
            u32x4 ra[4], rb[4];
            F4_LOADG(ra, Vg, 0);
            F4_LOADG(rb, Vg, 1); F4_ACCG(ra, 0);
            F4_LOADG(ra, Vg, 2); F4_ACCG(rb, 1);
            F4_LOADG(rb, Vg, 3); F4_ACCG(ra, 2);
            F4_ACCG(rb, 3);
        }
#undef F4_LOADG
#undef F4_DOTG
#undef F4_ACCG
        asm volatile("" : "+v"(lane));
        f32x2 xr[16];
#pragma unroll
        for (int j = 0; j < 8; ++j) {
            const f32x4 t4 = *(const GAS f32x4*)((const GAS float*)X + (size_t)row * D + 256 * j + lane * 4);
            xr[2 * j] = f32x2{t4[0], t4[1]}; xr[2 * j + 1] = f32x2{t4[2], t4[3]};
        }
        float s1 = 0.f;
#pragma unroll
        for (int k = 0; k < 16; ++k) { acc[k][0] = fmaf(ALPHA, xr[k][0], acc[k][0]); acc[k][1] = fmaf(ALPHA, xr[k][1], acc[k][1]); s1 += acc[k][0] + acc[k][1]; }
        const float mu = wsum(s1) * (1.f / D);
        float s2 = 0.f;
#pragma unroll
        for (int k = 0; k < 16; ++k) { const float d0 = acc[k][0] - mu, d1 = acc[k][1] - mu; s2 = fmaf(d0, d0, s2); s2 = fmaf(d1, d1, s2); }
        const float rstd = rsqrtf(wsum(s2) * (1.f / D) + LN_EPS);
        const float* gl_ = g; const float* bl_ = bb;
        asm volatile("" : "+s"(gl_), "+s"(bl_));
#pragma unroll
        for (int j = 0; j < 8; ++j) {
            const int col = 256 * j + lane * 4;
            const f32x4 g4 = *(const GAS f32x4*)((const GAS float*)gl_ + col), b4 = *(const GAS f32x4*)((const GAS float*)bl_ + col);
            f32x4 o4;
            o4[0] = (acc[2 * j][0] - mu) * rstd * g4[0] + b4[0]; o4[1] = (acc[2 * j][1] - mu) * rstd * g4[1] + b4[1];
            o4[2] = (acc[2 * j + 1][0] - mu) * rstd * g4[2] + b4[2]; o4[3] = (acc[2 * j + 1][1] - mu) * rstd * g4[3] + b4[3];
            *(GAS f32x4*)((GAS float*)dst + (size_t)row * D + col) = o4;
            *(GAS u32x2*)((GAS bf16_t*)xbout + (size_t)row * D + col) = u32x2{cvtpk(o4[0], o4[1]), cvtpk(o4[2], o4[3])};
        }
    }
}

#define P4_LOAD(buf, base, key) buf = *(const GAS u32x4*)((base) + (size_t)((unsigned)(key) >> 7) * F4_ROW + lane * 16)
#define P4_DOT(B, res) do { f32x2 s0_ = f32x2{0.f, 0.f}, s1_ = f32x2{0.f, 0.f}; \
    _Pragma("unroll") for (int w_ = 0; w_ < 4; ++w_) { const unsigned d_ = B[w_]; f32x2 c0_, c1_, c2_, c3_; \
        F4_CVT0(c0_, d_); F4_CVT1(c1_, d_); F4_CVT2(c2_, d_); F4_CVT3(c3_, d_); \
        F8_PKFMA(s0_, c0_, xr[4 * w_]); F8_PKFMA(s1_, c1_, xr[4 * w_ + 1]); F8_PKFMA(s0_, c2_, xr[4 * w_ + 2]); F8_PKFMA(s1_, c3_, xr[4 * w_ + 3]); } \
    res = (s0_[0] + s0_[1]) + (s1_[0] + s1_[1]); } while (0)
#define P4_ACC(B, wp) do { \
    _Pragma("unroll") for (int w_ = 0; w_ < 4; ++w_) { const unsigned d_ = B[w_]; f32x2 c0_, c1_, c2_, c3_; \
        F4_CVT0(c0_, d_); F4_CVT1(c1_, d_); F4_CVT2(c2_, d_); F4_CVT3(c3_, d_); \
        F8_PKFMA_S(acc[4 * w_], wp, c0_); F8_PKFMA_S(acc[4 * w_ + 1], wp, c1_); F8_PKFMA_S(acc[4 * w_ + 2], wp, c2_); F8_PKFMA_S(acc[4 * w_ + 3], wp, c3_); } } while (0)
#define P4_FOR16(M) M(0) M(1) M(2) M(3) M(4) M(5) M(6) M(7) M(8) M(9) M(10) M(11) M(12) M(13) M(14) M(15)
__device__ __forceinline__ void peer_gather_f4p(const float* X, const int* __restrict__ IDX, const float* __restrict__ G,
                                                const unsigned char* __restrict__ U4, const unsigned char* __restrict__ V4,
                                                const float* __restrict__ SU, const float* __restrict__ SV,
                                                const float* __restrict__ g, const float* __restrict__ bb, float* dst, bf16_t* xbout) {
    extern __shared__ __attribute__((aligned(16))) unsigned char p4_lds[];
    const int tid_ = opaque_tid(); const int wave = __builtin_amdgcn_readfirstlane(tid_ >> 6);
    const GAS unsigned char* Ug = (const GAS unsigned char*)U4; const GAS unsigned char* Vg = (const GAS unsigned char*)V4;
    LAS int* keys = (LAS int*)((LAS unsigned char*)p4_lds + wave * 8192);
    LAS float* sub = (LAS float*)((LAS unsigned char*)p4_lds + wave * 8192 + 2048);
    LAS float* wbuf = (LAS float*)((LAS unsigned char*)p4_lds + wave * 8192 + 4096);
    u32x4 b0, b1, b2, b3, b4, b5, b6, b7, b8, b9, b10, b11, b12, b13, b14, b15;
#pragma unroll 1
    for (int kt = 0; kt < 4; ++kt) {
        const int row = blockIdx.x * 32 + wave * 4 + kt;
        int lane = tid_ & 63; asm volatile("" : "+v"(lane));
        int k0 = (IDX[(size_t)row * 128 + lane] << 7) | lane, k1 = (IDX[(size_t)row * 128 + 64 + lane] << 7) | (64 + lane);
#define GS_STEP(SIZE, STRIDE) do { const int p0_ = swz_xor_i<STRIDE>(k0), p1_ = swz_xor_i<STRIDE>(k1); const bool lo_ = (lane & STRIDE) == 0; \
            const bool up0_ = (SIZE == 128) ? true : ((SIZE == 64) ? true : ((lane & SIZE) == 0)), up1_ = (SIZE == 128) ? true : ((SIZE == 64) ? false : ((lane & SIZE) == 0)); \
            k0 = (up0_ == lo_) ? imin(k0, p0_) : imax(k0, p0_); k1 = (up1_ == lo_) ? imin(k1, p1_) : imax(k1, p1_); } while (0)
#define GS_STEP32(SIZE) do { auto r0_ = __builtin_amdgcn_permlane32_swap((unsigned)k0, (unsigned)k0, false, false); auto r1_ = __builtin_amdgcn_permlane32_swap((unsigned)k1, (unsigned)k1, false, false); \
            const bool lo_ = (lane & 32) == 0; const int p0_ = lo_ ? (int)r0_[1] : (int)r0_[0], p1_ = lo_ ? (int)r1_[1] : (int)r1_[0]; \
            const bool up0_ = true, up1_ = (SIZE == 128); \
            k0 = (up0_ == lo_) ? imin(k0, p0_) : imax(k0, p0_); k1 = (up1_ == lo_) ? imin(k1, p1_) : imax(k1, p1_); } while (0)
        GS_STEP(2, 1);
        GS_STEP(4, 2); GS_STEP(4, 1);
        GS_STEP(8, 4); GS_STEP(8, 2); GS_STEP(8, 1);
        GS_STEP(16, 8); GS_STEP(16, 4); GS_STEP(16, 2); GS_STEP(16, 1);
        GS_STEP(32, 16); GS_STEP(32, 8); GS_STEP(32, 4); GS_STEP(32, 2); GS_STEP(32, 1);
        GS_STEP32(64); GS_STEP(64, 16); GS_STEP(64, 8); GS_STEP(64, 4); GS_STEP(64, 2); GS_STEP(64, 1);
        { const int a_ = imin(k0, k1), b_ = imax(k0, k1); k0 = a_; k1 = b_; }
        GS_STEP32(128); GS_STEP(128, 16); GS_STEP(128, 8); GS_STEP(128, 4); GS_STEP(128, 2); GS_STEP(128, 1);
#undef GS_STEP
#undef GS_STEP32
        if (kt == 0) {
#define P4_L0(i) P4_LOAD(b##i, Ug, __builtin_amdgcn_readlane(k0, i));
            P4_FOR16(P4_L0)
#undef P4_L0
        }
        keys[kt * 128 + lane] = k0; keys[kt * 128 + 64 + lane] = k1;
        sub[kt * 128 + lane] = SU[k0 >> 7]; sub[kt * 128 + 64 + lane] = SU[k1 >> 7];
        wbuf[kt * 128 + lane] = G[(size_t)row * 128 + (k0 & 127)] * SV[k0 >> 7]; wbuf[kt * 128 + 64 + lane] = G[(size_t)row * 128 + (k1 & 127)] * SV[k1 >> 7];
    }
#pragma unroll 1
    for (int kt = 0; kt < 4; ++kt) {
        const int row = blockIdx.x * 32 + wave * 4 + kt;
        int lane = tid_ & 63; asm volatile("" : "+v"(lane));
        f32x2 xr[16];
#pragma unroll
        for (int j = 0; j < 8; ++j) {
            const f32x4 t4 = *(const GAS f32x4*)((const GAS float*)X + (size_t)row * D + 256 * j + lane * 4);
            xr[2 * j] = f32x2{t4[0], t4[1]}; xr[2 * j + 1] = f32x2{t4[2], t4[3]};
        }
        const int k0 = keys[kt * 128 + lane], k1 = keys[kt * 128 + 64 + lane];
        const int kn = keys[((kt + 1) & 3) * 128 + lane];
        const GAS unsigned char* nbase = (kt < 3) ? Ug : Vg;
        float part[16];
#define P4_RED(bt_) do { float r8[8], r4[4], r2[2], h; \
            { const bool hb = (lane & 8) != 0; _Pragma("unroll") for (int k = 0; k < 8; ++k) { const float keep = hb ? part[8 + k] : part[k], send = hb ? part[k] : part[8 + k]; r8[k] = keep + swz_xor<8>(send); } } \
            { const bool hb = (lane & 4) != 0; _Pragma("unroll") for (int k = 0; k < 4; ++k) { const float keep = hb ? r8[4 + k] : r8[k], send = hb ? r8[k] : r8[4 + k]; r4[k] = keep + swz_xor<4>(send); } } \
            { const bool hb = (lane & 2) != 0; _Pragma("unroll") for (int k = 0; k < 2; ++k) { const float keep = hb ? r4[2 + k] : r4[k], send = hb ? r4[k] : r4[2 + k]; r2[k] = keep + swz_xor<2>(send); } } \
            { const bool hb = (lane & 1) != 0; const float keep = hb ? r2[1] : r2[0], send = hb ? r2[0] : r2[1]; h = keep + swz_xor<1>(send); } \
            h += swz_xor<16>(h); \
            { auto rr = __builtin_amdgcn_permlane32_swap(__float_as_uint(h), __float_as_uint(h), false, false); h = __uint_as_float(rr[0]) + __uint_as_float(rr[1]); } \
            const int pp_ = kt * 128 + (bt_) * 16 + (lane & 15); \
            const float wq_ = wbuf[pp_] * gelu_tanh(h * sub[pp_]); \
            if (lane < 16) wbuf[pp_] = wq_; } while (0)
#pragma unroll 1
        for (int bt = 0; bt < 7; ++bt) {
            const int ksel = (bt + 1 < 4) ? k0 : k1;
            const int nb = (16 * (bt + 1)) & 63;
#define P4_U(i) { P4_DOT(b##i, part[i]); const int nk_ = __builtin_amdgcn_readlane(ksel, nb + i); P4_LOAD(b##i, Ug, nk_); }
            P4_FOR16(P4_U)
#undef P4_U
            P4_RED(bt);
        }
        {
#define P4_U(i) { P4_DOT(b##i, part[i]); const int nk_ = __builtin_amdgcn_readlane(kn, i); P4_LOAD(b##i, nbase, nk_); }
            P4_FOR16(P4_U)
#undef P4_U
            P4_RED(7);
        }
#undef P4_RED
    }
#pragma unroll 1
    for (int kt = 0; kt < 4; ++kt) {
        const int row = blockIdx.x * 32 + wave * 4 + kt;
        int lane = tid_ & 63; asm volatile("" : "+v"(lane));
        const int k0 = keys[kt * 128 + lane], k1 = keys[kt * 128 + 64 + lane];
        const int kn = keys[((kt + 1) & 3) * 128 + lane];
        f32x2 acc[16];
#pragma unroll
        for (int k = 0; k < 16; ++k) acc[k] = f32x2{0.f, 0.f};
#pragma unroll 1
        for (int bt = 0; bt < 7; ++bt) {
            const int ksel = (bt + 1 < 4) ? k0 : k1;
            const int nb = (16 * (bt + 1)) & 63;
            const float wreg = wbuf[kt * 128 + bt * 16 + (lane & 15)];
#define P4_V(i) { const unsigned wu_ = (unsigned)__builtin_amdgcn_readlane((int)__float_as_uint(wreg), i); const unsigned long long wp_ = ((unsigned long long)wu_ << 32) | wu_; \
              P4_ACC(b##i, wp_); const int nk_ = __builtin_amdgcn_readlane(ksel, nb + i); P4_LOAD(b##i, Vg, nk_); }
            P4_FOR16(P4_V)
#undef P4_V
        }
        {
            const float wreg = wbuf[kt * 128 + 7 * 16 + (lane & 15)];
            if (kt < 3) {
#define P4_V(i) { const unsigned wu_ = (unsigned)__builtin_amdgcn_readlane((int)__float_as_uint(wreg), i); const unsigned long long wp_ = ((unsigned long long)wu_ << 32) | wu_; \
              P4_ACC(b##i, wp_); const int nk_ = __builtin_amdgcn_readlane(kn, i); P4_LOAD(b##i, Vg, nk_); }
                P4_FOR16(P4_V)
#undef P4_V
            } else {
#define P4_V(i) { const unsigned wu_ = (unsigned)__builtin_amdgcn_readlane((int)__float_as_uint(wreg), i); const unsigned long long wp_ = ((unsigned long long)wu_ << 32) | wu_; \
              P4_ACC(b##i, wp_); }
                P4_FOR16(P4_V)
#undef P4_V
            }
        }
        asm volatile("" : "+v"(lane));
        f32x2 xr[16];
#pragma unroll
        for (int j = 0; j < 8; ++j) {
            const f32x4 t4 = *(const GAS f32x4*)((const GAS float*)X + (size_t)row * D + 256 * j + lane * 4);
            xr[2 * j] = f32x2{t4[0], t4[1]}; xr[2 * j + 1] = f32x2{t4[2], t4[3]};
        }
        float s1 = 0.f;
#pragma unroll
        for (int k = 0; k < 16; ++k) { acc[k][0] = fmaf(ALPHA, xr[k][0], acc[k][0]); acc[k][1] = fmaf(ALPHA, xr[k][1], acc[k][1]); s1 += acc[k][0] + acc[k][1]; }
        const float mu = wsum(s1) * (1.f / D);
        float s2 = 0.f;
#pragma unroll
        for (int k = 0; k < 16; ++k) { const float d0 = acc[k][0] - mu, d1 = acc[k][1] - mu; s2 = fmaf(d0, d0, s2); s2 = fmaf(d1, d1, s2); }
        const float rstd = rsqrtf(wsum(s2) * (1.f / D) + LN_EPS);
        const float* gl_ = g; const float* bl_ = bb;
        asm volatile("" : "+s"(gl_), "+s"(bl_));
#pragma unroll
        for (int j = 0; j < 8; ++j) {
            const int col = 256 * j + lane * 4;
            const f32x4 g4 = *(const GAS f32x4*)((const GAS float*)gl_ + col), b4 = *(const GAS f32x4*)((const GAS float*)bl_ + col);
            f32x4 o4;
            o4[0] = (acc[2 * j][0] - mu) * rstd * g4[0] + b4[0]; o4[1] = (acc[2 * j][1] - mu) * rstd * g4[1] + b4[1];
            o4[2] = (acc[2 * j + 1][0] - mu) * rstd * g4[2] + b4[2]; o4[3] = (acc[2 * j + 1][1] - mu) * rstd * g4[3] + b4[3];
            *(GAS f32x4*)((GAS float*)dst + (size_t)row * D + col) = o4;
            *(GAS u32x2*)((GAS bf16_t*)xbout + (size_t)row * D + col) = u32x2{cvtpk(o4[0], o4[1]), cvtpk(o4[2], o4[3])};
        }
    }
}
#undef P4_LOAD
#undef P4_DOT
#undef P4_ACC
#undef P4_FOR16

template <int NR, int SIZE, int STRIDE> __device__ __forceinline__ void sort512_stage(int (&k)[NR], int lane) {
    if constexpr (STRIDE >= 64) {
        constexpr int RS = STRIDE / 64;
#pragma unroll
        for (int r = 0; r < NR; ++r) if ((r & RS) == 0) {
            const bool up = (((r * 64) & SIZE) == 0);
            const int a = k[r], b = k[r | RS], mn = imin(a, b), mx = imax(a, b);
            k[r] = up ? mn : mx; k[r | RS] = up ? mx : mn;
        }
    } else if constexpr (STRIDE == 32) {
        const bool lo = (lane & 32) == 0;
#pragma unroll
        for (int r = 0; r < NR; ++r) {
            auto rr = __builtin_amdgcn_permlane32_swap((unsigned)k[r], (unsigned)k[r], false, false);
            const int pv = lo ? (int)rr[1] : (int)rr[0];
            const bool up = (((r * 64) & SIZE) == 0);
            k[r] = (up == lo) ? imin(k[r], pv) : imax(k[r], pv);
        }
    } else {
        const bool lo = (lane & STRIDE) == 0;
#pragma unroll
        for (int r = 0; r < NR; ++r) {
            const int pv = swz_xor_i<STRIDE>(k[r]);
            const bool up = (SIZE >= 64) ? (((r * 64) & SIZE) == 0) : ((lane & SIZE) == 0);
            k[r] = (up == lo) ? imin(k[r], pv) : imax(k[r], pv);
        }
    }
}
template <int NR, int SIZE, int STRIDE> struct Sort512 {
    static __device__ __forceinline__ void run(int (&k)[NR], int lane) {
        sort512_stage<NR, SIZE, STRIDE>(k, lane);
        if constexpr (STRIDE > 1) Sort512<NR, SIZE, STRIDE / 2>::run(k, lane);
        else if constexpr (SIZE < NR * 64) Sort512<NR, SIZE * 2, SIZE>::run(k, lane);
    }
};
#define SW_CVT8(c, w) f32x2 c##0, c##1, c##2, c##3, c##4, c##5, c##6, c##7; \
    F8_CVT_LO(c##0, w[0]); F8_CVT_HI(c##1, w[0]); F8_CVT_LO(c##2, w[1]); F8_CVT_HI(c##3, w[1]); F8_CVT_LO(c##4, w[2]); F8_CVT_HI(c##5, w[2]); F8_CVT_LO(c##6, w[3]); F8_CVT_HI(c##7, w[3])
#define SW_DOT(XR, Ba, Bb, res) do { f32x2 s0_ = f32x2{0.f, 0.f}, s1_ = f32x2{0.f, 0.f}; \
    { SW_CVT8(ca_, Ba); F8_PKFMA(s0_, ca_0, XR[0]); F8_PKFMA(s1_, ca_1, XR[1]); F8_PKFMA(s0_, ca_2, XR[2]); F8_PKFMA(s1_, ca_3, XR[3]); \
      F8_PKFMA(s0_, ca_4, XR[4]); F8_PKFMA(s1_, ca_5, XR[5]); F8_PKFMA(s0_, ca_6, XR[6]); F8_PKFMA(s1_, ca_7, XR[7]); } \
    { SW_CVT8(cb_, Bb); F8_PKFMA(s0_, cb_0, XR[8]); F8_PKFMA(s1_, cb_1, XR[9]); F8_PKFMA(s0_, cb_2, XR[10]); F8_PKFMA(s1_, cb_3, XR[11]); \
      F8_PKFMA(s0_, cb_4, XR[12]); F8_PKFMA(s1_, cb_5, XR[13]); F8_PKFMA(s0_, cb_6, XR[14]); F8_PKFMA(s1_, cb_7, XR[15]); } \
    res = (s0_[0] + s0_[1]) + (s1_[0] + s1_[1]); } while (0)
#define SW_ACC(AC, Ba, Bb, wp) do { \
    { SW_CVT8(ca_, Ba); F8_PKFMA_S(AC[0], wp, ca_0); F8_PKFMA_S(AC[1], wp, ca_1); F8_PKFMA_S(AC[2], wp, ca_2); F8_PKFMA_S(AC[3], wp, ca_3); \
      F8_PKFMA_S(AC[4], wp, ca_4); F8_PKFMA_S(AC[5], wp, ca_5); F8_PKFMA_S(AC[6], wp, ca_6); F8_PKFMA_S(AC[7], wp, ca_7); } \
    { SW_CVT8(cb_, Bb); F8_PKFMA_S(AC[8], wp, cb_0); F8_PKFMA_S(AC[9], wp, cb_1); F8_PKFMA_S(AC[10], wp, cb_2); F8_PKFMA_S(AC[11], wp, cb_3); \
      F8_PKFMA_S(AC[12], wp, cb_4); F8_PKFMA_S(AC[13], wp, cb_5); F8_PKFMA_S(AC[14], wp, cb_6); F8_PKFMA_S(AC[15], wp, cb_7); } } while (0)
__device__ __forceinline__ void peer_gather_sweep(const float* X, const int* __restrict__ IDX, const float* __restrict__ G,
                                                  const unsigned char* __restrict__ U8, const unsigned char* __restrict__ V8,
                                                  const float* __restrict__ SU, const float* __restrict__ SV,
                                                  const float* __restrict__ g, const float* __restrict__ bb, float* dst, bf16_t* xbout) {
    extern __shared__ __attribute__((aligned(16))) unsigned char sw_lds[];
    const int tid_ = opaque_tid(); const int wave = __builtin_amdgcn_readfirstlane(tid_ >> 6);
    int* keys = (int*)(sw_lds + wave * 12800);
    float* wbuf = (float*)(sw_lds + wave * 12800 + 2048);
    float* part = (float*)(sw_lds + wave * 12800 + 4096);
    const GAS unsigned char* Ug = (const GAS unsigned char*)U8; const GAS unsigned char* Vg = (const GAS unsigned char*)V8;
    for (int tb = blockIdx.x * 8 + wave; tb < T / 2; tb += NBLK * 8) {
        int lane = tid_ & 63; asm volatile("" : "+v"(lane));
        const int row0 = tb * 2;
        {
            int k[4];
#pragma unroll
            for (int r = 0; r < 4; ++r) { const int t = r >> 1, slot = (r & 1) * 64 + lane; k[r] = (IDX[(size_t)(row0 + t) * 128 + slot] << 9) | (t << 7) | slot; }
            Sort512<4, 2, 1>::run(k, lane);
#pragma unroll
            for (int r = 0; r < 4; ++r) keys[r * 64 + lane] = k[r];
        }
#define SW_KEY(p) __builtin_amdgcn_readfirstlane(keys[p])
#define SW_LOAD(Ba, Bb, base, p) do { const int key_ = SW_KEY(p); const GAS unsigned char* p_ = (base) + (size_t)(key_ >> 9) * D + lane * 16; \
        Ba = *(const GAS u32x4*)(p_); Bb = *(const GAS u32x4*)(p_ + 1024); } while (0)
        {
            f32x2 xr0[16], xr1[16];
#define SW_LDX(XR, t) do { _Pragma("unroll") for (int i = 0; i < 2; ++i) _Pragma("unroll") for (int q = 0; q < 4; ++q) { \
                const f32x4 t4 = *(const GAS f32x4*)((const GAS float*)X + (size_t)(row0 + t) * D + i * 1024 + lane * 16 + 4 * q); \
                XR[8 * i + 2 * q] = f32x2{t4[0], t4[1]}; XR[8 * i + 2 * q + 1] = f32x2{t4[2], t4[3]}; } } while (0)
            __builtin_amdgcn_sched_barrier(0); SW_LDX(xr0, 0); SW_LDX(xr1, 1); __builtin_amdgcn_sched_barrier(0);
            u32x4 a0, b0, a1, b1, a2, b2, a3, b3;
            SW_LOAD(a0, b0, Ug, 0); SW_LOAD(a1, b1, Ug, 1); SW_LOAD(a2, b2, Ug, 2); SW_LOAD(a3, b3, Ug, 3);
#define SW_UPAIR(Ba, Bb, p) do { const int key_ = SW_KEY(p); const int t_ = (key_ >> 7) & 1; float res_; \
            if (t_ == 0) SW_DOT(xr0, Ba, Bb, res_); else SW_DOT(xr1, Ba, Bb, res_); \
            part[((p) & 31) * 65 + lane] = res_; } while (0)
#pragma unroll 1
            for (int p = 0; p < 256; p += 4) {
                SW_UPAIR(a0, b0, p);     if (p + 4 < 256) SW_LOAD(a0, b0, Ug, p + 4);
                SW_UPAIR(a1, b1, p + 1); if (p + 5 < 256) SW_LOAD(a1, b1, Ug, p + 5);
                SW_UPAIR(a2, b2, p + 2); if (p + 6 < 256) SW_LOAD(a2, b2, Ug, p + 6);
                SW_UPAIR(a3, b3, p + 3); if (p + 7 < 256) SW_LOAD(a3, b3, Ug, p + 7);
                if ((p & 31) == 28) {
                    const int q = lane & 31, hf = lane >> 5;
                    float sum = 0.f;
#pragma unroll
                    for (int kk = 0; kk < 32; ++kk) sum += part[q * 65 + 32 * hf + kk];
                    { auto rr = __builtin_amdgcn_permlane32_swap(__float_as_uint(sum), __float_as_uint(sum), false, false); sum = __uint_as_float(rr[0]) + __uint_as_float(rr[1]); }
                    const int pp = (p - 28) + q, kq = keys[pp], iq = kq >> 9;
                    const float gq = G[(size_t)(row0 + ((kq >> 7) & 1)) * 128 + (kq & 127)];
                    const float wq = gq * gelu_tanh(sum * SU[iq]) * SV[iq];
                    if (hf == 0) wbuf[pp] = wq;
                }
            }
#undef SW_UPAIR
#undef SW_LDX
        }
        f32x2 ac0[16], ac1[16];
#pragma unroll
        for (int k = 0; k < 16; ++k) { ac0[k] = f32x2{0.f, 0.f}; ac1[k] = f32x2{0.f, 0.f}; }
        {
            u32x4 a0, b0, a1, b1, a2, b2, a3, b3;
            SW_LOAD(a0, b0, Vg, 0); SW_LOAD(a1, b1, Vg, 1); SW_LOAD(a2, b2, Vg, 2); SW_LOAD(a3, b3, Vg, 3);
#define SW_VPAIR(Ba, Bb, p) do { const int key_ = SW_KEY(p); const int t_ = (key_ >> 7) & 1; \
            const unsigned wu_ = (unsigned)__builtin_amdgcn_readfirstlane((int)__float_as_uint(wbuf[p])); const unsigned long long wp_ = ((unsigned long long)wu_ << 32) | wu_; \
            if (t_ == 0) SW_ACC(ac0, Ba, Bb, wp_); else SW_ACC(ac1, Ba, Bb, wp_); } while (0)
#pragma unroll 1
            for (int p = 0; p < 256; p += 4) {
                SW_VPAIR(a0, b0, p);     if (p + 4 < 256) SW_LOAD(a0, b0, Vg, p + 4);
                SW_VPAIR(a1, b1, p + 1); if (p + 5 < 256) SW_LOAD(a1, b1, Vg, p + 5);
                SW_VPAIR(a2, b2, p + 2); if (p + 6 < 256) SW_LOAD(a2, b2, Vg, p + 6);
                SW_VPAIR(a3, b3, p + 3); if (p + 7 < 256) SW_LOAD(a3, b3, Vg, p + 7);
            }
#undef SW_VPAIR
        }
#define SW_LN(AC, t) do { asm volatile("" : "+v"(lane)); const int row = row0 + t; float s1 = 0.f; \
            _Pragma("unroll") for (int i = 0; i < 2; ++i) _Pragma("unroll") for (int q = 0; q < 4; ++q) { \
                const f32x4 t4 = *(const GAS f32x4*)((const GAS float*)X + (size_t)row * D + i * 1024 + lane * 16 + 4 * q); \
                AC[8 * i + 2 * q][0] = fmaf(ALPHA, t4[0], AC[8 * i + 2 * q][0]); AC[8 * i + 2 * q][1] = fmaf(ALPHA, t4[1], AC[8 * i + 2 * q][1]); \
                AC[8 * i + 2 * q + 1][0] = fmaf(ALPHA, t4[2], AC[8 * i + 2 * q + 1][0]); AC[8 * i + 2 * q + 1][1] = fmaf(ALPHA, t4[3], AC[8 * i + 2 * q + 1][1]); } \
            _Pragma("unroll") for (int k = 0; k < 16; ++k) s1 += AC[k][0] + AC[k][1]; \
            const float mu = wsum(s1) * (1.f / D); float s2 = 0.f; \
            _Pragma("unroll") for (int k = 0; k < 16; ++k) { const float d0 = AC[k][0] - mu, d1 = AC[k][1] - mu; s2 = fmaf(d0, d0, s2); s2 = fmaf(d1, d1, s2); } \
            const float rstd = rsqrtf(wsum(s2) * (1.f / D) + LN_EPS); \
            const float* gl_ = g; const float* bl_ = bb; asm volatile("" : "+s"(gl_), "+s"(bl_)); \
            _Pragma("unroll") for (int i = 0; i < 2; ++i) { float o[16]; \
                _Pragma("unroll") for (int q = 0; q < 4; ++q) { const int col = i * 1024 + lane * 16 + 4 * q; \
                    const f32x4 g4 = *(const GAS f32x4*)((const GAS float*)gl_ + col), b4 = *(const GAS f32x4*)((const GAS float*)bl_ + col); f32x4 o4; \
                    o4[0] = (AC[8 * i + 2 * q][0] - mu) * rstd * g4[0] + b4[0]; o4[1] = (AC[8 * i + 2 * q][1] - mu) * rstd * g4[1] + b4[1]; \
                    o4[2] = (AC[8 * i + 2 * q + 1][0] - mu) * rstd * g4[2] + b4[2]; o4[3] = (AC[8 * i + 2 * q + 1][1] - mu) * rstd * g4[3] + b4[3]; \
                    o[4 * q] = o4[0]; o[4 * q + 1] = o4[1]; o[4 * q + 2] = o4[2]; o[4 * q + 3] = o4[3]; \
                    *(GAS f32x4*)((GAS float*)dst + (size_t)row * D + col) = o4; } \
                *(GAS u32x4*)((GAS bf16_t*)xbout + (size_t)row * D + i * 1024 + lane * 16) = u32x4{cvtpk(o[0], o[1]), cvtpk(o[2], o[3]), cvtpk(o[4], o[5]), cvtpk(o[6], o[7])}; \
                *(GAS u32x4*)((GAS bf16_t*)xbout + (size_t)row * D + i * 1024 + lane * 16 + 8) = u32x4{cvtpk(o[8], o[9]), cvtpk(o[10], o[11]), cvtpk(o[12], o[13]), cvtpk(o[14], o[15])}; } } while (0)
        __builtin_amdgcn_sched_barrier(0); SW_LN(ac0, 0); __builtin_amdgcn_sched_barrier(0); SW_LN(ac1, 1); __builtin_amdgcn_sched_barrier(0);
#undef SW_LN
#undef SW_LOAD
#undef SW_KEY
    }
}

struct ColGate { __device__ __forceinline__ int operator()(int n) const { return n < 8 ? 3072 + n : -1; } };
struct ColKpe  { __device__ __forceinline__ int operator()(int n) const { return 1024 + n; } };
template <int NB_, int MODE>
__device__ __forceinline__ void skinny_mfma(const bf16_t* __restrict__ Xb, const bf16_t* __restrict__ Ws, float* __restrict__ GL,
                                            const float2* __restrict__ R64, bf16_t* __restrict__ km, float* __restrict__ tot_out = nullptr, const float* __restrict__ bfg = nullptr) {
    extern __shared__ __attribute__((aligned(16))) unsigned char sk_lds[];
    const int tid_ = opaque_tid(); const int wave = tid_ >> 6, lane = tid_ & 63, c = lane & 31, hi = lane >> 5;
    float* part = (float*)sk_lds;
    for (int tile = blockIdx.x; tile < T / 32; tile += NBLK) {
        const int tok = tile * 32 + c;
        f32x16 acc[NB_];
#pragma unroll
        for (int nb = 0; nb < NB_; ++nb)
#pragma unroll
            for (int r = 0; r < 16; ++r) acc[nb][r] = 0.f;
        const GAS bf16_t* xp = (const GAS bf16_t*)Xb + (size_t)tok * D + wave * 256 + 8 * hi;
        const GAS bf16_t* wp = (const GAS bf16_t*)Ws + (size_t)c * D + wave * 256 + 8 * hi;
#pragma unroll
        for (int s = 0; s < 16; ++s) {
            const bf16x8 xf = *(const GAS bf16x8*)(xp + 16 * s);
#pragma unroll
            for (int nb = 0; nb < NB_; ++nb)
                acc[nb] = __builtin_amdgcn_mfma_f32_32x32x16_bf16(*(const GAS bf16x8*)(wp + (size_t)nb * 32 * D + 16 * s), xf, acc[nb], 0, 0, 0);
        }
        if (wave != 0) {
#pragma unroll
            for (int nb = 0; nb < NB_; ++nb)
#pragma unroll
                for (int r = 0; r < 16; ++r) part[((wave * NB_ + nb) * 16 + r) * 64 + lane] = acc[nb][r];
        }
        __syncthreads();
        if (wave == 0) {
#pragma unroll 1
            for (int w = 1; w < 8; ++w)
#pragma unroll
                for (int nb = 0; nb < NB_; ++nb)
#pragma unroll
                    for (int r = 0; r < 16; ++r) acc[nb][r] += part[((w * NB_ + nb) * 16 + r) * 64 + lane];
            if (MODE == 0) {
                const int sq = tok & 4095, b = tok >> 12;
                float ls[4];
#pragma unroll
                for (int e = 0; e < 4; ++e) { const float z = acc[0][e] + bfg[4 * hi + e]; ls[e] = fminf(z, 0.f) - log1pf(expf(-fabsf(z))); }
#pragma unroll
                for (int d_ = 1; d_ < 32; d_ <<= 1)
#pragma unroll
                    for (int e = 0; e < 4; ++e) {
                        const float t_ = __int_as_float(__builtin_amdgcn_ds_bpermute((lane - d_) * 4, __float_as_int(ls[e])));
                        if (c >= d_) ls[e] += t_;
                    }
#pragma unroll
                for (int e = 0; e < 4; ++e) {
                    GL[(size_t)(b * 8 + 4 * hi + e) * S + sq] = ls[e] * LOG2E;
                    if (c == 31) tot_out[(b * 8 + 4 * hi + e) * 128 + (sq >> 5)] = ls[e] * LOG2E;
                }
            } else {
                const int sq = tok & 4095, b = tok >> 12;
#pragma unroll
                for (int gq = 0; gq < 4; ++gq) {
                    float o1[4], o2[4];
#pragma unroll
                    for (int e = 0; e < 4; ++e) {
                        const int i = 4 * hi + 8 * gq + e;
                        const float2 cs = R64[sq * 32 + i];
                        const float x1 = acc[0][4 * gq + e], x2 = acc[NB_ - 1][4 * gq + e];
                        o1[e] = x1 * cs.x - x2 * cs.y; o2[e] = x2 * cs.x + x1 * cs.y;
                    }
                    const u32x2 p1 = u32x2{cvtpk(o1[0], o1[1]), cvtpk(o1[2], o1[3])}, p2 = u32x2{cvtpk(o2[0], o2[1]), cvtpk(o2[2], o2[3])};
#pragma unroll
                    for (int h = 0; h < 8; ++h) {
                        GAS bf16_t* kp = (GAS bf16_t*)km + ((size_t)(b * 8 + h) * S + sq) * 192 + 128 + 4 * hi + 8 * gq;
                        *(GAS u32x2*)kp = p1; *(GAS u32x2*)(kp + 32) = p2;
                    }
                }
            }
        }
        __syncthreads();
    }
}

struct EpiBf16 {
    bf16_t* C; int ldc;
    __device__ __forceinline__ void operator()(const f32x4 (&acc)[2][2][4][2], int brow, int bcol, int wr, int wc, int fr, int fq) const {
#pragma unroll
        for (int ai = 0; ai < 2; ++ai)
#pragma unroll
            for (int m = 0; m < 4; ++m)
#pragma unroll
                for (int j = 0; j < 4; ++j)
#pragma unroll
                    for (int bj = 0; bj < 2; ++bj)
                        *(GAS unsigned*)(C + (size_t)(brow + ai * 128 + wr * 64 + m * 16 + fq * 4 + j) * ldc + bcol + bj * 128 + wc * 32 + 2 * fr) = cvtpk(acc[ai][bj][m][0][j], acc[ai][bj][m][1][j]);
    }
};
template <int N, int M> __device__ __forceinline__ void rs_step(const float (&in)[N], float (&out)[N / 2], bool hb) {
#pragma unroll
    for (int k = 0; k < N / 2; ++k) { const float keep = hb ? in[N / 2 + k] : in[k], send = hb ? in[k] : in[N / 2 + k]; out[k] = keep + swz_xor<M>(send); }
}
struct EpiLnRes {
    const float* Xin; float* X; bf16_t* Xb; const float* g; const float* b; unsigned long long* stats; unsigned* cnt; unsigned* tmo;
    __device__ __forceinline__ void operator()(f32x4 (&acc)[2][2][4][2], int brow, int bcol, int wr, int wc, int fr, int fq) const {
        extern __shared__ __attribute__((aligned(16))) unsigned char e_lds[];
        GAS float* Xg = (GAS float*)X; const GAS float* Xi = (const GAS float*)Xin;
#pragma unroll
        for (int ai = 0; ai < 2; ++ai)
#pragma unroll
            for (int m = 0; m < 4; ++m)
#pragma unroll
                for (int j = 0; j < 4; ++j)
#pragma unroll
                    for (int bj = 0; bj < 2; ++bj) {
                        const f32x2 xv = *(const GAS f32x2*)(Xi + (size_t)(brow + ai * 128 + wr * 64 + m * 16 + fq * 4 + j) * D + bcol + bj * 128 + wc * 32 + 2 * fr);
                        acc[ai][bj][m][0][j] = fmaf(ALPHA, xv[0], acc[ai][bj][m][0][j]); acc[ai][bj][m][1][j] = fmaf(ALPHA, xv[1], acc[ai][bj][m][1][j]);
                    }
        float s2[2], q2[2];
        {
            float s[32], q[32];
#pragma unroll
            for (int ai = 0; ai < 2; ++ai)
#pragma unroll
                for (int m = 0; m < 4; ++m)
#pragma unroll
                    for (int j = 0; j < 4; ++j) {
                        const float a0 = acc[ai][0][m][0][j], a1 = acc[ai][0][m][1][j], a2 = acc[ai][1][m][0][j], a3 = acc[ai][1][m][1][j];
                        s[(ai * 4 + m) * 4 + j] = (a0 + a1) + (a2 + a3); q[(ai * 4 + m) * 4 + j] = fmaf(a0, a0, fmaf(a1, a1, fmaf(a2, a2, a3 * a3)));
                    }
            float s16[16], q16[16], s8[8], q8[8], s4[4], q4[4];
            rs_step<32, 8>(s, s16, (fr & 8) != 0); rs_step<32, 8>(q, q16, (fr & 8) != 0);
            rs_step<16, 4>(s16, s8, (fr & 4) != 0); rs_step<16, 4>(q16, q8, (fr & 4) != 0);
            rs_step<8, 2>(s8, s4, (fr & 2) != 0); rs_step<8, 2>(q8, q4, (fr & 2) != 0);
            rs_step<4, 1>(s4, s2, (fr & 1) != 0); rs_step<4, 1>(q4, q2, (fr & 1) != 0);
        }
#pragma unroll
        for (int k = 0; k < 2; ++k) {
            const int R = (fr >> 3) * 128 + wr * 64 + ((fr >> 1) & 3) * 16 + fq * 4 + 2 * (fr & 1) + k;
            *(LAS f32x2*)((LAS unsigned char*)e_lds + (R * 4 + wc) * 8) = f32x2{s2[k], q2[k]};
        }
        __syncthreads();
        const int tid = (wr * 4 + wc) * 64 + fq * 16 + fr;
        GAS unsigned long long* sg = (GAS unsigned long long*)stats + (size_t)(brow + (tid & 255)) * 8;
        if (tid < 256) {
            const f32x4 a = *(const LAS f32x4*)((LAS unsigned char*)e_lds + tid * 32), c = *(const LAS f32x4*)((LAS unsigned char*)e_lds + tid * 32 + 16);
            const float S = (a[0] + a[2]) + (c[0] + c[2]), Q = (a[1] + a[3]) + (c[1] + c[3]);
            __hip_atomic_store(sg + (bcol >> 8), ((unsigned long long)__float_as_uint(Q) << 32) | (unsigned long long)__float_as_uint(S), __ATOMIC_RELAXED, __HIP_MEMORY_SCOPE_AGENT);
        }
        asm volatile("s_waitcnt vmcnt(0)" ::: "memory");
        __syncthreads();
        if (tid == 0) {
            unsigned* c_ = cnt + (brow >> 8) * 16;
            (void)xb_add(c_, 1u);
            unsigned sp = 0;
            while (xb_ld(c_) < 8u) {
                __builtin_amdgcn_s_sleep(1);
                if ((++sp & 255u) == 0u) { if (xb_ld(tmo)) break; if (sp > XB_SPIN_CAP) { atomicAdd(tmo, 1u); break; } }
            }
        }
        __syncthreads();
        if (tid < 256) {
            float S = 0.f, Q = 0.f;
#pragma unroll
            for (int c = 0; c < 8; ++c) {
                const unsigned long long v = __hip_atomic_load(sg + c, __ATOMIC_RELAXED, __HIP_MEMORY_SCOPE_AGENT);
                S += __uint_as_float((unsigned)v); Q += __uint_as_float((unsigned)(v >> 32));
            }
            const float mu = S * (1.f / D), var = fmaxf(Q * (1.f / D) - mu * mu, 0.f);
            *(LAS f32x2*)((LAS unsigned char*)e_lds + 8192 + tid * 8) = f32x2{mu, rsqrtf(var + LN_EPS)};
        }
        __syncthreads();
        f32x2 g2[2], b2[2];
#pragma unroll
        for (int bj = 0; bj < 2; ++bj) {
            g2[bj] = *(const GAS f32x2*)((const GAS float*)g + bcol + bj * 128 + wc * 32 + 2 * fr);
            b2[bj] = *(const GAS f32x2*)((const GAS float*)b + bcol + bj * 128 + wc * 32 + 2 * fr);
        }
#pragma unroll
        for (int ai = 0; ai < 2; ++ai)
#pragma unroll
            for (int m = 0; m < 4; ++m)
#pragma unroll
                for (int j = 0; j < 4; ++j) {
                    const int R = ai * 128 + wr * 64 + m * 16 + fq * 4 + j;
                    const f32x2 mr = *(const LAS f32x2*)((LAS unsigned char*)e_lds + 8192 + R * 8);
#pragma unroll
                    for (int bj = 0; bj < 2; ++bj) {
                        const float o0 = (acc[ai][bj][m][0][j] - mr[0]) * mr[1] * g2[bj][0] + b2[bj][0], o1 = (acc[ai][bj][m][1][j] - mr[0]) * mr[1] * g2[bj][1] + b2[bj][1];
                        const size_t off = (size_t)(brow + R) * D + bcol + bj * 128 + wc * 32 + 2 * fr;
                        *(GAS f32x2*)(Xg + off) = f32x2{o0, o1};
                        *(GAS unsigned*)((GAS bf16_t*)Xb + off) = cvtpk(o0, o1);
                    }
                }
    }
};
template <int MASK> __device__ __forceinline__ int f2key(float f, int payload) { int b = __float_as_int(f); b ^= (b >> 31) & 0x7fffffff; return (b & ~MASK) | payload; }
template <int MASK> __device__ __forceinline__ float key2f(int k) { int b = k & ~MASK; b ^= (b >> 31) & 0x7fffffff; return __int_as_float(b); }
template <int N, int MAXSZ> __device__ __forceinline__ void bitonic_blocks(int (&k)[N]) {
#pragma unroll
    for (int size = 2; size <= MAXSZ; size <<= 1)
#pragma unroll
        for (int stride = size >> 1; stride > 0; stride >>= 1)
#pragma unroll
            for (int i = 0; i < N; ++i) {
                const int j = i ^ stride;
                if (j > i) { const bool desc = ((i & size) == 0); const int a = k[i], b = k[j], mx = imax(a, b), mn = imin(a, b); k[i] = desc ? mx : mn; k[j] = desc ? mn : mx; }
            }
}
template <bool DESC> __device__ __forceinline__ void bitonic_sort16(int (&k)[16]) {
#pragma unroll
    for (int size = 2; size <= 16; size <<= 1)
#pragma unroll
        for (int stride = size >> 1; stride > 0; stride >>= 1)
#pragma unroll
            for (int i = 0; i < 16; ++i) {
                const int j = i ^ stride;
                if (j > i) { const bool dd = (((i & size) == 0) == DESC);
                             const int a = k[i], b = k[j], mx = imax(a, b), mn = imin(a, b); k[i] = dd ? mx : mn; k[j] = dd ? mn : mx; }
            }
}
template <bool DESC> __device__ __forceinline__ void bitonic_merge16(int (&k)[16]) {
#pragma unroll
    for (int stride = 8; stride > 0; stride >>= 1)
#pragma unroll
        for (int i = 0; i < 16; ++i) {
            const int j = i ^ stride;
            if (j > i) { const int a = k[i], b = k[j], mx = imax(a, b), mn = imin(a, b); k[i] = DESC ? mx : mn; k[j] = DESC ? mn : mx; }
        }
}
__device__ __forceinline__ void partner_merge16(int (&k)[16], int hi) {
    int pr[16];
#pragma unroll
    for (int i = 0; i < 16; ++i) { auto rr = __builtin_amdgcn_permlane32_swap((unsigned)k[i], (unsigned)k[i], false, false); pr[i] = hi ? (int)rr[0] : (int)rr[1]; }
#pragma unroll
    for (int i = 0; i < 16; ++i) k[i] = imax(k[i], pr[15 - i]);
    bitonic_merge16<true>(k);
}
__device__ __forceinline__ void route_mfma(const bf16_t* __restrict__ PQb, const bf16_t* __restrict__ SKb, int* __restrict__ IDX, float* __restrict__ G) {
    extern __shared__ __attribute__((aligned(16))) unsigned char r_lds[];
    const int tid_ = opaque_tid(); const int h = tid_ >> 6, lane = tid_ & 63, c = lane & 31, hi = lane >> 5;
    unsigned char* myslot = r_lds + (size_t)tid_ * 32;
    for (int tile = blockIdx.x; tile < T / 32; tile += NBLK) {
        const int tok = tile * 32 + c;
        int sv[2][16];
#pragma unroll
        for (int p = 0; p < 2; ++p) {
            const GAS bf16_t* qp = (const GAS bf16_t*)PQb + (size_t)tok * D + h * 256 + p * 128 + 8 * hi;
            const GAS bf16_t* kp = (const GAS bf16_t*)SKb + ((size_t)(h * 2 + p) * 128 + c) * 128 + 8 * hi;
            bf16x8 qf[8];
#pragma unroll
            for (int s = 0; s < 8; ++s) qf[s] = *(const GAS bf16x8*)(qp + 16 * s);
            int t0[16];
#pragma unroll
            for (int i = 0; i < 16; ++i) t0[i] = (int)0x80000000;
#pragma unroll 1
            for (int blk = 0; blk < 4; ++blk) {
                f32x16 acc;
#pragma unroll
                for (int r = 0; r < 16; ++r) acc[r] = 0.f;
#pragma unroll
                for (int s = 0; s < 8; ++s)
                    acc = __builtin_amdgcn_mfma_f32_32x32x16_bf16(*(const GAS bf16x8*)(kp + (size_t)blk * 32 * 128 + 16 * s), qf[s], acc, 0, 0, 0);
                int nk[16];
                const int pay = (32 * blk) | (hi << 2);
#pragma unroll
                for (int r = 0; r < 16; ++r) nk[r] = f2key<0x7f>(acc[r], pay | ((r & 3) + 8 * (r >> 2)));
                bitonic_sort16<false>(nk);
#pragma unroll
                for (int i = 0; i < 16; ++i) t0[i] = imax(t0[i], nk[i]);
                bitonic_merge16<true>(t0);
            }
            partner_merge16(t0, hi);
#pragma unroll
            for (int i = 0; i < 16; ++i) sv[p][i] = t0[i];
#pragma unroll
            for (int q4 = 0; q4 < 4; ++q4)
                *(unsigned*)(myslot + p * 16 + q4 * 4) = (unsigned)(t0[4 * q4] & 0x7f) | ((unsigned)(t0[4 * q4 + 1] & 0x7f) << 8) | ((unsigned)(t0[4 * q4 + 2] & 0x7f) << 16) | ((unsigned)(t0[4 * q4 + 3] & 0x7f) << 24);
        }
        float f0[16], f1[16];
#pragma unroll
        for (int i = 0; i < 16; ++i) { f0[i] = key2f<0x7f>(sv[0][i]); f1[i] = key2f<0x7f>(sv[1][i]); }
        int cd[32];
        {
            constexpr int PA[50] = {0,0,0,0,0,0,0,0,0,0,0,0,0,0,0,0, 1,1,1,1,1,1,1,1, 2,2,2,2,2, 3,3,3,3, 4,4,4, 5,5, 6,6, 7,7, 8,9,10,11,12,13,14,15};
            constexpr int PB[50] = {0,1,2,3,4,5,6,7,8,9,10,11,12,13,14,15, 0,1,2,3,4,5,6,7, 0,1,2,3,4, 0,1,2,3, 0,1,2, 0,1, 0,1, 0,1, 0,0,0,0,0,0,0,0};
#pragma unroll
            for (int q = 0; q < 25; ++q) {
                const int a0 = PA[2 * q], b0 = PB[2 * q], a1 = PA[2 * q + 1], b1 = PB[2 * q + 1];
                const float s0 = f0[a0] + f1[b0], s1 = f0[a1] + f1[b1];
                cd[q] = hi ? f2key<0xff>(s1, a1 * 16 + b1) : f2key<0xff>(s0, a0 * 16 + b0);
            }
#pragma unroll
            for (int q = 25; q < 32; ++q) cd[q] = (int)0x80000000;
        }
        bitonic_blocks<32, 16>(cd);
        int top[16];
#pragma unroll
        for (int i = 0; i < 16; ++i) top[i] = imax(cd[i], cd[16 + i]);
        bitonic_merge16<true>(top);
        partner_merge16(top, hi);
        float e[16]; float sum = 0.f;
        const float mx = key2f<0xff>(top[0]);
#pragma unroll
        for (int i = 0; i < 16; ++i) { e[i] = __expf(key2f<0xff>(top[i]) - mx); sum += e[i]; }
        const float inv = 1.f / sum;
        if (hi == 0) {
            int id[16];
#pragma unroll
            for (int i = 0; i < 16; ++i) { const int cc = top[i] & 0xff; id[i] = (int)myslot[cc >> 4] * 128 + (int)myslot[16 + (cc & 15)]; }
#pragma unroll
            for (int q4 = 0; q4 < 4; ++q4)
                *(GAS u32x4*)((GAS int*)IDX + (size_t)tok * 128 + h * 16 + 4 * q4) = u32x4{(unsigned)id[4 * q4], (unsigned)id[4 * q4 + 1], (unsigned)id[4 * q4 + 2], (unsigned)id[4 * q4 + 3]};
        } else {
#pragma unroll
            for (int q4 = 0; q4 < 4; ++q4)
                *(GAS f32x4*)((GAS float*)G + (size_t)tok * 128 + h * 16 + 4 * q4) = f32x4{e[4 * q4] * inv, e[4 * q4 + 1] * inv, e[4 * q4 + 2] * inv, e[4 * q4 + 3] * inv};
        }
    }
}

#define KARG_U64(off) ({ unsigned long long _v; asm volatile("s_load_dwordx2 %0, %1, %2\n\ts_waitcnt lgkmcnt(0)" : "=s"(_v) : "s"(__builtin_amdgcn_kernarg_segment_ptr()), "n"(off) : "memory"); _v; })
#define KARG_U32(off) ({ unsigned _v; asm volatile("s_load_dword %0, %1, %2\n\ts_waitcnt lgkmcnt(0)" : "=s"(_v) : "s"(__builtin_amdgcn_kernarg_segment_ptr()), "n"(off) : "memory"); _v; })
#define IN(k) ((const float*)KARG_U64((k) * 8))
#define bX   ((float*)(ws + OFF_X))
#define bP   ((float*)(ws + OFF_P))
#define bQ2  ((float*)(ws + OFF_Q2))
#define bKV2 ((float*)(ws + OFF_KV2))
#define bY   ((float*)(ws + OFF_Y))
#define bPQ  ((float*)(ws + OFF_PQ))
#define bA12 ((float*)(ws + OFF_A12))
#define bR128 ((float2*)(ws + OFF_R128))
#define bR64 ((float2*)(ws + OFF_R64))
#define bIDX ((int*)(ws + OFF_IDX))
#define bG   ((float*)(ws + OFF_G))
#define bCUM ((float*)(ws + OFF_CUM))
#define bWT  ((bf16_t*)(ws + OFF_WT))
#define bXb  ((bf16_t*)(ws + OFF_XB))
#define bOb  ((bf16_t*)(ws + OFF_OB))
#define bCQb ((bf16_t*)(ws + OFF_CQB))
#define bATT ((bf16_t*)(ws + OFF_ATT))
#define bGL  ((float*)(ws + OFF_GL))
#define bCUMH ((float*)(ws + OFF_CUMH))
#define bSSQ ((float*)(ws + OFF_SSQ))
#define bKPE ((float*)(ws + OFF_KPE))
#define bUb  ((bf16_t*)(ws + OFF_UB))
#define bVb  ((bf16_t*)(ws + OFF_VB))
#define bPQb ((bf16_t*)(ws + OFF_PQB))
#define bU8  ((unsigned char*)(ws + OFF_UB))
#define bV8  ((unsigned char*)(ws + OFF_VB))
#define bSU  ((float*)(ws + OFF_SU))
#define bSV  ((float*)(ws + OFF_SV))
#define bSKb ((bf16_t*)(ws + OFF_SKB))

__global__ void __launch_bounds__(NTHR, 2) fwd_kernel(Params p_unused) {
    extern __shared__ __attribute__((aligned(16))) unsigned char lds_raw[];
    float* lds = (float*)lds_raw;
    volatile LAS unsigned* bst = (volatile LAS unsigned*)(lds_raw + LDS_BYTES - 16);
    if (threadIdx.x == 0) { bst[0] = 0u; bst[1] = 0u; bst[2] = 0u; bst[3] = 0u; }
    __syncthreads();
    const int lo = (int)KARG_U32(184), hi = (int)KARG_U32(188);
    XcdBarrier bar; bar.bar = (unsigned*)((unsigned char*)KARG_U64(176) + OFF_BAR); bar.x = 0; bar.st = bst;
    if (hi - lo > 1) bar = xcd_barrier_post(bar.bar, bst);
    constexpr int NOSPLIT = 1 << 30;

    int ph = 0;
#define PH_BEGIN if (ph >= lo && ph < hi) { unsigned char* const ws = (unsigned char*)KARG_U64(176);
#define PH_END   if (ph + 1 < hi) xcd_barrier(bar); } ++ph;

    PH_BEGIN
#pragma unroll 1
      for (int rep = 0; rep < ((PROBE == 1 || PROBE == 8 || PROBE == 9) ? 2 : 1); ++rep) {
        if (rep == 0 || PROBE == 1) { convert_rows_bf16(IN(0), bXb, (size_t)T * D); rope_tables(bR128, bR64);
        convert_rows_bf16(IN(14), bSKb, (size_t)4 * 8 * 2 * 128 * 128); }
        if (rep == 1 && PROBE == 9) {} else if (PEER_FP8 && PEER_FP4) { convert_rows_fp4(IN(15), bU8, bSU, 4 * 16384); convert_rows_fp4(IN(16), bV8, bSV, 4 * 16384); }
        else if (PEER_FP8 && PEER_FP6) { convert_rows_fp6(IN(15), bU8, bSU, 4 * 16384); convert_rows_fp6(IN(16), bV8, bSV, 4 * 16384); }
        else if (PEER_FP8) { convert_rows_fp8(IN(15), bU8, bSU, 4 * 16384); convert_rows_fp8(IN(16), bV8, bSV, 4 * 16384); }
        else { convert_rows_bf16(IN(15), bUb, (size_t)4 * 16384 * D); convert_rows_bf16(IN(16), bVb, (size_t)4 * 16384 * D); }
        int gb = 0;
        if (rep == 1 && PROBE == 8) continue;
#pragma unroll 1
        for (int i = 0; i < 2; ++i) {
            transpose_convert(IN(1) + (size_t)i * D * NEV, NEV, D, 6144, ColEven{}, nullptr, bWT + WT_EIN + (size_t)i * 6144 * 2048, gb);
            transpose_convert(IN(4) + (size_t)i * D * D, D, D, 2048, ColPair{}, nullptr, bWT + WT_EOUT + (size_t)i * 2048 * 2048, gb);
            transpose_convert(IN(5) + (size_t)i * D * NOD, NOD, D, 4096, ColOddIn{}, nullptr, bWT + WT_OIN + (size_t)i * 4096 * 2048, gb);
            transpose_convert(IN(8) + (size_t)i * 512 * 1536, 1536, 512, 1536, ColUq{}, IN(6) + i * 512, bWT + WT_UQ + (size_t)i * 1536 * 512, gb);
            transpose_convert(IN(9) + (size_t)i * 512 * 2048, 2048, 512, 2048, ColUkv{}, IN(7) + i * 512, bWT + WT_UKV + (size_t)i * 2048 * 512, gb);
            transpose_convert(IN(12) + (size_t)i * D * D, D, D, 2048, ColPair{}, nullptr, bWT + WT_OOUT + (size_t)i * 2048 * 2048, gb);
            transpose_convert(IN(1) + (size_t)i * D * NEV, NEV, D, 64, ColGate{}, nullptr, bWT + WT_GATE + (size_t)i * 64 * 2048, gb);
            transpose_convert(IN(5) + (size_t)i * D * NOD, NOD, D, 64, ColKpe{}, nullptr, bWT + WT_KPE + (size_t)i * 64 * 2048, gb);
        }
#pragma unroll 1
        for (int l = 0; l < 4; ++l)
            transpose_convert(IN(13) + (size_t)l * D * D, D, D, 2048, ColPair{}, nullptr, bWT + WT_PQ + (size_t)l * 2048 * 2048, gb);
      }
    PH_END

#pragma unroll 1
    for (int pr = 0; pr < 2; ++pr) {
        {
            const int l = 2 * pr, i = pr;
            PH_BEGIN
                gemm_phase(bXb, bWT + WT_EIN + (size_t)i * 6144 * 2048, T, 6144, D, 0, EpiEven{bATT});
                if (PROBE == 5) { __syncthreads(); gemm_phase(bXb, bWT + WT_EIN + (size_t)i * 6144 * 2048, T, 6144, D, 0, EpiEven{bATT}); }
                __syncthreads();
                skinny_mfma<1, 0>(bXb, bWT + WT_GATE + (size_t)i * 64 * 2048, bCUMH, nullptr, nullptr, bGL, IN(2) + i * 8);
            PH_END
            PH_BEGIN attn_even_phase<ATT_NAIVE>(bATT, bCUMH, IN(3) + i * 8 * 257, bOb, (unsigned*)(ws + OFF_BAR) + CTR_WORD0 + 64 * l, lds, bGL);
                     if (PROBE == 3) { __syncthreads(); attn_even_phase<ATT_NAIVE>(bATT, bCUMH, IN(3) + i * 8 * 257, bOb, (unsigned*)(ws + OFF_BAR) + CTR_WORD0 + 64 * l + 8, lds, bGL); } PH_END
            PH_BEGIN gemm_phase(bOb, bWT + WT_EOUT + (size_t)i * 2048 * 2048, T, 2048, D, 0,
                                EpiLnRes{(l == 0) ? IN(0) : (const float*)bX, bX, bXb, IN(17) + l * D, IN(18) + l * D, (unsigned long long*)(ws + OFF_LNS) + (size_t)l * T * 8,
                                         (unsigned*)(ws + OFF_BAR) + LNC_WORD0 + l * 512, (unsigned*)(ws + OFF_BAR) + XB_TMO}); PH_END
            PH_BEGIN gemm_phase(bXb, bWT + WT_PQ + (size_t)l * 2048 * 2048, T, 2048, D, 0, EpiBf16{bPQb, D});
                     if (PROBE == 6) { __syncthreads(); gemm_phase(bXb, bWT + WT_PQ + (size_t)l * 2048 * 2048, T, 2048, D, 0, EpiBf16{bPQb, D}); } PH_END
            PH_BEGIN route_mfma(bPQb, bSKb + (size_t)l * 8 * 2 * 128 * 128, bIDX, bG);
                asm volatile("s_waitcnt vmcnt(0)" ::: "memory"); __builtin_amdgcn_fence(__ATOMIC_RELEASE, "workgroup"); __syncthreads(); __builtin_amdgcn_fence(__ATOMIC_ACQUIRE, "workgroup");
                if (PROBE == 2) peer_gather_f4(bX, bIDX, bG, bU8 + (size_t)l * 16384 * F4_ROW, bV8 + (size_t)l * 16384 * F4_ROW, bSU + l * 16384, bSV + l * 16384,
                                             IN(19) + l * D, IN(20) + l * D, bY, bPQb);
                if (PEER_FP8 && PEER_SWEEP) peer_gather_sweep(bX, bIDX, bG, bU8 + (size_t)l * 16384 * D, bV8 + (size_t)l * 16384 * D, bSU + l * 16384, bSV + l * 16384,
                                             IN(19) + l * D, IN(20) + l * D, bX, bXb);
                else if (PEER_FP8 && PEER_FP4 && PEER_SPLIT && PEER_PIPE) peer_gather_f4p(bX, bIDX, bG, bU8 + (size_t)l * 16384 * F4_ROW, bV8 + (size_t)l * 16384 * F4_ROW, bSU + l * 16384, bSV + l * 16384,
                                             IN(19) + l * D, IN(20) + l * D, bX, bXb);
                else if (PEER_FP8 && PEER_FP4 && PEER_SPLIT) peer_gather_f4s(bX, bIDX, bG, bU8 + (size_t)l * 16384 * F4_ROW, bV8 + (size_t)l * 16384 * F4_ROW, bSU + l * 16384, bSV + l * 16384,
                                             IN(19) + l * D, IN(20) + l * D, bX, bXb);
                else if (PEER_FP8 && PEER_FP4) peer_gather_f4(bX, bIDX, bG, bU8 + (size_t)l * 16384 * F4_ROW, bV8 + (size_t)l * 16384 * F4_ROW, bSU + l * 16384, bSV + l * 16384,
                                             IN(19) + l * D, IN(20) + l * D, bX, bXb);
                else if (PEER_FP8 && PEER_FP6) peer_gather_f6(bX, bIDX, bG, bU8 + (size_t)l * 16384 * F6_ROW, bV8 + (size_t)l * 16384 * F6_ROW, bSU + l * 16384, bSV + l * 16384,
                                             IN(19) + l * D, IN(20) + l * D, bX, bXb);
                else if (PEER_FP8) peer_gather_f8(bX, bIDX, bG, bU8 + (size_t)l * 16384 * D, bV8 + (size_t)l * 16384 * D, bSU + l * 16384, bSV + l * 16384,
                                             IN(19) + l * D, IN(20) + l * D, bX, bXb);
                else peer_gather_b(bX, bXb, bIDX, bG, bUb + (size_t)l * 16384 * D, bVb + (size_t)l * 16384 * D, IN(19) + l * D, IN(20) + l * D, bX, bXb);
            PH_END
        }
        {
            const int l = 2 * pr + 1, i = pr;
            PH_BEGIN
                gemm_phase(bXb, bWT + WT_OIN + (size_t)i * 4096 * 2048, T, 4096, D, 0, EpiOddIn{bCQb, bSSQ, bATT, bR128});
                if (PROBE == 5) { __syncthreads(); gemm_phase(bXb, bWT + WT_OIN + (size_t)i * 4096 * 2048, T, 4096, D, 0, EpiOddIn{bCQb, bSSQ, bATT, bR128}); }
                __syncthreads();
                skinny_mfma<2, 1>(bXb, bWT + WT_KPE + (size_t)i * 64 * 2048, nullptr, bR64, bATT + MHSZ);
            PH_END
            PH_BEGIN
                gemm_phase(bCQb, bWT + WT_UQ + (size_t)i * 1536 * 512, T, 1536, 512, 0, EpiUq{bSSQ, bATT, bR64});
                gemm_phase(bCQb + (size_t)T * 512, bWT + WT_UKV + (size_t)i * 2048 * 512, T, 2048, 512, 192, EpiUkv{bSSQ + (size_t)T * 8, bATT + MHSZ, bATT + 2 * MHSZ});
            PH_END
            PH_BEGIN attn_odd_phase(bATT, bOb, bA12, (unsigned*)(ws + OFF_BAR) + CTR_WORD0 + 64 * l);
                     if (PROBE == 4) { __syncthreads(); attn_odd_phase(bATT, bOb, bA12, (unsigned*)(ws + OFF_BAR) + CTR_WORD0 + 64 * l + 8); } PH_END
            PH_BEGIN diff_combine_naive(bA12, IN(10) + i * 512, IN(11) + i * 256, 0.8f - 0.6f * expf(-0.3f * (float)l), bOb); PH_END
            PH_BEGIN gemm_phase(bOb, bWT + WT_OOUT + (size_t)i * 2048 * 2048, T, 2048, D, 0,
                                EpiLnRes{bX, bX, bXb, IN(17) + l * D, IN(18) + l * D, (unsigned long long*)(ws + OFF_LNS) + (size_t)l * T * 8,
                                         (unsigned*)(ws + OFF_BAR) + LNC_WORD0 + l * 512, (unsigned*)(ws + OFF_BAR) + XB_TMO}); PH_END
            PH_BEGIN gemm_phase(bXb, bWT + WT_PQ + (size_t)l * 2048 * 2048, T, 2048, D, 0, EpiBf16{bPQb, D});
                     if (PROBE == 6) { __syncthreads(); gemm_phase(bXb, bWT + WT_PQ + (size_t)l * 2048 * 2048, T, 2048, D, 0, EpiBf16{bPQb, D}); } PH_END
            PH_BEGIN route_mfma(bPQb, bSKb + (size_t)l * 8 * 2 * 128 * 128, bIDX, bG);
                asm volatile("s_waitcnt vmcnt(0)" ::: "memory"); __builtin_amdgcn_fence(__ATOMIC_RELEASE, "workgroup"); __syncthreads(); __builtin_amdgcn_fence(__ATOMIC_ACQUIRE, "workgroup");
                if (PROBE == 2) peer_gather_f4(bX, bIDX, bG, bU8 + (size_t)l * 16384 * F4_ROW, bV8 + (size_t)l * 16384 * F4_ROW, bSU + l * 16384, bSV + l * 16384,
                                             IN(19) + l * D, IN(20) + l * D, bY, bPQb);
                if (PEER_FP8 && PEER_SWEEP) peer_gather_sweep(bX, bIDX, bG, bU8 + (size_t)l * 16384 * D, bV8 + (size_t)l * 16384 * D, bSU + l * 16384, bSV + l * 16384,
                                             IN(19) + l * D, IN(20) + l * D, (l == 3) ? (float*)KARG_U64(168) : bX, bXb);
                else if (PEER_FP8 && PEER_FP4 && PEER_SPLIT && PEER_PIPE) peer_gather_f4p(bX, bIDX, bG, bU8 + (size_t)l * 16384 * F4_ROW, bV8 + (size_t)l * 16384 * F4_ROW, bSU + l * 16384, bSV + l * 16384,
                                             IN(19) + l * D, IN(20) + l * D, (l == 3) ? (float*)KARG_U64(168) : bX, bXb);
                else if (PEER_FP8 && PEER_FP4 && PEER_SPLIT) peer_gather_f4s(bX, bIDX, bG, bU8 + (size_t)l * 16384 * F4_ROW, bV8 + (size_t)l * 16384 * F4_ROW, bSU + l * 16384, bSV + l * 16384,
                                             IN(19) + l * D, IN(20) + l * D, (l == 3) ? (float*)KARG_U64(168) : bX, bXb);
                else if (PEER_FP8 && PEER_FP4) peer_gather_f4(bX, bIDX, bG, bU8 + (size_t)l * 16384 * F4_ROW, bV8 + (size_t)l * 16384 * F4_ROW, bSU + l * 16384, bSV + l * 16384,
                                             IN(19) + l * D, IN(20) + l * D, (l == 3) ? (float*)KARG_U64(168) : bX, bXb);
                else if (PEER_FP8 && PEER_FP6) peer_gather_f6(bX, bIDX, bG, bU8 + (size_t)l * 16384 * F6_ROW, bV8 + (size_t)l * 16384 * F6_ROW, bSU + l * 16384, bSV + l * 16384,
                                             IN(19) + l * D, IN(20) + l * D, (l == 3) ? (float*)KARG_U64(168) : bX, bXb);
                else if (PEER_FP8) peer_gather_f8(bX, bIDX, bG, bU8 + (size_t)l * 16384 * D, bV8 + (size_t)l * 16384 * D, bSU + l * 16384, bSV + l * 16384,
                                             IN(19) + l * D, IN(20) + l * D, (l == 3) ? (float*)KARG_U64(168) : bX, bXb);
                else peer_gather_b(bX, bXb, bIDX, bG, bUb + (size_t)l * 16384 * D, bVb + (size_t)l * 16384 * D, IN(19) + l * D, IN(20) + l * D,
                                   (l == 3) ? (float*)KARG_U64(168) : bX, bXb);
            PH_END
        }
    }
#undef PH_BEGIN
#undef PH_END
}
constexpr int N_PHASES = 1 + 2 * (5 + 7);
}

extern "C" void kernel_launch(void* const* d_in, const int* in_sizes, int n_in, void* d_out, int out_size, void* d_ws, size_t ws_size,
                              hipStream_t stream) {
    static int grid = 0;
    if (grid == 0) {
        if (n_in != 21 || out_size != T * D || ws_size < WS_END) { fprintf(stderr, "kernel_launch: unexpected shapes (n_in %d out %d ws %zu need %zu)\n", n_in, out_size, ws_size, (size_t)WS_END); grid = -1; return; }
        int dev = 0, cus = 0;
        if (hipGetDevice(&dev) != hipSuccess || hipDeviceGetAttribute(&cus, hipDeviceAttributeMultiprocessorCount, dev) != hipSuccess || cus <= 0) cus = 256;
        if (hipFuncSetAttribute((const void*)fwd_kernel, hipFuncAttributeMaxDynamicSharedMemorySize, LDS_BYTES) != hipSuccess) { fprintf(stderr, "kernel_launch: hipFuncSetAttribute failed\n"); grid = -1; return; }
        int per_cu = 0;
        if (hipOccupancyMaxActiveBlocksPerMultiprocessor(&per_cu, (const void*)fwd_kernel, NTHR, LDS_BYTES) != hipSuccess || per_cu < 1)
            fprintf(stderr, "kernel_launch: occupancy query says %d\n", per_cu);
        (void)hipGetLastError();
        if (cus < NBLK) { fprintf(stderr, "kernel_launch: needs %d CUs for a resident grid, device has %d\n", NBLK, cus); grid = -1; return; }
        grid = NBLK;
    }
    if (grid < 0) return;
    (void)hipMemsetAsync((char*)d_ws + OFF_BAR, 0, CTL_WORDS * sizeof(unsigned), stream);
    Params p{};
    for (int i = 0; i < 21; ++i) p.in[i] = (const float*)d_in[i];
    p.out = (float*)d_out; p.ws = (unsigned char*)d_ws;
    if (N_LAUNCH_SPLIT) {
        for (int ph = 0; ph < N_PHASES; ++ph) {
            p.ph_lo = ph; p.ph_hi = ph + 1;
            hipLaunchKernelGGL(fwd_kernel, dim3(grid), dim3(NTHR), LDS_BYTES, stream, p);
        }
    } else {
        p.ph_lo = 0; p.ph_hi = N_PHASES;
        hipLaunchKernelGGL(fwd_kernel, dim3(grid), dim3(NTHR), LDS_BYTES, stream, p);
    }
}
```

```cpp
#include <hip/hip_runtime.h>
#include <stdint.h>
#include <stdio.h>

namespace {
constexpr int D = 2048, NB = 2, S = 4096, T = NB * S;
constexpr int NEV = 6152, NOD = 4160;
constexpr float ALPHA = 1.681792830507429f;
constexpr float LN_EPS = 1e-5f, RMS_EPS = 1e-6f;
constexpr int NTHR = 512;
constexpr int NBLK = 256;
constexpr int LDS_BYTES = 144 * 1024;
constexpr int N_LAUNCH_SPLIT = 0;
constexpr int PROBE = 0;
constexpr bool ATT_NAIVE = false;
constexpr bool RES_BF16 = true;
constexpr bool PEER_PIPE = true;
constexpr bool PEER_SPLIT = true;
constexpr bool PEER_FP4 = true;
constexpr bool PEER_FP6 = true;
constexpr bool PEER_SWEEP = false;
constexpr bool PEER_FP8 = true;

constexpr size_t SZ_TD   = (size_t)T * D * 4;
constexpr size_t OFF_BAR = 0;
constexpr size_t OFF_X   = 1 << 16;
constexpr size_t OFF_P   = OFF_X + SZ_TD;
constexpr size_t OFF_Q2  = OFF_P + (size_t)T * NEV * 4;
constexpr size_t OFF_KV2 = OFF_Q2 + (size_t)T * 1536 * 4;
constexpr size_t OFF_O   = OFF_KV2 + SZ_TD;
constexpr size_t OFF_Y   = OFF_O + SZ_TD;
constexpr size_t OFF_PQ  = OFF_Y + SZ_TD;
constexpr size_t OFF_A12 = OFF_PQ + SZ_TD;
constexpr size_t OFF_IDX = OFF_A12 + SZ_TD;
constexpr size_t OFF_G   = OFF_IDX + (size_t)T * 128 * 4;
constexpr size_t OFF_CUM = OFF_G + (size_t)T * 128 * 4;
constexpr size_t OFF_R128 = OFF_CUM + (size_t)T * 8 * 4;
constexpr size_t OFF_R64  = OFF_R128 + (size_t)S * 64 * 8;
constexpr size_t OFF_WT   = OFF_R64 + (size_t)S * 32 * 8;
constexpr size_t WT_EIN  = 0;
constexpr size_t WT_EOUT = WT_EIN + (size_t)2 * 6144 * 2048;
constexpr size_t WT_OIN  = WT_EOUT + (size_t)2 * 2048 * 2048;
constexpr size_t WT_UQ   = WT_OIN + (size_t)2 * 4096 * 2048;
constexpr size_t WT_UKV  = WT_UQ + (size_t)2 * 1536 * 512;
constexpr size_t WT_OOUT = WT_UKV + (size_t)2 * 2048 * 512;
constexpr size_t WT_PQ   = WT_OOUT + (size_t)2 * 2048 * 2048;
constexpr size_t WT_GATE = WT_PQ + (size_t)4 * 2048 * 2048;
constexpr size_t WT_KPE  = WT_GATE + (size_t)2 * 64 * 2048;
constexpr size_t WT_ELEMS = WT_KPE + (size_t)2 * 64 * 2048;
constexpr size_t OFF_XB  = OFF_WT + WT_ELEMS * 2;
constexpr size_t OFF_OB  = OFF_XB + (size_t)T * D * 2;
constexpr size_t OFF_CQB = OFF_OB + (size_t)T * D * 2;
constexpr size_t OFF_ATT = OFF_CQB + (size_t)T * 1024 * 2;
constexpr size_t OFF_GL  = OFF_ATT + (size_t)128 * 1024 * 1024;
constexpr size_t OFF_CUMH = OFF_GL + (size_t)T * 8 * 4;
constexpr size_t OFF_SSQ = OFF_CUMH + (size_t)T * 8 * 4;
constexpr size_t OFF_KPE = OFF_SSQ + (size_t)2 * T * 8 * 4;
constexpr size_t OFF_UB  = OFF_KPE + (size_t)T * 64 * 4;
constexpr size_t OFF_VB  = OFF_UB + (size_t)4 * 16384 * D * 2;
constexpr size_t OFF_SU  = OFF_VB + (size_t)4 * 16384 * D * 2;
constexpr size_t OFF_SV  = OFF_SU + (size_t)4 * 16384 * 4;
constexpr size_t OFF_PQB = OFF_SV + (size_t)4 * 16384 * 4;
constexpr size_t OFF_SKB = OFF_PQB + (size_t)T * D * 2;
constexpr size_t OFF_LNS = OFF_SKB + (size_t)4 * 8 * 2 * 128 * 128 * 2;
constexpr size_t WS_END  = OFF_LNS + (size_t)4 * T * 8 * 8;
constexpr int CTR_WORD0 = 4096;
constexpr int LNC_WORD0 = 4096 + 64 * 8;
constexpr int CTL_WORDS = LNC_WORD0 + 4 * 32 * 16;

struct Params {
    const float* in[21];
    float* out;
    unsigned char* ws;
    int ph_lo, ph_hi;
};

#define XB_TMO      128
#define XB_XCNT(j)  (256  + 64 * (j))
#define XB_XSUB(j)  (1280 + 64 * (j))
#define XB_XGEN(j)  (2304 + 64 * (j))
#define XB_TOP      3328
#define XB_TOPGEN   3392
#define XCD_BAR_WORDS 3456
#define XB_SPIN_CAP (1u << 26)
#define LAS __attribute__((address_space(3)))

__device__ __forceinline__ unsigned xb_ld(unsigned* p)              { return __hip_atomic_load(p, __ATOMIC_RELAXED, __HIP_MEMORY_SCOPE_AGENT); }
__device__ __forceinline__ unsigned xb_add(unsigned* p, unsigned v) { return __hip_atomic_fetch_add(p, v, __ATOMIC_RELAXED, __HIP_MEMORY_SCOPE_AGENT); }
__device__ __forceinline__ unsigned xb_xcc_id() { return (unsigned)__builtin_amdgcn_s_getreg((3 << 11) | 20) & 0xFu; }
#define XB_SPIN(cond, bar) do { unsigned _sp = 0; while (cond) { __builtin_amdgcn_s_sleep(1); \
    if ((++_sp & 255u) == 0u) { if (xb_ld(&(bar)[XB_TMO])) break; if (_sp > XB_SPIN_CAP) { atomicAdd(&(bar)[XB_TMO], 1u); break; } } } } while (0)

struct XcdBarrier { unsigned* bar; unsigned x; volatile LAS unsigned* st; };

__device__ __forceinline__ XcdBarrier xcd_barrier_post(unsigned* bar, volatile LAS unsigned* st) {
    XcdBarrier b; b.bar = bar; b.x = xb_xcc_id(); b.st = st;
    if (threadIdx.x == 0) (void)xb_add(&bar[XB_XCNT(b.x)], 1u);
    return b;
}
__device__ __forceinline__ void xcd_barrier_complete(unsigned* bar, unsigned x, unsigned& nloc, unsigned& nx) {
    const unsigned G = (unsigned)NBLK;
    unsigned sum, cnt, mine, sp = 0u;
    for (;;) {
        sum = 0u; cnt = 0u; mine = 0u;
#pragma unroll
        for (unsigned j = 0; j < 16; ++j) { const unsigned c = xb_ld(&bar[XB_XCNT(j)]); sum += c; cnt += (c > 0u) ? 1u : 0u; mine = (j == x) ? c : mine; }
        if (sum == G) break;
        __builtin_amdgcn_s_sleep(1);
        if ((++sp & 255u) == 0u) { if (xb_ld(&bar[XB_TMO])) break; if (sp > XB_SPIN_CAP) { atomicAdd(&bar[XB_TMO], 1u); break; } }
    }
    nloc = mine > 0u ? mine : 1u; nx = cnt > 0u ? cnt : 1u;
}
__device__ __forceinline__ void xcd_barrier(const XcdBarrier& b) {
    asm volatile("s_waitcnt vmcnt(0)" ::: "memory");
    __syncthreads();
    if (threadIdx.x == 0) {
        unsigned* bar = b.bar;
        __builtin_amdgcn_s_waitcnt(0);
        unsigned nloc = b.st[0], nx = b.st[1];
        if (nloc == 0u) { xcd_barrier_complete(bar, b.x, nloc, nx); b.st[0] = nloc; b.st[1] = nx; }
        const unsigned old = xb_add(&bar[XB_XSUB(b.x)], 1u);
        const unsigned gen = old / nloc;
        if (old + 1u == (gen + 1u) * nloc) {
            __builtin_amdgcn_fence(__ATOMIC_RELEASE, "agent");
            asm volatile("s_waitcnt vmcnt(0)" ::: "memory");
            const unsigned og = xb_add(&bar[XB_TOP], 1u);
            const unsigned tg = og / nx;
            if (og + 1u == (tg + 1u) * nx) xb_add(&bar[XB_TOPGEN], 1u);
            else XB_SPIN(xb_ld(&bar[XB_TOPGEN]) == tg, bar);
            __builtin_amdgcn_fence(__ATOMIC_ACQUIRE, "agent");
            xb_add(&bar[XB_XGEN(b.x)], 1u);
            asm volatile("s_waitcnt vmcnt(0)" ::: "memory");
        } else {
            XB_SPIN(xb_ld(&bar[XB_XGEN(b.x)]) == gen, bar);
            __builtin_amdgcn_fence(__ATOMIC_ACQUIRE, "agent");
            asm volatile("s_waitcnt vmcnt(0)" ::: "memory");
        }
    }
    __syncthreads();
}

template <int M> __device__ __forceinline__ float swz_xor(float v) { return __int_as_float(__builtin_amdgcn_ds_swizzle(__float_as_int(v), (M << 10) | 0x1f)); }
template <int M> __device__ __forceinline__ int swz_xor_i(int v) { return __builtin_amdgcn_ds_swizzle(v, (M << 10) | 0x1f); }
__device__ __forceinline__ float swap32(float v) {
    auto rr = __builtin_amdgcn_permlane32_swap(__float_as_uint(v), __float_as_uint(v), false, false);
    const float a = __uint_as_float(rr[0]), b = __uint_as_float(rr[1]);
    return (__float_as_uint(a) == __float_as_uint(v)) ? b : a;
}
__device__ __forceinline__ float wsum(float v) {
    v += swz_xor<1>(v); v += swz_xor<2>(v); v += swz_xor<4>(v); v += swz_xor<8>(v); v += swz_xor<16>(v);
    auto rr = __builtin_amdgcn_permlane32_swap(__float_as_uint(v), __float_as_uint(v), false, false);
    return __uint_as_float(rr[0]) + __uint_as_float(rr[1]);
}
__device__ __forceinline__ float wmaxf(float v) {
    v = fmaxf(v, swz_xor<1>(v)); v = fmaxf(v, swz_xor<2>(v)); v = fmaxf(v, swz_xor<4>(v)); v = fmaxf(v, swz_xor<8>(v)); v = fmaxf(v, swz_xor<16>(v));
    auto rr = __builtin_amdgcn_permlane32_swap(__float_as_uint(v), __float_as_uint(v), false, false);
    return fmaxf(__uint_as_float(rr[0]), __uint_as_float(rr[1]));
}
__device__ __forceinline__ int imax(int a, int b) { return a > b ? a : b; }
__device__ __forceinline__ int imin(int a, int b) { return a < b ? a : b; }
__device__ __forceinline__ float gelu_tanh(float h) {
    return 0.5f * h * (1.f + tanhf(0.7978845608028654f * (h + 0.044715f * h * h * h)));
}

__device__ __forceinline__ int opaque_tid() { int t = threadIdx.x; asm volatile("" : "+v"(t)); return t; }


#define GAS __attribute__((address_space(1)))
typedef unsigned short bf16_t;
using bf16x8 = __attribute__((ext_vector_type(8))) short;
using f32x4 = __attribute__((ext_vector_type(4))) float;
using f32x16 = __attribute__((ext_vector_type(16))) float;
using u32x2 = __attribute__((ext_vector_type(2))) unsigned;
using u32x4 = __attribute__((ext_vector_type(4))) unsigned;
typedef __bf16 bf16x2_cv __attribute__((ext_vector_type(2)));
typedef float f32x2_cv __attribute__((ext_vector_type(2)));
__device__ __forceinline__ unsigned cvtpk(float lo, float hi) { return __builtin_bit_cast(unsigned, __builtin_convertvector(f32x2_cv{lo, hi}, bf16x2_cv)); }
__device__ __forceinline__ bf16_t f2bf(float f) { return (bf16_t)(cvtpk(f, 0.f) & 0xffffu); }

__device__ __forceinline__ void convert_rows_bf16(const float* __restrict__ src, bf16_t* __restrict__ dst, size_t n) {
    const int tid_ = opaque_tid();
    const size_t n4 = n / 4;
    for (size_t i = (size_t)blockIdx.x * NTHR + tid_; i < n4; i += (size_t)NBLK * NTHR) {
        const float4 v = ((const float4*)src)[i];
        ((uint2*)dst)[i] = make_uint2(cvtpk(v.x, v.y), cvtpk(v.z, v.w));
    }
}

__device__ __forceinline__ int perm_pair(int p) { return (p & ~31) | ((p & 15) << 1) | ((p >> 4) & 1); }
__device__ __forceinline__ int perm_rope128(int p) { return (((p >> 4) & 1) << 6) | ((p >> 5) << 4) | (p & 15); }
struct ColId   { __device__ __forceinline__ int operator()(int n) const { return n; } };
struct ColPair { __device__ __forceinline__ int operator()(int n) const { return (n & ~127) | perm_pair(n & 127); } };
struct ColEven {
    __device__ __forceinline__ int operator()(int n) const {
        const int g = n >> 10, c = n & 1023, p = c & 127; const bool isv = (g == 2) || (g == 5);
        return g * 1024 + (c & ~127) + (isv ? p : perm_pair(p)) + (g >= 3 ? 8 : 0);
    }
};
struct ColOddIn {
    __device__ __forceinline__ int operator()(int n) const {
        if (n < 1024) return (n & ~127) | perm_pair(n & 127);
        const int m = n - 1024, g2 = m >> 10, c = m & 1023, p = c & 127;
        return 1088 + g2 * 1024 + (c & ~127) + (g2 < 2 ? perm_rope128(p) : p);
    }
};
struct ColOddTmp { __device__ __forceinline__ int operator()(int n) const { return n + (n >= 1024 ? 64 : 0); } };
struct ColUq {
    __device__ __forceinline__ int operator()(int n) const {
        if (n < 1024) return (n >> 7) * 192 + perm_pair(n & 127);
        const int m = n - 1024, tidx = m >> 8, p = m & 255, bj = p >> 7, wc = (p >> 5) & 3, nn = (p >> 4) & 1, fr = p & 15;
        return (tidx * 4 + bj * 2 + (wc >> 1)) * 192 + 128 + nn * 32 + (wc & 1) * 16 + fr;
    }
};
struct ColUkv {
    __device__ __forceinline__ int operator()(int n) const { const int p = n & 255; return (n & ~255) + (p < 128 ? perm_pair(p) : p); }
};
template <class SrcCol>
__device__ __forceinline__ void transpose_convert(const float* __restrict__ W, int ldw, int K, int Nout, SrcCol srccol, const float* __restrict__ kgain,
                                                  bf16_t* __restrict__ Wt, int& gbase) {
    const int tid = opaque_tid(); const int wave = tid >> 6, lane = tid & 63;
    const int nk = K / 64, ntile = (Nout / 64) * nk, G = NBLK * 8;
    const int me = blockIdx.x * 8 + wave;
    const int first = gbase + ((me - gbase % G) + G) % G;
    for (int g = first; g < gbase + ntile; g += G) {
        const int v = g - gbase, n0 = (v / nk) * 64, k0 = (v % nk) * 64;
        const int sc = srccol(n0 + lane);
        const GAS float* wp = (const GAS float*)W + (size_t)k0 * ldw + (sc >= 0 ? sc : 0);
        float f[64];
#pragma unroll
        for (int k = 0; k < 64; ++k) f[k] = wp[(size_t)k * ldw];
        if (sc < 0) {
#pragma unroll
            for (int k = 0; k < 64; ++k) f[k] = 0.f;
        }
        if (kgain) {
#pragma unroll
            for (int k = 0; k < 64; ++k) f[k] *= kgain[k0 + k];
        }
        extern __shared__ __attribute__((aligned(16))) unsigned char tc_lds[];
        LAS unsigned char* tl = (LAS unsigned char*)tc_lds + wave * (64 * 144);
#pragma unroll
        for (int q = 0; q < 8; ++q)
            *(LAS u32x4*)(tl + lane * 144 + q * 16) = u32x4{cvtpk(f[8 * q], f[8 * q + 1]), cvtpk(f[8 * q + 2], f[8 * q + 3]), cvtpk(f[8 * q + 4], f[8 * q + 5]), cvtpk(f[8 * q + 6], f[8 * q + 7])};
#pragma unroll
        for (int q = 0; q < 8; ++q) {
            const int nr = q * 8 + (lane >> 3);
            const u32x4 t = *(const LAS u32x4*)(tl + nr * 144 + (lane & 7) * 16);
            *(GAS u32x4*)((GAS bf16_t*)Wt + (size_t)(n0 + nr) * K + k0 + (lane & 7) * 8) = t;
        }
    }
    gbase += ntile;
}

constexpr int G_HT = 128 * 64;
__device__ __forceinline__ int g_lds_byte(int r, int c) { const int st = (r >> 4) * 2 + (c >> 5), rr = r & 15, cc = c & 31, ob = rr * 64 + cc * 2; return st * 1024 + (ob ^ (((ob >> 9) & 1) << 5)); }
__device__ __forceinline__ void g_stage_rc(int b, int& R, int& C) { const int st = b / 1024, sb = b % 1024, swz = sb ^ (((sb >> 9) & 1) << 5); R = (st >> 1) * 16 + swz / 64; C = (st & 1) * 32 + (swz % 64) / 2; }

struct EpiF32 {
    float* C; int ldc; int split; int skip;
    __device__ __forceinline__ void operator()(const f32x4 (&acc)[2][2][4][2], int brow, int bcol, int wr, int wc, int fr, int fq) const {
        __attribute__((address_space(1))) float* Cg = (__attribute__((address_space(1))) float*)C;
#pragma unroll
        for (int ai = 0; ai < 2; ++ai)
#pragma unroll
            for (int bj = 0; bj < 2; ++bj)
#pragma unroll
                for (int m = 0; m < 4; ++m)
#pragma unroll
                    for (int n = 0; n < 2; ++n) {
                        int col = bcol + bj * 128 + wc * 32 + n * 16 + fr; col += (col >= split) ? skip : 0;
#pragma unroll
                        for (int j = 0; j < 4; ++j)
                            Cg[(size_t)(brow + ai * 128 + wr * 64 + m * 16 + fq * 4 + j) * ldc + col] = acc[ai][bj][m][n][j];
                    }
    }
};

template <class Epi>
__device__ __forceinline__ void gemm_tile_256(const bf16_t* __restrict__ A, const bf16_t* __restrict__ Bt, int K, int brow, int bcol, const Epi& epi) {
    extern __shared__ __attribute__((aligned(16))) bf16_t g_shm[];
#define SA(b,h) (g_shm+((b)*2+(h))*G_HT)
#define SB(b,h) (g_shm+(4+(b)*2+(h))*G_HT)
#define STAGE_X(P,BASE,br,kt) do{ const char* _gb=(const char*)(BASE)+((size_t)(br)*(size_t)K+(size_t)(kt)*64)*2; \
      __builtin_amdgcn_global_load_lds((const unsigned*)(_gb+so0),(unsigned*)((char*)(P)+tid*16),16,0,0); \
      __builtin_amdgcn_global_load_lds((const unsigned*)(_gb+so1),(unsigned*)((char*)(P)+tid*16+8192),16,0,0); }while(0)
#define STAGE_A(P,br,kt) STAGE_X(P,A,br,kt)
#define STAGE_B(P,br,kt) STAGE_X(P,Bt,br,kt)
#define LDA(dst,b,h) for(int m=0;m<4;++m)for(int k=0;k<2;++k) dst[m][k]=*reinterpret_cast<const bf16x8*>((char*)SA(b,h)+g_lds_byte(wr*64+m*16+fr,k*32+fq*8))
#define LDB(dst,b,h) for(int n=0;n<2;++n)for(int k=0;k<2;++k) dst[n][k]=*reinterpret_cast<const bf16x8*>((char*)SB(b,h)+g_lds_byte(wc*32+n*16+fr,k*32+fq*8))
#define MMA(ai,bj,At_,Bt_) do{__builtin_amdgcn_s_setprio(1); \
    for(int m=0;m<4;++m)for(int n=0;n<2;++n)for(int k=0;k<2;++k) \
      acc[ai][bj][m][n]=__builtin_amdgcn_mfma_f32_16x16x32_bf16(At_[m][k],Bt_[n][k],acc[ai][bj][m][n],0,0,0); \
    __builtin_amdgcn_s_setprio(0);}while(0)
#define WAIT_V(n) asm volatile("s_waitcnt vmcnt(" #n ")":::"memory")
#define WAIT_L(n) asm volatile("s_waitcnt lgkmcnt(" #n ")":::"memory")
#define BAR __builtin_amdgcn_s_barrier()
#define SCHED __builtin_amdgcn_sched_barrier(0)
    int tid = opaque_tid();
    int wid = tid >> 6, lane = tid & 63, wr = wid >> 2, wc = wid & 3, fr = lane & 15, fq = lane >> 4;
    unsigned so0, so1;
    { int r_, c_; g_stage_rc(tid * 16, r_, c_); so0 = (unsigned)(r_ * K + c_) * 2u; g_stage_rc(tid * 16 + 8192, r_, c_); so1 = (unsigned)(r_ * K + c_) * 2u; }
    f32x4 acc[2][2][4][2];
#pragma unroll
    for (int a0 = 0; a0 < 2; ++a0)
#pragma unroll
        for (int a1 = 0; a1 < 2; ++a1)
#pragma unroll
            for (int a2 = 0; a2 < 4; ++a2)
#pragma unroll
                for (int a3 = 0; a3 < 2; ++a3) acc[a0][a1][a2][a3] = f32x4{0.f, 0.f, 0.f, 0.f};
    bf16x8 At[4][2], B0[2][2], B1[2][2];
    const int nt = K / 64;
    STAGE_B(SB(0,0),bcol,0); STAGE_A(SA(0,0),brow,0);
    STAGE_B(SB(0,1),bcol+128,0); STAGE_A(SA(0,1),brow+128,0);
    if(wr==1)BAR;
    WAIT_V(4); BAR;
    STAGE_B(SB(1,0),bcol,1); STAGE_A(SA(1,0),brow,1); STAGE_B(SB(1,1),bcol+128,1);
    WAIT_V(6); BAR;
    for(int t=0;t<nt-2;t+=2){
        LDB(B0,0,0); SCHED; LDA(At,0,0); STAGE_A(SA(1,1),brow+128,t+1);
        WAIT_L(8); BAR; WAIT_L(0); MMA(0,0,At,B0); BAR; SCHED;
        LDB(B1,0,1); STAGE_B(SB(0,0),bcol,t+2);
        BAR; WAIT_L(0); MMA(0,1,At,B1); BAR;
        LDA(At,0,1); STAGE_A(SA(0,0),brow,t+2);
        BAR; WAIT_L(0); MMA(1,0,At,B0); BAR; SCHED;
        STAGE_B(SB(0,1),bcol+128,t+2);
        WAIT_V(6); BAR; MMA(1,1,At,B1); BAR;
        LDB(B0,1,0); SCHED; LDA(At,1,0); STAGE_A(SA(0,1),brow+128,t+2);
        WAIT_L(8); BAR; WAIT_L(0); MMA(0,0,At,B0); BAR; SCHED;
        LDB(B1,1,1); STAGE_B(SB(1,0),bcol,t+3);
        BAR; WAIT_L(0); MMA(0,1,At,B1); BAR;
        LDA(At,1,1); STAGE_A(SA(1,0),brow,t+3);
        BAR; WAIT_L(0); MMA(1,0,At,B0); BAR; SCHED;
        STAGE_B(SB(1,1),bcol+128,t+3);
        WAIT_V(6); BAR; MMA(1,1,At,B1); BAR;
    }
    { int tz = threadIdx.x; asm volatile("":"+v"(tz)); tid = tz; wid=tz>>6; lane=tz&63; wr=wid>>2; wc=wid&3; fr=lane&15; fq=lane>>4;
      int r_, c_; g_stage_rc(tid * 16, r_, c_); so0 = (unsigned)(r_ * K + c_) * 2u; g_stage_rc(tid * 16 + 8192, r_, c_); so1 = (unsigned)(r_ * K + c_) * 2u; }
    { LDB(B0,0,0); WAIT_V(0); LDA(At,0,0); STAGE_A(SA(1,1),brow+128,nt-1);
      BAR; WAIT_L(0); MMA(0,0,At,B0); BAR;
      LDB(B1,0,1); BAR; WAIT_L(0); MMA(0,1,At,B1); BAR;
      LDA(At,0,1); WAIT_V(4); BAR; WAIT_L(0); MMA(1,0,At,B0); MMA(1,1,At,B1); BAR; }
    { LDB(B0,1,0); LDA(At,1,0); WAIT_V(2); BAR; WAIT_L(0); MMA(0,0,At,B0); BAR;
      LDB(B1,1,1); WAIT_V(0); BAR; WAIT_L(0); MMA(0,1,At,B1); BAR;
      LDA(At,1,1); BAR; WAIT_L(0); MMA(1,0,At,B0); MMA(1,1,At,B1); BAR; }
    if(wr==0)BAR;
    epi(acc, brow, bcol, wr, wc, fr, fq);
#undef SA
#undef SB
#undef STAGE_X
#undef STAGE_A
#undef STAGE_B
#undef LDA
#undef LDB
#undef MMA
#undef WAIT_V
#undef WAIT_L
#undef BAR
#undef SCHED
}

template <class Epi>
__device__ __forceinline__ void gemm_phase(const bf16_t* __restrict__ A, const bf16_t* __restrict__ Bt, int M, int N, int K, int goff, const Epi& epi) {
    const int nM = M / 256, nN = N / 256, ntile = nM * nN, G = NBLK;
    const int first = goff + (((int)blockIdx.x - goff % G) + G) % G;
    const bool super = ((nN & 7) == 0) && ((nM & 3) == 0) && (G == 256) && (goff == 0);
    for (int g = first; g < goff + ntile; g += G) {
        const int v = g - goff;
        int pm, pn;
        if (super) { const int r = v >> 8, slot = v & 255, xcd = slot & 7, j = slot >> 3, st = r * 8 + xcd, nSN = nN >> 3; pm = (st / nSN) * 4 + (j >> 3); pn = (st % nSN) * 8 + (j & 7); }
        else { pm = v / nN; pn = v % nN; }
        gemm_tile_256(A, Bt, K, pm * 256, pn * 256, epi);
    }
}

constexpr float LOG2E = 1.4426950408889634f;
constexpr size_t EHSZ = (size_t)NB * 8 * S * 128;
constexpr size_t MHSZ = (size_t)NB * 8 * S * 192;
__device__ __forceinline__ float bf2f(bf16_t v) { return __uint_as_float((unsigned)v << 16); }

template <int BJ_LO, int BJ_HI>
__device__ __forceinline__ void vt_store_lds(const f32x4 (&acc)[2][2][4][2], int brow, int wr, int wc, int fr, int fq, const float* __restrict__ ssq, bf16_t* dst0) {
    extern __shared__ __attribute__((aligned(16))) unsigned char vt_lds[];
    constexpr int PITCH = 528;
    LAS unsigned char* L = (LAS unsigned char*)vt_lds;
#pragma unroll
    for (int ai = 0; ai < 2; ++ai)
#pragma unroll
        for (int m = 0; m < 4; ++m) {
            const int r0 = ai * 128 + wr * 64 + m * 16 + fq * 4;
            float rs[4] = {1.f, 1.f, 1.f, 1.f};
            if (ssq) {
#pragma unroll
                for (int j = 0; j < 4; ++j) {
                    const f32x4 a = *(const GAS f32x4*)(ssq + (size_t)(brow + r0 + j) * 8), c = *(const GAS f32x4*)(ssq + (size_t)(brow + r0 + j) * 8 + 4);
                    rs[j] = rsqrtf(((a[0] + a[1]) + (a[2] + a[3]) + (c[0] + c[1]) + (c[2] + c[3])) * (1.f / 512.f) + RMS_EPS);
                }
            }
#pragma unroll
            for (int bj = BJ_LO; bj < BJ_HI; ++bj)
#pragma unroll
                for (int n = 0; n < 2; ++n) {
                    const f32x4 a = acc[ai][bj][m][n];
                    const int col = (bj - BJ_LO) * 128 + wc * 32 + n * 16 + fr;
                    *(LAS u32x2*)(L + col * PITCH + r0 * 2) = u32x2{cvtpk(a[0] * rs[0], a[1] * rs[1]), cvtpk(a[2] * rs[2], a[3] * rs[3])};
                }
        }
    __syncthreads();
    const int tid = (wr * 4 + wc) * 64 + fq * 16 + fr;
    constexpr int NCH = (BJ_HI - BJ_LO) * 128 * 32;
#pragma unroll
    for (int ch = 0; ch < NCH; ch += NTHR) {
        const int col = (ch + tid) >> 5, tc = (ch + tid) & 31;
        const u32x4 t = *(const LAS u32x4*)(L + col * PITCH + tc * 16);
        *(GAS u32x4*)((GAS bf16_t*)dst0 + (size_t)col * S + tc * 8) = t;
    }
    __syncthreads();
}
struct EpiEven {
    bf16_t* base;
    __device__ __forceinline__ void operator()(const f32x4 (&acc)[2][2][4][2], int brow, int bcol, int wr, int wc, int fr, int fq) const {
        const int g = bcol >> 10, h0 = (bcol & 1023) >> 7;
        bf16_t* dst = base + (size_t)g * EHSZ;
        const int b = brow >> 12;
        if (g != 2 && g != 5) {
#pragma unroll
            for (int ai = 0; ai < 2; ++ai)
#pragma unroll
                for (int m = 0; m < 4; ++m)
#pragma unroll
                    for (int j = 0; j < 4; ++j) {
                        const int sq = (brow & 4095) + ai * 128 + wr * 64 + m * 16 + fq * 4 + j;
#pragma unroll
                        for (int bj = 0; bj < 2; ++bj)
                            *(GAS unsigned*)(dst + ((size_t)(b * 8 + h0 + bj) * S + sq) * 128 + wc * 32 + 2 * fr) = cvtpk(acc[ai][bj][m][0][j], acc[ai][bj][m][1][j]);
                    }
        } else {
            vt_store_lds<0, 2>(acc, brow, wr, wc, fr, fq, nullptr, dst + ((size_t)(b * 8 + h0) * 128) * S + (brow & 4095));
        }
    }
};

struct EpiOddIn {
    bf16_t* cq; float* ssq; bf16_t* att; const float2* r128;
    __device__ __forceinline__ void operator()(const f32x4 (&acc)[2][2][4][2], int brow, int bcol, int wr, int wc, int fr, int fq) const {
        const int b = brow >> 12;
        if (bcol < 1024) {
            const int g = bcol >> 9, tg = (bcol >> 8) & 1;
#pragma unroll
            for (int ai = 0; ai < 2; ++ai)
#pragma unroll
                for (int m = 0; m < 4; ++m)
#pragma unroll
                    for (int j = 0; j < 4; ++j) {
                        const int row = brow + ai * 128 + wr * 64 + m * 16 + fq * 4 + j;
                        float ss = 0.f;
#pragma unroll
                        for (int bj = 0; bj < 2; ++bj) {
                            const float v0 = acc[ai][bj][m][0][j], v1 = acc[ai][bj][m][1][j];
                            ss = fmaf(v0, v0, ss); ss = fmaf(v1, v1, ss);
                            *(GAS unsigned*)(cq + ((size_t)g * T + row) * 512 + tg * 256 + bj * 128 + wc * 32 + 2 * fr) = cvtpk(v0, v1);
                        }
                        ss += swz_xor<1>(ss); ss += swz_xor<2>(ss); ss += swz_xor<4>(ss); ss += swz_xor<8>(ss);
                        if (fr == 0) *(GAS float*)(ssq + ((size_t)g * T + row) * 8 + tg * 4 + wc) = ss;
                    }
        } else if (bcol < 3072) {
            const int g2 = (bcol - 1024) >> 10, vh0 = ((bcol - 1024) & 1023) >> 7, i = wc * 16 + fr;
            bf16_t* dst = att + 2 * MHSZ + EHSZ + (size_t)g2 * EHSZ;
#pragma unroll
            for (int ai = 0; ai < 2; ++ai)
#pragma unroll
                for (int m = 0; m < 4; ++m)
#pragma unroll
                    for (int j = 0; j < 4; ++j) {
                        const int sq = (brow & 4095) + ai * 128 + wr * 64 + m * 16 + fq * 4 + j;
                        const float2 cs = r128[sq * 64 + i];
#pragma unroll
                        for (int bj = 0; bj < 2; ++bj) {
                            const float x1 = acc[ai][bj][m][0][j], x2 = acc[ai][bj][m][1][j];
                            GAS bf16_t* p = (GAS bf16_t*)(dst + ((size_t)(b * 8 + vh0 + bj) * S + sq) * 128);
                            p[i] = f2bf(x1 * cs.x - x2 * cs.y); p[64 + i] = f2bf(x2 * cs.x + x1 * cs.y);
                        }
                    }
        } else {
            const int c0 = bcol - 3072, hd = c0 >> 8;
            bf16_t* dst = att + 2 * MHSZ + 3 * EHSZ;
            vt_store_lds<0, 2>(acc, brow, wr, wc, fr, fq, nullptr, dst + ((size_t)(b * 4 + hd) * 256 + (c0 & 255)) * S + (brow & 4095));
        }
    }
};
__device__ __forceinline__ float rstd_from_ssq(const float* __restrict__ ssq, int row) {
    const f32x4 a = *(const GAS f32x4*)(ssq + (size_t)row * 8), c = *(const GAS f32x4*)(ssq + (size_t)row * 8 + 4);
    return rsqrtf(((a[0] + a[1]) + (a[2] + a[3]) + (c[0] + c[1]) + (c[2] + c[3])) * (1.f / 512.f) + RMS_EPS);
}
struct EpiUq {
    const float* ssq; bf16_t* qm; const float2* r64;
    __device__ __forceinline__ void operator()(const f32x4 (&acc)[2][2][4][2], int brow, int bcol, int wr, int wc, int fr, int fq) const {
        const int b = brow >> 12;
#pragma unroll
        for (int ai = 0; ai < 2; ++ai)
#pragma unroll
            for (int m = 0; m < 4; ++m)
#pragma unroll
                for (int j = 0; j < 4; ++j) {
                    const int row = brow + ai * 128 + wr * 64 + m * 16 + fq * 4 + j, sq = row & 4095;
                    const float rs = rstd_from_ssq(ssq, row);
                    if (bcol < 1024) {
#pragma unroll
                        for (int bj = 0; bj < 2; ++bj)
                            *(GAS unsigned*)(qm + ((size_t)(b * 8 + (bcol >> 7) + bj) * S + sq) * 192 + wc * 32 + 2 * fr) = cvtpk(acc[ai][bj][m][0][j] * rs, acc[ai][bj][m][1][j] * rs);
                    } else {
                        const int i = (wc & 1) * 16 + fr;
                        const float2 cs = r64[sq * 32 + i];
#pragma unroll
                        for (int bj = 0; bj < 2; ++bj) {
                            const int head = ((bcol - 1024) >> 8) * 4 + bj * 2 + (wc >> 1);
                            const float x1 = acc[ai][bj][m][0][j] * rs, x2 = acc[ai][bj][m][1][j] * rs;
                            GAS bf16_t* p = (GAS bf16_t*)(qm + ((size_t)(b * 8 + head) * S + sq) * 192 + 128);
                            p[i] = f2bf(x1 * cs.x - x2 * cs.y); p[32 + i] = f2bf(x2 * cs.x + x1 * cs.y);
                        }
                    }
                }
    }
};
struct EpiUkv {
    const float* ssq; bf16_t* km; bf16_t* vtm;
    __device__ __forceinline__ void operator()(const f32x4 (&acc)[2][2][4][2], int brow, int bcol, int wr, int wc, int fr, int fq) const {
        const int b = brow >> 12, head = bcol >> 8;
#pragma unroll
        for (int ai = 0; ai < 2; ++ai)
#pragma unroll
            for (int m = 0; m < 4; ++m) {
                const int row0 = brow + ai * 128 + wr * 64 + m * 16 + fq * 4, s0 = row0 & 4095;
                float rs[4];
#pragma unroll
                for (int j = 0; j < 4; ++j) rs[j] = rstd_from_ssq(ssq, row0 + j);
#pragma unroll
                for (int j = 0; j < 4; ++j)
                    *(GAS unsigned*)(km + ((size_t)(b * 8 + head) * S + s0 + j) * 192 + wc * 32 + 2 * fr) = cvtpk(acc[ai][0][m][0][j] * rs[j], acc[ai][0][m][1][j] * rs[j]);
            }
        vt_store_lds<1, 2>(acc, brow, wr, wc, fr, fq, ssq, vtm + ((size_t)(b * 8 + head) * 128) * S + (brow & 4095));
    }
};
__device__ __forceinline__ void kpe_finish(const float* __restrict__ KPE, const float2* __restrict__ R64, bf16_t* __restrict__ km) {
    const int tid_ = opaque_tid(); const int wave = tid_ >> 6, lane = tid_ & 63;
    for (int row = blockIdx.x * 8 + wave; row < T; row += NBLK * 8) {
        const int sq = row & 4095, b = row >> 12, i = lane & 31;
        const float2 cs = R64[sq * 32 + i];
        const float x1 = KPE[(size_t)row * 64 + i], x2 = KPE[(size_t)row * 64 + 32 + i];
        const bf16_t o = (lane < 32) ? f2bf(x1 * cs.x - x2 * cs.y) : f2bf(x2 * cs.x + x1 * cs.y);
#pragma unroll
        for (int h = 0; h < 8; ++h) km[((size_t)(b * 8 + h) * S + sq) * 192 + 128 + lane] = o;
    }
}

typedef __bf16 bf16x2_t __attribute__((ext_vector_type(2)));
__device__ __forceinline__ float dot2bf(unsigned w, unsigned x, float acc) { return __builtin_amdgcn_fdot2_f32_bf16(__builtin_bit_cast(bf16x2_t, w), __builtin_bit_cast(bf16x2_t, x), acc, false); }
template <int DK, int MODE, bool OUTF32>
__device__ __forceinline__ void attn_item(const bf16_t* __restrict__ Qh, const bf16_t* __restrict__ Kh, const bf16_t* __restrict__ Vth,
                                          void* __restrict__ outp, int out_ld, int q0,
                                          const float* __restrict__ cumh, const float* __restrict__ relb, float sc2) {
    extern __shared__ __attribute__((aligned(16))) unsigned char a_lds[];
    constexpr int KP = DK * 2 + 16, KBUF = 64 * KP, VP = 136, VBUF = 128 * VP;
    constexpr int OFF_V = 2 * 25600, OFF_CK = OFF_V + 2 * VBUF, OFF_RB = OFF_CK + 512;
    constexpr int NKS = DK / 16, KCH = DK / 8, NKL = (64 * KCH) / NTHR;
    const int tid = opaque_tid(), wave = tid >> 6, lane = tid & 63, c = lane & 31, hi = lane >> 5;
    const int rg = wave >> 1, kh = wave & 1;
    const int qw0 = q0 + 32 * rg, qrow = qw0 + c, cw = qw0 >> 6;
    int t_lo = 0;
    if (MODE == 1) { t_lo = (q0 >> 6) - 8; if (t_lo < 0) t_lo = 0; }
    const int t_hi = ((q0 + 127) >> 6) + 1;
    bf16x8 qf[NKS];
#pragma unroll
    for (int s = 0; s < NKS; ++s) qf[s] = *(const bf16x8*)(Qh + (size_t)qrow * DK + 16 * s + 8 * hi);
    float cq = 0.f;
    if (MODE == 0) cq = cumh[qrow];
#pragma unroll
    for (int s = 0; s < NKS; ++s) asm volatile("" : "+v"(qf[s]));
    asm volatile("" : "+v"(cq));
    if (MODE == 1) { for (int i = tid; i < 257; i += NTHR) ((float*)(a_lds + OFF_RB))[i] = relb[i] * LOG2E; }
    float cso = 0.f;
    const float* offs = (const float*)(a_lds + OFF_RB);
    if (MODE == 0) {
        if (wave == 0) {
            const float v0 = relb[lane], v1 = relb[64 + lane];
            float s0 = v0, s1 = v1;
#pragma unroll
            for (int d_ = 1; d_ < 64; d_ <<= 1) {
                const float t0 = __int_as_float(__builtin_amdgcn_ds_bpermute((lane - d_) * 4, __float_as_int(s0)));
                const float t1 = __int_as_float(__builtin_amdgcn_ds_bpermute((lane - d_) * 4, __float_as_int(s1)));
                if (lane >= d_) { s0 += t0; s1 += t1; }
            }
            const float tot0 = __int_as_float(__builtin_amdgcn_readlane(__float_as_int(s0), 63));
            ((float*)(a_lds + OFF_RB))[lane] = s0 - v0; ((float*)(a_lds + OFF_RB))[64 + lane] = s1 - v1 + tot0;
        }
        __syncthreads();
        cq += offs[qrow >> 5];
    }
    u32x4 kst0, kst1, kst2 = u32x4{0u, 0u, 0u, 0u}, vst0, vst1; f32x4 cst = f32x4{0.f, 0.f, 0.f, 0.f};
    const int kr0 = tid / KCH, kc0 = tid % KCH, kr1 = (tid + NTHR) / KCH, kc1 = (tid + NTHR) % KCH, kr2 = (tid + 2 * NTHR) / KCH, kc2 = (tid + 2 * NTHR) % KCH;
    const int vd0 = tid >> 3, vc0 = tid & 7, vd1 = vd0 + 64;
    const GAS bf16_t* Kg = (const GAS bf16_t*)Kh; const GAS bf16_t* Vg = (const GAS bf16_t*)Vth; const GAS float* cumg = (const GAS float*)cumh;
#define A_ISSUE(tt) do { const int key0_ = 64 * (tt); \
        kst0 = *(const GAS u32x4*)(Kg + (size_t)(key0_ + kr0) * DK + kc0 * 8); \
        kst1 = *(const GAS u32x4*)(Kg + (size_t)(key0_ + kr1) * DK + kc1 * 8); \
        if (NKL == 3) kst2 = *(const GAS u32x4*)(Kg + (size_t)(key0_ + kr2) * DK + kc2 * 8); \
        vst0 = *(const GAS u32x4*)(Vg + (size_t)vd0 * S + key0_ + vc0 * 8); \
        vst1 = *(const GAS u32x4*)(Vg + (size_t)vd1 * S + key0_ + vc0 * 8); \
        if (MODE == 0) { if (tid < 16) { cst = *(const GAS f32x4*)(cumg + key0_ + 4 * tid); cso = offs[(key0_ + 4 * tid) >> 5]; } } } while (0)
#define A_WRITE(bf) do { \
        *(u32x4*)(a_lds + (bf) * KBUF + kr0 * KP + kc0 * 16) = kst0; \
        *(u32x4*)(a_lds + (bf) * KBUF + kr1 * KP + kc1 * 16) = kst1; \
        if (NKL == 3) *(u32x4*)(a_lds + (bf) * KBUF + kr2 * KP + kc2 * 16) = kst2; \
        { unsigned char* vp_ = a_lds + OFF_V + (bf) * VBUF + vd0 * VP + vc0 * 16; *(u32x2*)vp_ = u32x2{vst0[0], vst0[1]}; *(u32x2*)(vp_ + 8) = u32x2{vst0[2], vst0[3]}; } \
        { unsigned char* vp_ = a_lds + OFF_V + (bf) * VBUF + vd1 * VP + vc0 * 16; *(u32x2*)vp_ = u32x2{vst1[0], vst1[1]}; *(u32x2*)(vp_ + 8) = u32x2{vst1[2], vst1[3]}; } \
        if (MODE == 0) { if (tid < 16) *(f32x4*)(a_lds + OFF_CK + (bf) * 256 + tid * 16) = f32x4{cst[0] + cso, cst[1] + cso, cst[2] + cso, cst[3] + cso}; } } while (0)
    A_ISSUE(t_lo); A_WRITE(0);
    __syncthreads();
    float m = -1e30f, l = 0.f;
    f32x16 o[4];
#pragma unroll
    for (int db = 0; db < 4; ++db)
#pragma unroll
        for (int r = 0; r < 16; ++r) o[db][r] = 0.f;
    const float NEGINF = -__builtin_inff();
    for (int t = t_lo; t < t_hi; ++t) {
        const int cur = (t - t_lo) & 1;
        if (t + 1 < t_hi) A_ISSUE(t + 1);
        bool act;
        if (MODE == 0) act = (64 * t + 32 * kh) <= (qw0 + 31);
        else if (MODE == 1) act = (t <= cw) && (t >= cw - 8);
        else act = (t <= cw);
        if (act) {
            f32x16 p;
#pragma unroll
            for (int r = 0; r < 16; ++r) p[r] = 0.f;
            const unsigned char* kb = a_lds + cur * KBUF + (32 * kh + c) * KP + hi * 16;
            constexpr bool HOISTK = true;
            bf16x8 kf[NKS];
            if (HOISTK) {
#pragma unroll
                for (int s = 0; s < NKS; ++s) kf[s] = *(const bf16x8*)(kb + s * 32);
            }
            const unsigned char* vb = a_lds + OFF_V + cur * VBUF + c * VP + (32 * kh + 4 * hi) * 2;
            bf16x8 vf[8];
#define A_VREADS(D0, D1) do { _Pragma("unroll") for (int dq_ = (D0); dq_ < (D1); ++dq_) _Pragma("unroll") for (int s2 = 0; s2 < 2; ++s2) { \
                    const uint2 v0 = *(const uint2*)(vb + dq_ * 32 * VP + s2 * 32), v1 = *(const uint2*)(vb + dq_ * 32 * VP + s2 * 32 + 16); \
                    const uint4 u = make_uint4(v0.x, v0.y, v1.x, v1.y); vf[2 * dq_ + s2] = *reinterpret_cast<const bf16x8*>(&u); } } while (0)
            constexpr bool HOISTV = (DK == 128) && (MODE == 2 || MODE == 1);
            if (HOISTV) A_VREADS(0, 3);
            if (HOISTK) __builtin_amdgcn_sched_barrier(0);
#pragma unroll
            for (int s = 0; s < NKS; ++s) p = __builtin_amdgcn_mfma_f32_32x32x16_bf16(HOISTK ? kf[s] : *(const bf16x8*)(kb + s * 32), qf[s], p, 0, 0, 0);
            if (HOISTV) { A_VREADS(3, 4); __builtin_amdgcn_sched_barrier(0); }
            if (MODE == 0) {
                const float* ckp = (const float*)(a_lds + OFF_CK + cur * 256) + 32 * kh + 4 * hi;
#pragma unroll
                for (int g = 0; g < 4; ++g) {
                    const float4 ck = *(const float4*)(ckp + 8 * g);
                    p[4 * g + 0] = fmaf(p[4 * g + 0], sc2, cq - ck.x); p[4 * g + 1] = fmaf(p[4 * g + 1], sc2, cq - ck.y);
                    p[4 * g + 2] = fmaf(p[4 * g + 2], sc2, cq - ck.z); p[4 * g + 3] = fmaf(p[4 * g + 3], sc2, cq - ck.w);
                }
                if (64 * t + 32 * kh + 31 > qw0) {
                    const int kbase = 64 * t + 32 * kh + 4 * hi;
#pragma unroll
                    for (int r = 0; r < 16; ++r) if (kbase + (r & 3) + 8 * (r >> 2) > qrow) p[r] = NEGINF;
                }
            } else if (MODE == 1) {
                const float* rb = (const float*)(a_lds + OFF_RB);
                if (t <= cw - 3) {
                    const float bb = rb[256];
#pragma unroll
                    for (int r = 0; r < 16; ++r) p[r] = fmaf(p[r], sc2, bb);
                } else {
                    const int kbase = 64 * t + 32 * kh + 4 * hi;
#pragma unroll
                    for (int r = 0; r < 16; ++r) { int rel = qrow - (kbase + (r & 3) + 8 * (r >> 2)); rel = rel > 128 ? 128 : rel; p[r] = fmaf(p[r], sc2, rb[rel + 128]); }
                }
            }
            float mx = p[0];
#pragma unroll
            for (int r = 1; r < 16; ++r) mx = fmaxf(mx, p[r]);
            if (MODE == 2) mx *= sc2;
            { auto rr = __builtin_amdgcn_permlane32_swap(__float_as_uint(mx), __float_as_uint(mx), false, false); mx = fmaxf(__uint_as_float(rr[0]), __uint_as_float(rr[1])); }
            if (!__all(mx - m <= 8.f)) {
                const float mn = fmaxf(m, mx), alpha = __builtin_amdgcn_exp2f(m - mn);
                m = mn; l *= alpha;
#pragma unroll
                for (int db = 0; db < 4; ++db)
#pragma unroll
                    for (int r = 0; r < 16; ++r) o[db][r] *= alpha;
            }
#pragma unroll
            for (int r = 0; r < 16; ++r) p[r] = __builtin_amdgcn_exp2f((MODE == 2) ? fmaf(p[r], sc2, -m) : (p[r] - m));
            bf16x8 pb0, pb1;
            { const unsigned w0 = cvtpk(p[0], p[1]), w1 = cvtpk(p[2], p[3]), w2 = cvtpk(p[4], p[5]), w3 = cvtpk(p[6], p[7]);
              const uint4 u = make_uint4(w0, w1, w2, w3); pb0 = *reinterpret_cast<const bf16x8*>(&u); }
            { const unsigned w0 = cvtpk(p[8], p[9]), w1 = cvtpk(p[10], p[11]), w2 = cvtpk(p[12], p[13]), w3 = cvtpk(p[14], p[15]);
              const uint4 u = make_uint4(w0, w1, w2, w3); pb1 = *reinterpret_cast<const bf16x8*>(&u); }
            {
                const uint4 ua = *reinterpret_cast<const uint4*>(&pb0), ub = *reinterpret_cast<const uint4*>(&pb1);
                float ps = 0.f, ps2 = 0.f;
                ps = dot2bf(ua.x, 0x3f803f80u, ps); ps2 = dot2bf(ua.y, 0x3f803f80u, ps2); ps = dot2bf(ua.z, 0x3f803f80u, ps); ps2 = dot2bf(ua.w, 0x3f803f80u, ps2);
                ps = dot2bf(ub.x, 0x3f803f80u, ps); ps2 = dot2bf(ub.y, 0x3f803f80u, ps2); ps = dot2bf(ub.z, 0x3f803f80u, ps); ps2 = dot2bf(ub.w, 0x3f803f80u, ps2);
                l += ps + ps2;
            }
            if (HOISTK && !HOISTV) A_VREADS(0, 4);
            if (HOISTK) __builtin_amdgcn_sched_barrier(0);
#pragma unroll
            for (int db = 0; db < 4; ++db) {
                if (!HOISTK) { A_VREADS(db, db + 1); }
                o[db] = __builtin_amdgcn_mfma_f32_32x32x16_bf16(vf[2 * db], pb0, o[db], 0, 0, 0);
                o[db] = __builtin_amdgcn_mfma_f32_32x32x16_bf16(vf[2 * db + 1], pb1, o[db], 0, 0, 0);
            }
#undef A_VREADS
        }
        if (t + 1 < t_hi) A_WRITE(cur ^ 1);
        __syncthreads();
    }
#undef A_ISSUE
#undef A_WRITE
    { auto rr = __builtin_amdgcn_permlane32_swap(__float_as_uint(l), __float_as_uint(l), false, false); l = __uint_as_float(rr[0]) + __uint_as_float(rr[1]); }
    float* xo = (float*)a_lds + wave * 2176;
    if (kh == 0) {
#pragma unroll
        for (int r = 0; r < 16; ++r) { xo[r * 64 + lane] = o[2][r]; xo[(16 + r) * 64 + lane] = o[3][r]; }
    } else {
#pragma unroll
        for (int r = 0; r < 16; ++r) { xo[r * 64 + lane] = o[0][r]; xo[(16 + r) * 64 + lane] = o[1][r]; }
    }
    xo[2048 + lane] = m; xo[2112 + lane] = l;
    __syncthreads();
    const float* xp = (const float*)a_lds + (wave ^ 1) * 2176;
    const float mp = xp[2048 + lane], lp = xp[2112 + lane];
    const float M = fmaxf(m, mp), ea = __builtin_amdgcn_exp2f(m - M), eb = __builtin_amdgcn_exp2f(mp - M);
    const float inv = 1.f / (l * ea + lp * eb), fa = ea * inv, fb = eb * inv;
#define A_OUT(OA, OB, dbase) do { \
        _Pragma("unroll") for (int x_ = 0; x_ < 2; ++x_) { \
            _Pragma("unroll") for (int g_ = 0; g_ < 4; ++g_) { \
                float v_[4]; \
                _Pragma("unroll") for (int e_ = 0; e_ < 4; ++e_) { const int r_ = 4 * g_ + e_; v_[e_] = (x_ ? OB[r_] : OA[r_]) * fa + xp[(x_ * 16 + r_) * 64 + lane] * fb; } \
                const int d_ = (dbase + x_) * 32 + 8 * g_ + 4 * hi; \
                if (OUTF32) *(GAS f32x4*)((float*)outp + (size_t)qrow * out_ld + d_) = f32x4{v_[0], v_[1], v_[2], v_[3]}; \
                else *(GAS u32x2*)((bf16_t*)outp + (size_t)qrow * out_ld + d_) = u32x2{cvtpk(v_[0], v_[1]), cvtpk(v_[2], v_[3])}; } } } while (0)
    if (kh == 0) A_OUT(o[0], o[1], 0); else A_OUT(o[2], o[3], 2);
#undef A_OUT
    __syncthreads();
}

template <int MODE>
__device__ __forceinline__ void attn_naive_b(const bf16_t* __restrict__ Qh, const bf16_t* __restrict__ Kh, const bf16_t* __restrict__ Vth, int dk,
                                             float* __restrict__ Of, bf16_t* __restrict__ Ob, int ldo, int t8,
                                             const float* __restrict__ cumh, const float* __restrict__ relb, float sc2, float* lds) {
    const int tid_ = opaque_tid(); const int wave = tid_ >> 6, lane = tid_ & 63;
    float* qs = lds + wave * 4352;
    float* sc = qs + 256;
    const int t = t8 * 8 + wave;
    for (int d = lane; d < dk; d += 64) qs[d] = bf2f(Qh[(size_t)t * dk + d]);
    int klo, khi;
    if (MODE == 0) { klo = 0; khi = t + 1; }
    else if (MODE == 1) { const int c = t >> 6; klo = (c - 8) * 64; if (klo < 0) klo = 0; khi = (c + 1) * 64; }
    else { klo = 0; khi = ((t >> 6) + 1) * 64; }
    __syncthreads();
    float mx = -3e38f;
    const float cq = (MODE == 0) ? cumh[t] : 0.f;
    for (int s = klo + lane; s < khi; s += 64) {
        const bf16_t* kp = Kh + (size_t)s * dk;
        float a = 0.f;
        for (int d = 0; d < dk; d += 8) {
            const uint4 kv = *(const uint4*)(kp + d);
            a = fmaf(qs[d], __uint_as_float(kv.x << 16), a); a = fmaf(qs[d + 1], __uint_as_float(kv.x & 0xffff0000u), a);
            a = fmaf(qs[d + 2], __uint_as_float(kv.y << 16), a); a = fmaf(qs[d + 3], __uint_as_float(kv.y & 0xffff0000u), a);
            a = fmaf(qs[d + 4], __uint_as_float(kv.z << 16), a); a = fmaf(qs[d + 5], __uint_as_float(kv.z & 0xffff0000u), a);
            a = fmaf(qs[d + 6], __uint_as_float(kv.w << 16), a); a = fmaf(qs[d + 7], __uint_as_float(kv.w & 0xffff0000u), a);
        }
        a *= sc2;
        if (MODE == 0) a += cq - cumh[s];
        if (MODE == 1) { int rel = t - s; rel = rel < -128 ? -128 : (rel > 128 ? 128 : rel); a += relb[rel + 128] * LOG2E; }
        sc[s - klo] = a; mx = fmaxf(mx, a);
    }
    mx = wmaxf(mx);
    float sum = 0.f;
    for (int s = klo + lane; s < khi; s += 64) { const float p = exp2f(sc[s - klo] - mx); sc[s - klo] = p; sum += p; }
    sum = wsum(sum);
    const float inv = 1.f / sum;
    __syncthreads();
    for (int d0 = 0; d0 < 128; d0 += 64) {
        const int d = d0 + lane;
        const bf16_t* vp = Vth + (size_t)d * S;
        float a0 = 0.f, a1 = 0.f;
        int s = klo;
        for (; s + 1 < khi; s += 2) { a0 = fmaf(sc[s - klo], bf2f(vp[s]), a0); a1 = fmaf(sc[s + 1 - klo], bf2f(vp[s + 1]), a1); }
        for (; s < khi; ++s) a0 = fmaf(sc[s - klo], bf2f(vp[s]), a0);
        const float ov = (a0 + a1) * inv;
        if (Ob) Ob[(size_t)t * ldo + d] = f2bf(ov); else Of[(size_t)t * ldo + d] = ov;
    }
    __syncthreads();
}

template <bool NAIVE>
__device__ __forceinline__ void attn_even_phase(const bf16_t* __restrict__ att, const float* __restrict__ cumh, const float* __restrict__ relb,
                                                bf16_t* __restrict__ Ob, unsigned* ctr, float* lds, const float* __restrict__ tot) {
    extern __shared__ __attribute__((aligned(16))) unsigned char ae_lds[];
    volatile int* slot = (volatile int*)(ae_lds + 140 * 1024);
    constexpr float SC2 = 0.08838834764831845f * LOG2E;
    if (NAIVE) {
        for (int item = blockIdx.x; item < 2 * 16 * (S / 8); item += NBLK) {
            const int kind = item / (16 * (S / 8)), r = item % (16 * (S / 8)), bh = r / (S / 8), t8 = r % (S / 8), b = bh >> 3, h = bh & 7;
            if (kind == 0) attn_naive_b<0>(att + (size_t)bh * S * 128, att + EHSZ + (size_t)bh * S * 128, att + 2 * EHSZ + (size_t)bh * 128 * S, 128,
                                           nullptr, Ob + (size_t)b * S * D + h * 128, D, t8, cumh + (size_t)bh * S, nullptr, SC2, lds);
            else attn_naive_b<1>(att + 3 * EHSZ + (size_t)bh * S * 128, att + 4 * EHSZ + (size_t)bh * S * 128, att + 5 * EHSZ + (size_t)bh * 128 * S, 128,
                                 nullptr, Ob + (size_t)b * S * D + 1024 + h * 128, D, t8, nullptr, relb + h * 257, SC2, lds);
        }
    } else {
        int item = blockIdx.x;
        while (item < 1024) {
            if (item < 512) {
                const int j = 31 - (item >> 4), bh = item & 15, b = bh >> 3, h = bh & 7;
                attn_item<128, 0, false>(att + (size_t)bh * S * 128, att + EHSZ + (size_t)bh * S * 128, att + 2 * EHSZ + (size_t)bh * 128 * S,
                                         Ob + (size_t)b * S * D + h * 128, D, j * 128, cumh + (size_t)bh * S, tot + bh * 128, SC2);
            } else {
                const int r = item - 512, j = r >> 4, bh = r & 15, b = bh >> 3, h = bh & 7;
                attn_item<128, 1, false>(att + 3 * EHSZ + (size_t)bh * S * 128, att + 4 * EHSZ + (size_t)bh * S * 128, att + 5 * EHSZ + (size_t)bh * 128 * S,
                                         Ob + (size_t)b * S * D + 1024 + h * 128, D, j * 128, nullptr, relb + h * 257, SC2);
            }
            if (opaque_tid() == 0) *slot = NBLK + (int)atomicAdd(ctr, 1u);
            __syncthreads();
            item = *slot;
        }
    }
}

__device__ __forceinline__ void attn_odd_phase(const bf16_t* __restrict__ att, bf16_t* __restrict__ Ob, float* __restrict__ A12, unsigned* ctr) {
    extern __shared__ __attribute__((aligned(16))) unsigned char ao_lds[];
    volatile int* slot = (volatile int*)(ao_lds + 140 * 1024);
    constexpr float SC128 = 0.08838834764831845f * LOG2E, SC192 = 0.07216878364870323f * LOG2E;
    int item = blockIdx.x;
    while (item < 48 * 32) {
        const int j = 31 - item / 48, r = item % 48;
        if (r < 16) {
            const int bh = r, b = bh >> 3, h = bh & 7;
            attn_item<192, 2, false>(att + (size_t)bh * S * 192, att + MHSZ + (size_t)bh * S * 192, att + 2 * MHSZ + (size_t)bh * 128 * S,
                                     Ob + (size_t)b * S * D + h * 128, D, j * 128, nullptr, nullptr, SC192);
        } else {
            const int v = r - 16, b = v >> 4, vh2 = v & 15, vh = vh2 >> 1, half = vh2 & 1, hd = vh >> 1, comp = vh & 1;
            attn_item<128, 2, true>(att + 2 * MHSZ + EHSZ + (size_t)(b * 8 + vh) * S * 128, att + 2 * MHSZ + 2 * EHSZ + (size_t)(b * 8 + vh) * S * 128,
                                    att + 2 * MHSZ + 3 * EHSZ + ((size_t)(b * 4 + hd) * 256 + half * 128) * S,
                                    A12 + (size_t)b * S * D + hd * 512 + comp * 256 + half * 128, D, j * 128, nullptr, nullptr, SC128);
        }
        if (opaque_tid() == 0) *slot = NBLK + (int)atomicAdd(ctr, 1u);
        __syncthreads();
        item = *slot;
    }
}

__device__ __forceinline__ void cumsum_b(const float* __restrict__ GL, const float* __restrict__ bf, float* __restrict__ CUMH, float* lds) {
    const int tid = opaque_tid();
    for (int seq = blockIdx.x; seq < NB * 8; seq += NBLK) {
        const int b = seq >> 3, h = seq & 7;
        float v[8]; float run = 0.f;
#pragma unroll
        for (int i = 0; i < 8; ++i) {
            const int t = tid * 8 + i;
            const float z = GL[((size_t)b * S + t) * 8 + h] + bf[h];
            const float ls = fminf(z, 0.f) - log1pf(expf(-fabsf(z)));
            run += ls; v[i] = run;
        }
        float incl = run;
        lds[tid] = incl;
        __syncthreads();
#pragma unroll 1
        for (int d_ = 1; d_ < NTHR; d_ <<= 1) {
            const float add = (tid >= d_) ? lds[tid - d_] : 0.f;
            __syncthreads();
            incl += add; lds[tid] = incl;
            __syncthreads();
        }
        const float off = incl - run;
#pragma unroll
        for (int i = 0; i < 8; ++i) CUMH[(size_t)seq * S + tid * 8 + i] = (v[i] + off) * LOG2E;
        __syncthreads();
    }
}

__device__ __forceinline__ void copy_f4(const float* __restrict__ src, float* __restrict__ dst, size_t n) {
    const size_t n4 = n / 4;
    const int tid_ = opaque_tid();
    for (size_t i = (size_t)blockIdx.x * NTHR + tid_; i < n4; i += (size_t)NBLK * NTHR)
        ((float4*)dst)[i] = ((const float4*)src)[i];
}

__device__ __forceinline__ void copy_convert_f4(const float* __restrict__ src, float* __restrict__ dst, bf16_t* __restrict__ dstb, size_t n) {
    const size_t n4 = n / 4;
    const int tid_ = opaque_tid();
    for (size_t i = (size_t)blockIdx.x * NTHR + tid_; i < n4; i += (size_t)NBLK * NTHR) {
        const float4 v = ((const float4*)src)[i];
        ((float4*)dst)[i] = v;
        ((uint2*)dstb)[i] = make_uint2(cvtpk(v.x, v.y), cvtpk(v.z, v.w));
    }
}

__device__ __forceinline__ void rope_tables(float2* __restrict__ R128, float2* __restrict__ R64) {
    const int tid_ = opaque_tid();
    for (int e = blockIdx.x * NTHR + tid_; e < S * 96; e += NBLK * NTHR) {
        const int t = e / 96, j = e % 96;
        const bool big = j < 64;
        const int i = big ? j : j - 64;
        const double inv = pow(10000.0, -(2.0 * i) / (big ? 128.0 : 64.0)), ang = (double)t * inv;
        const float2 cs = make_float2((float)cos(ang), (float)sin(ang));
        if (big) R128[t * 64 + i] = cs; else R64[t * 32 + i] = cs;
    }
}

__device__ __forceinline__ void gemm_naive(const float* __restrict__ A, int lda, const float* __restrict__ W, int ldw,
                           float* __restrict__ C, int ldc, int M, int N, int K, float* lds) {
    float* As = lds;
    float* Bs = lds + 16 * 132;
    const int tid = opaque_tid(), ty = tid >> 5, tx = tid & 31;
    const int ntn = (N + 127) / 128, ntiles = (M / 128) * ntn;
    for (int tile = blockIdx.x; tile < ntiles; tile += NBLK) {
        const int m0 = (tile / ntn) * 128, n0 = (tile % ntn) * 128;
        float acc[8][4];
#pragma unroll
        for (int i = 0; i < 8; ++i)
#pragma unroll
            for (int j = 0; j < 4; ++j) acc[i][j] = 0.f;
        for (int k0 = 0; k0 < K; k0 += 16) {
            {
                const int r = tid >> 2, kq = (tid & 3) * 4;
                const float4 a = *(const float4*)(A + (size_t)(m0 + r) * lda + k0 + kq);
                As[(kq + 0) * 132 + r] = a.x; As[(kq + 1) * 132 + r] = a.y; As[(kq + 2) * 132 + r] = a.z; As[(kq + 3) * 132 + r] = a.w;
            }
            {
                const int k = tid >> 5, n = (tid & 31) * 4;
                float4 b = make_float4(0.f, 0.f, 0.f, 0.f);
                if (n0 + n < N) b = *(const float4*)(W + (size_t)(k0 + k) * ldw + n0 + n);
                *(float4*)(Bs + k * 128 + n) = b;
            }
            __syncthreads();
#pragma unroll
            for (int k = 0; k < 16; ++k) {
                const float4 a0 = *(const float4*)(As + k * 132 + ty * 8), a1 = *(const float4*)(As + k * 132 + ty * 8 + 4);
                const float4 b = *(const float4*)(Bs + k * 128 + tx * 4);
                const float av[8] = {a0.x, a0.y, a0.z, a0.w, a1.x, a1.y, a1.z, a1.w};
                const float bv[4] = {b.x, b.y, b.z, b.w};
#pragma unroll
                for (int i = 0; i < 8; ++i)
#pragma unroll
                    for (int j = 0; j < 4; ++j) acc[i][j] = fmaf(av[i], bv[j], acc[i][j]);
            }
            __syncthreads();
        }
        if (n0 + tx * 4 < N) {
#pragma unroll
            for (int i = 0; i < 8; ++i)
                *(float4*)(C + (size_t)(m0 + ty * 8 + i) * ldc + n0 + tx * 4) = make_float4(acc[i][0], acc[i][1], acc[i][2], acc[i][3]);
        }
    }
}

__device__ __forceinline__ void cumsum_naive(const float* __restrict__ P, const float* __restrict__ bf, float* __restrict__ CUM, float* lds) {
    const int tid = opaque_tid();
    for (int seq = blockIdx.x; seq < NB * 8; seq += NBLK) {
        const int b = seq >> 3, h = seq & 7;
        float v[8]; float run = 0.f;
#pragma unroll
        for (int i = 0; i < 8; ++i) {
            const int t = tid * 8 + i;
            const float z = P[((size_t)b * S + t) * NEV + 3072 + h] + bf[h];
            const float ls = fminf(z, 0.f) - log1pf(expf(-fabsf(z)));
            run += ls; v[i] = run;
        }
        lds[tid] = run;
        __syncthreads();
        if (tid == 0) { float a = 0.f; for (int i = 0; i < NTHR; ++i) { const float x = lds[i]; lds[i] = a; a += x; } }
        __syncthreads();
        const float off = lds[tid];
#pragma unroll
        for (int i = 0; i < 8; ++i) CUM[((size_t)b * S + tid * 8 + i) * 8 + h] = v[i] + off;
        __syncthreads();
    }
}

template <int MODE>
__device__ __forceinline__ void attn_naive(const float* __restrict__ Q, int ldq, int qoff, int qhs,
                           const float* __restrict__ K1, int ldk1, int k1off, int k1hs, int dk1,
                           const float* __restrict__ K2, int ldk2, int k2off, int dk2,
                           const float* __restrict__ V, int ldv, int voff, int vhs, int vshift, int dv,
                           float* __restrict__ O, bf16_t* __restrict__ Ob, int ldo, int ooff, int ohs,
                           float scale, int nheads, const float* __restrict__ cum, const float* __restrict__ relb, float* lds) {
    const int tid_ = opaque_tid(); const int wave = tid_ >> 6, lane = tid_ & 63;
    float* qs = lds + wave * 4352;
    float* sc = qs + 256;
    const int nitems = nheads * NB * (S / 8);
    for (int item = blockIdx.x; item < nitems; item += NBLK) {
        const int t8 = item % (S / 8), bh = item / (S / 8), h = bh % nheads, b = bh / nheads;
        const int t = t8 * 8 + wave;
        const size_t row = (size_t)b * S + t;
        const float* qp = Q + row * ldq + qoff + h * qhs;
        for (int d = lane; d < dk1 + dk2; d += 64) qs[d] = qp[d];
        int klo, khi;
        if (MODE == 0) { klo = 0; khi = t + 1; }
        else if (MODE == 1) { const int c = t >> 6; klo = (c - 8) * 64; if (klo < 0) klo = 0; khi = (c + 1) * 64; }
        else { klo = 0; khi = ((t >> 6) + 1) * 64; }
        __syncthreads();
        float mx = -3e38f;
        const float cq = (MODE == 0) ? cum[row * 8 + h] : 0.f;
        for (int s = klo + lane; s < khi; s += 64) {
            const size_t krow = (size_t)b * S + s;
            const float* kp = K1 + krow * ldk1 + k1off + h * k1hs;
            float a = 0.f;
            for (int d = 0; d < dk1; d += 4) {
                const float4 kv = *(const float4*)(kp + d);
                a = fmaf(qs[d], kv.x, a); a = fmaf(qs[d + 1], kv.y, a); a = fmaf(qs[d + 2], kv.z, a); a = fmaf(qs[d + 3], kv.w, a);
            }
            if (dk2 > 0) {
                const float* kp2 = K2 + krow * ldk2 + k2off;
                for (int d = 0; d < dk2; d += 4) {
                    const float4 kv = *(const float4*)(kp2 + d);
                    a = fmaf(qs[dk1 + d], kv.x, a); a = fmaf(qs[dk1 + d + 1], kv.y, a); a = fmaf(qs[dk1 + d + 2], kv.z, a); a = fmaf(qs[dk1 + d + 3], kv.w, a);
                }
            }
            a *= scale;
            if (MODE == 0) a += cq - cum[krow * 8 + h];
            if (MODE == 1) { int rel = t - s; rel = rel < -128 ? -128 : (rel > 128 ? 128 : rel); a += relb[h * 257 + rel + 128]; }
            sc[s - klo] = a; mx = fmaxf(mx, a);
        }
        mx = wmaxf(mx);
        float sum = 0.f;
        for (int s = klo + lane; s < khi; s += 64) { const float p = expf(sc[s - klo] - mx); sc[s - klo] = p; sum += p; }
        sum = wsum(sum);
        const float inv = 1.f / sum;
        __syncthreads();
        const int vh = h >> vshift;
        for (int d0 = 0; d0 < dv; d0 += 64) {
            const int d = d0 + lane;
            const float* vp = V + (size_t)b * S * ldv + voff + vh * vhs + d;
            float a0 = 0.f, a1 = 0.f, a2 = 0.f, a3 = 0.f;
            int s = klo;
            for (; s + 3 < khi; s += 4) {
                a0 = fmaf(sc[s - klo], vp[(size_t)s * ldv], a0);
                a1 = fmaf(sc[s + 1 - klo], vp[(size_t)(s + 1) * ldv], a1);
                a2 = fmaf(sc[s + 2 - klo], vp[(size_t)(s + 2) * ldv], a2);
                a3 = fmaf(sc[s + 3 - klo], vp[(size_t)(s + 3) * ldv], a3);
            }
            for (; s < khi; ++s) a0 = fmaf(sc[s - klo], vp[(size_t)s * ldv], a0);
            const float ov = ((a0 + a1) + (a2 + a3)) * inv;
            if (Ob) Ob[row * ldo + ooff + h * ohs + d] = f2bf(ov); else O[row * ldo + ooff + h * ohs + d] = ov;
        }
        __syncthreads();
    }
}

__device__ __forceinline__ void ln_res_naive(const float* X, const float* __restrict__ Y, const float* __restrict__ g, const float* __restrict__ bb, float* dst, bf16_t* __restrict__ xb) {
    const int tid_ = opaque_tid(); const int wave = tid_ >> 6, lane = tid_ & 63;
    for (int row = blockIdx.x * 8 + wave; row < T; row += NBLK * 8) {
        float4 z[8]; float s = 0.f;
#pragma unroll
        for (int i = 0; i < 8; ++i) {
            const float4 x = ((const float4*)(X + (size_t)row * D))[i * 64 + lane];
            const float4 y = ((const float4*)(Y + (size_t)row * D))[i * 64 + lane];
            z[i] = make_float4(ALPHA * x.x + y.x, ALPHA * x.y + y.y, ALPHA * x.z + y.z, ALPHA * x.w + y.w);
            s += (z[i].x + z[i].y) + (z[i].z + z[i].w);
        }
        const float mu = wsum(s) * (1.f / D);
        float v = 0.f;
#pragma unroll
        for (int i = 0; i < 8; ++i) { const float a = z[i].x - mu, b = z[i].y - mu, c = z[i].z - mu, d = z[i].w - mu; v += (a * a + b * b) + (c * c + d * d); }
        const float rstd = rsqrtf(wsum(v) * (1.f / D) + LN_EPS);
#pragma unroll
        for (int i = 0; i < 8; ++i) {
            const float4 gg = ((const float4*)g)[i * 64 + lane], b4 = ((const float4*)bb)[i * 64 + lane];
            const float4 o4 = make_float4((z[i].x - mu) * rstd * gg.x + b4.x, (z[i].y - mu) * rstd * gg.y + b4.y,
                                          (z[i].z - mu) * rstd * gg.z + b4.z, (z[i].w - mu) * rstd * gg.w + b4.w);
            ((float4*)(dst + (size_t)row * D))[i * 64 + lane] = o4;
            ((uint2*)(xb + (size_t)row * D))[i * 64 + lane] = make_uint2(cvtpk(o4.x, o4.y), cvtpk(o4.z, o4.w));
        }
    }
}

__device__ __forceinline__ void odd_prep_naive(float* __restrict__ P, const float* __restrict__ gq, const float* __restrict__ gkv, const float2* __restrict__ R128, const float2* __restrict__ R64, bf16_t* __restrict__ CQb) {
    const int tid_ = opaque_tid(); const int wave = tid_ >> 6, lane = tid_ & 63;
    for (int row = blockIdx.x * 8 + wave; row < T; row += NBLK * 8) {
        float* p = P + (size_t)row * NOD;
        const int t = row % S;
        for (int part = 0; part < 2; ++part) {
            float* c = p + part * 512; const float* g = part ? gkv : gq;
            float v[8]; float ss = 0.f;
#pragma unroll
            for (int i = 0; i < 8; ++i) { v[i] = c[i * 64 + lane]; ss += v[i] * v[i]; }
            const float r = rsqrtf(wsum(ss) * (1.f / 512.f) + RMS_EPS);
#pragma unroll
            for (int i = 0; i < 8; ++i) CQb[((size_t)part * T + row) * 512 + i * 64 + lane] = f2bf(v[i] * r * g[i * 64 + lane]);
        }
        if (lane < 32) {
            const float2 cs = R64[t * 32 + lane];
            const float x1 = p[1024 + lane], x2 = p[1024 + 32 + lane];
            p[1024 + lane] = x1 * cs.x - x2 * cs.y; p[1024 + 32 + lane] = x2 * cs.x + x1 * cs.y;
        }
        {
            const float2 cs = R128[t * 64 + lane];
            for (int sl = 0; sl < 16; ++sl) {
                float* c = p + 1088 + sl * 128;
                const float x1 = c[lane], x2 = c[64 + lane];
                c[lane] = x1 * cs.x - x2 * cs.y; c[64 + lane] = x2 * cs.x + x1 * cs.y;
            }
        }
    }
}

__device__ __forceinline__ void q2_rope_naive(float* __restrict__ Q2, const float2* __restrict__ R64) {
    const int tid_ = opaque_tid(); const int wave = tid_ >> 6, lane = tid_ & 63;
    for (int row = blockIdx.x * 8 + wave; row < T; row += NBLK * 8) {
        const int t = row % S;
        const int i = lane & 31;
        const float2 cs = R64[t * 32 + i];
        for (int hh = 0; hh < 4; ++hh) {
            const int h = hh * 2 + (lane >> 5);
            float* c = Q2 + (size_t)row * 1536 + h * 192 + 128;
            const float x1 = c[i], x2 = c[32 + i];
            c[i] = x1 * cs.x - x2 * cs.y; c[32 + i] = x2 * cs.x + x1 * cs.y;
        }
    }
}

__device__ __forceinline__ void diff_combine_naive(const float* __restrict__ A12, const float* __restrict__ dl, const float* __restrict__ gs, float lam_init, bf16_t* __restrict__ O) {
    const int tid_ = opaque_tid(); const int wave = tid_ >> 6, lane = tid_ & 63;
    float s1 = dl[lane] * dl[128 + lane] + dl[64 + lane] * dl[128 + 64 + lane];
    float s2 = dl[256 + lane] * dl[384 + lane] + dl[256 + 64 + lane] * dl[384 + 64 + lane];
    s1 = wsum(s1); s2 = wsum(s2);
    const float lam = expf(s1) - expf(s2) + lam_init;
    float4 gsv = *(const float4*)(gs + lane * 4);
    gsv.x *= (1.f - lam_init); gsv.y *= (1.f - lam_init); gsv.z *= (1.f - lam_init); gsv.w *= (1.f - lam_init);
    for (int row = blockIdx.x * 8 + wave; row < T; row += NBLK * 8) {
        f32x4 a1[4], a2[4];
#pragma unroll
        for (int hd = 0; hd < 4; ++hd) {
            a1[hd] = *(const GAS f32x4*)((const GAS float*)A12 + (size_t)row * D + hd * 512 + lane * 4);
            a2[hd] = *(const GAS f32x4*)((const GAS float*)A12 + (size_t)row * D + hd * 512 + 256 + lane * 4);
        }
#pragma unroll
        for (int hd = 0; hd < 4; ++hd) {
            float d[4]; float ss = 0.f;
#pragma unroll
            for (int i = 0; i < 4; ++i) { d[i] = a1[hd][i] - lam * a2[hd][i]; ss += d[i] * d[i]; }
            const float r = rsqrtf(wsum(ss) * (1.f / 256.f) + RMS_EPS);
            *(GAS u32x2*)((GAS bf16_t*)O + (size_t)row * D + 1024 + hd * 256 + lane * 4) = u32x2{cvtpk(d[0] * r * gsv.x, d[1] * r * gsv.y), cvtpk(d[2] * r * gsv.z, d[3] * r * gsv.w)};
        }
    }
}

__device__ __forceinline__ void wargmax(float& v, int& ix) {
#define WAM_STEP(M) { const float ov = swz_xor<M>(v); const int oi = swz_xor_i<M>(ix); if (ov > v || (ov == v && oi < ix)) { v = ov; ix = oi; } }
    WAM_STEP(1) WAM_STEP(2) WAM_STEP(4) WAM_STEP(8) WAM_STEP(16)
#undef WAM_STEP
    {
        auto rv = __builtin_amdgcn_permlane32_swap(__float_as_uint(v), __float_as_uint(v), false, false);
        auto ri = __builtin_amdgcn_permlane32_swap((unsigned)ix, (unsigned)ix, false, false);
        const float v0 = __uint_as_float(rv[0]), v1 = __uint_as_float(rv[1]); const int i0 = (int)ri[0], i1 = (int)ri[1];
        if (v0 > v1 || (v0 == v1 && i0 < i1)) { v = v0; ix = i0; } else { v = v1; ix = i1; }
    }
}

__device__ __forceinline__ void route_naive(const float* __restrict__ PQ, const float* __restrict__ SK  , int* __restrict__ IDX, float* __restrict__ G, float* lds) {
    const int tid_ = opaque_tid(); const int wave = tid_ >> 6, lane = tid_ & 63;
    float* qs = lds + wave * 512;
    float* svs = qs + 256;
    int* sis = (int*)(qs + 288);
    const float NEG = -3.0e38f;
    for (int item = blockIdx.x * 8 + wave; item < T * 8; item += NBLK * 8) {
        const int tok = item >> 3, h = item & 7;
        const float* q = PQ + (size_t)tok * D + h * 256;
#pragma unroll
        for (int i = 0; i < 4; ++i) qs[i * 64 + lane] = q[i * 64 + lane];
        __syncthreads();
        for (int p = 0; p < 2; ++p) {
            const float* k0 = SK + ((size_t)(h * 2 + p) * 128 + lane) * 128;
            const float* k1 = k0 + 64 * 128;
            float v0 = 0.f, v1 = 0.f;
            for (int d = 0; d < 128; d += 4) {
                const float4 a = *(const float4*)(k0 + d), b = *(const float4*)(k1 + d);
                const float q0 = qs[p * 128 + d], q1 = qs[p * 128 + d + 1], q2 = qs[p * 128 + d + 2], q3 = qs[p * 128 + d + 3];
                v0 = fmaf(q0, a.x, v0); v0 = fmaf(q1, a.y, v0); v0 = fmaf(q2, a.z, v0); v0 = fmaf(q3, a.w, v0);
                v1 = fmaf(q0, b.x, v1); v1 = fmaf(q1, b.y, v1); v1 = fmaf(q2, b.z, v1); v1 = fmaf(q3, b.w, v1);
            }
            for (int r = 0; r < 16; ++r) {
                float bv; int bi;
                if (v0 >= v1) { bv = v0; bi = lane; } else { bv = v1; bi = lane + 64; }
                wargmax(bv, bi);
                if (bi == lane) v0 = NEG;
                if (bi == lane + 64) v1 = NEG;
                if (lane == 0) { svs[p * 16 + r] = bv; sis[p * 16 + r] = bi; }
            }
        }
        __syncthreads();
        float c[4];
#pragma unroll
        for (int j = 0; j < 4; ++j) { const int cc = lane + 64 * j; c[j] = svs[cc >> 4] + svs[16 + (cc & 15)]; }
        float myv = 0.f; int myc = 0;
        for (int r = 0; r < 16; ++r) {
            float bv = c[0]; int bi = lane;
#pragma unroll
            for (int j = 1; j < 4; ++j) if (c[j] > bv) { bv = c[j]; bi = lane + 64 * j; }
            wargmax(bv, bi);
#pragma unroll
            for (int j = 0; j < 4; ++j) if (bi == lane + 64 * j) c[j] = NEG;
            if (lane == r) { myv = bv; myc = bi; }
        }
        const float mx = __uint_as_float(__builtin_amdgcn_readfirstlane(__float_as_uint(myv)));
        const float e = (lane < 16) ? expf(myv - mx) : 0.f;
        const float sum = wsum(e);
        if (lane < 16) {
            IDX[(size_t)tok * 128 + h * 16 + lane] = sis[myc >> 4] * 128 + sis[16 + (myc & 15)];
            G[(size_t)tok * 128 + h * 16 + lane] = e / sum;
        }
        __syncthreads();
    }
}

__device__ __forceinline__ void peer_gather_naive(const float* X, const int* __restrict__ IDX, const float* __restrict__ G,
                                  const float* __restrict__ U, const float* __restrict__ Vt,
                                  const float* __restrict__ g, const float* __restrict__ bb, float* dst, bf16_t* __restrict__ xb) {
    const int tid_ = opaque_tid(); const int wave = tid_ >> 6, lane = tid_ & 63;
    for (int row = blockIdx.x * 8 + wave; row < T; row += NBLK * 8) {
        float4 x[8], acc[8];
#pragma unroll
        for (int i = 0; i < 8; ++i) { x[i] = ((const float4*)(X + (size_t)row * D))[i * 64 + lane]; acc[i] = make_float4(0.f, 0.f, 0.f, 0.f); }
#pragma unroll 1
        for (int e = 0; e < 128; ++e) {
            const int ix = IDX[(size_t)row * 128 + e];
            const float ge = G[(size_t)row * 128 + e];
            const float4* u = (const float4*)(U + (size_t)ix * D);
            float s = 0.f;
#pragma unroll
            for (int i = 0; i < 8; ++i) { const float4 uu = u[i * 64 + lane]; s += (x[i].x * uu.x + x[i].y * uu.y) + (x[i].z * uu.z + x[i].w * uu.w); }
            s = wsum(s);
            const float w = ge * gelu_tanh(s);
            const float4* v = (const float4*)(Vt + (size_t)ix * D);
#pragma unroll
            for (int i = 0; i < 8; ++i) { const float4 vv = v[i * 64 + lane]; acc[i].x = fmaf(w, vv.x, acc[i].x); acc[i].y = fmaf(w, vv.y, acc[i].y); acc[i].z = fmaf(w, vv.z, acc[i].z); acc[i].w = fmaf(w, vv.w, acc[i].w); }
        }
        float s = 0.f;
#pragma unroll
        for (int i = 0; i < 8; ++i) {
            acc[i] = make_float4(ALPHA * x[i].x + acc[i].x, ALPHA * x[i].y + acc[i].y, ALPHA * x[i].z + acc[i].z, ALPHA * x[i].w + acc[i].w);
            s += (acc[i].x + acc[i].y) + (acc[i].z + acc[i].w);
        }
        const float mu = wsum(s) * (1.f / D);
        float v = 0.f;
#pragma unroll
        for (int i = 0; i < 8; ++i) { const float a = acc[i].x - mu, b = acc[i].y - mu, c = acc[i].z - mu, d = acc[i].w - mu; v += (a * a + b * b) + (c * c + d * d); }
        const float rstd = rsqrtf(wsum(v) * (1.f / D) + LN_EPS);
#pragma unroll
        for (int i = 0; i < 8; ++i) {
            const float4 gg = ((const float4*)g)[i * 64 + lane], b4 = ((const float4*)bb)[i * 64 + lane];
            const float4 o4 = make_float4((acc[i].x - mu) * rstd * gg.x + b4.x, (acc[i].y - mu) * rstd * gg.y + b4.y,
                                          (acc[i].z - mu) * rstd * gg.z + b4.z, (acc[i].w - mu) * rstd * gg.w + b4.w);
            ((float4*)(dst + (size_t)row * D))[i * 64 + lane] = o4;
            ((uint2*)(xb + (size_t)row * D))[i * 64 + lane] = make_uint2(cvtpk(o4.x, o4.y), cvtpk(o4.z, o4.w));
        }
    }
}

__device__ __forceinline__ void peer_gather_b(const float* X, const bf16_t* __restrict__ Xbin, const int* __restrict__ IDX, const float* __restrict__ G,
                                              const bf16_t* __restrict__ Ub, const bf16_t* __restrict__ Vb,
                                              const float* __restrict__ g, const float* __restrict__ bb, float* dst, bf16_t* xbout) {
    const int tid_ = opaque_tid(); const int wave = tid_ >> 6, lane = tid_ & 63;
    const GAS unsigned char* Ug = (const GAS unsigned char*)Ub; const GAS unsigned char* Vg = (const GAS unsigned char*)Vb;
    for (int row = blockIdx.x * 8 + wave; row < T; row += NBLK * 8) {
        u32x4 xb[4];
#pragma unroll
        for (int i = 0; i < 4; ++i) xb[i] = *(const GAS u32x4*)((const GAS bf16_t*)Xbin + (size_t)row * D + i * 512 + lane * 8);
        float acc[32];
#pragma unroll
        for (int k = 0; k < 32; ++k) acc[k] = 0.f;
#pragma unroll 1
        for (int bt = 0; bt < 8; ++bt) {
            const int idxv = IDX[(size_t)row * 128 + bt * 16 + (lane & 15)];
            const float gv = G[(size_t)row * 128 + bt * 16 + (lane & 15)];
            float part[16];
#pragma unroll
            for (int e = 0; e < 16; ++e) {
                const int ix = __builtin_amdgcn_readlane(idxv, e);
                const GAS unsigned char* up = Ug + (size_t)ix * (D * 2) + lane * 16;
                const u32x4 u0 = *(const GAS u32x4*)(up), u1 = *(const GAS u32x4*)(up + 1024), u2 = *(const GAS u32x4*)(up + 2048), u3 = *(const GAS u32x4*)(up + 3072);
                float a0 = 0.f, a1 = 0.f, a2 = 0.f, a3 = 0.f;
                a0 = dot2bf(u0[0], xb[0][0], a0); a1 = dot2bf(u0[1], xb[0][1], a1); a2 = dot2bf(u0[2], xb[0][2], a2); a3 = dot2bf(u0[3], xb[0][3], a3);
                a0 = dot2bf(u1[0], xb[1][0], a0); a1 = dot2bf(u1[1], xb[1][1], a1); a2 = dot2bf(u1[2], xb[1][2], a2); a3 = dot2bf(u1[3], xb[1][3], a3);
                a0 = dot2bf(u2[0], xb[2][0], a0); a1 = dot2bf(u2[1], xb[2][1], a1); a2 = dot2bf(u2[2], xb[2][2], a2); a3 = dot2bf(u2[3], xb[2][3], a3);
                a0 = dot2bf(u3[0], xb[3][0], a0); a1 = dot2bf(u3[1], xb[3][1], a1); a2 = dot2bf(u3[2], xb[3][2], a2); a3 = dot2bf(u3[3], xb[3][3], a3);
                part[e] = (a0 + a1) + (a2 + a3);
            }
            float r8[8], r4[4], r2[2], h;
            { const bool hb = (lane & 8) != 0;
#pragma unroll
              for (int k = 0; k < 8; ++k) { const float keep = hb ? part[8 + k] : part[k], send = hb ? part[k] : part[8 + k]; r8[k] = keep + swz_xor<8>(send); } }
            { const bool hb = (lane & 4) != 0;
#pragma unroll
              for (int k = 0; k < 4; ++k) { const float keep = hb ? r8[4 + k] : r8[k], send = hb ? r8[k] : r8[4 + k]; r4[k] = keep + swz_xor<4>(send); } }
            { const bool hb = (lane & 2) != 0;
#pragma unroll
              for (int k = 0; k < 2; ++k) { const float keep = hb ? r4[2 + k] : r4[k], send = hb ? r4[k] : r4[2 + k]; r2[k] = keep + swz_xor<2>(send); } }
            { const bool hb = (lane & 1) != 0; const float keep = hb ? r2[1] : r2[0], send = hb ? r2[0] : r2[1]; h = keep + swz_xor<1>(send); }
            h += swz_xor<16>(h);
            { auto rr = __builtin_amdgcn_permlane32_swap(__float_as_uint(h), __float_as_uint(h), false, false); h = __uint_as_float(rr[0]) + __uint_as_float(rr[1]); }
            const float w = gv * gelu_tanh(h);
            const unsigned wb = cvtpk(w, 0.f);
#pragma unroll
            for (int e = 0; e < 16; ++e) {
                const int ix = __builtin_amdgcn_readlane(idxv, e);
                const unsigned wlo = (unsigned)__builtin_amdgcn_readlane((int)wb, e), whi = wlo << 16;
                const GAS unsigned char* vp = Vg + (size_t)ix * (D * 2) + lane * 16;
                const u32x4 v0 = *(const GAS u32x4*)(vp), v1 = *(const GAS u32x4*)(vp + 1024), v2 = *(const GAS u32x4*)(vp + 2048), v3 = *(const GAS u32x4*)(vp + 3072);
#pragma unroll
                for (int k = 0; k < 4; ++k) {
                    acc[2 * k] = dot2bf(v0[k], wlo, acc[2 * k]);           acc[2 * k + 1] = dot2bf(v0[k], whi, acc[2 * k + 1]);
                    acc[8 + 2 * k] = dot2bf(v1[k], wlo, acc[8 + 2 * k]);   acc[8 + 2 * k + 1] = dot2bf(v1[k], whi, acc[8 + 2 * k + 1]);
                    acc[16 + 2 * k] = dot2bf(v2[k], wlo, acc[16 + 2 * k]); acc[16 + 2 * k + 1] = dot2bf(v2[k], whi, acc[16 + 2 * k + 1]);
                    acc[24 + 2 * k] = dot2bf(v3[k], wlo, acc[24 + 2 * k]); acc[24 + 2 * k + 1] = dot2bf(v3[k], whi, acc[24 + 2 * k + 1]);
                }
            }
        }
        float s1 = 0.f;
#pragma unroll
        for (int i = 0; i < 4; ++i) {
            const f32x4 xa = *(const GAS f32x4*)((const GAS float*)X + (size_t)row * D + i * 512 + lane * 8), xc = *(const GAS f32x4*)((const GAS float*)X + (size_t)row * D + i * 512 + lane * 8 + 4);
#pragma unroll
            for (int k = 0; k < 4; ++k) { acc[8 * i + k] = fmaf(ALPHA, xa[k], acc[8 * i + k]); acc[8 * i + 4 + k] = fmaf(ALPHA, xc[k], acc[8 * i + 4 + k]); }
        }
#pragma unroll
        for (int k = 0; k < 32; ++k) s1 += acc[k];
        const float mu = wsum(s1) * (1.f / D);
        float s2 = 0.f;
#pragma unroll
        for (int k = 0; k < 32; ++k) { const float d_ = acc[k] - mu; s2 = fmaf(d_, d_, s2); }
        const float rstd = rsqrtf(wsum(s2) * (1.f / D) + LN_EPS);
        const float* gl_ = g; const float* bl_ = bb;
        asm volatile("" : "+s"(gl_), "+s"(bl_));
#pragma unroll
        for (int i = 0; i < 4; ++i) {
            const int col = i * 512 + lane * 8;
            const f32x4 g0 = *(const GAS f32x4*)((const GAS float*)gl_ + col), g1 = *(const GAS f32x4*)((const GAS float*)gl_ + col + 4);
            const f32x4 b0 = *(const GAS f32x4*)((const GAS float*)bl_ + col), b1 = *(const GAS f32x4*)((const GAS float*)bl_ + col + 4);
            f32x4 o0, o1;
#pragma unroll
            for (int k = 0; k < 4; ++k) { o0[k] = (acc[8 * i + k] - mu) * rstd * g0[k] + b0[k]; o1[k] = (acc[8 * i + 4 + k] - mu) * rstd * g1[k] + b1[k]; }
            *(GAS f32x4*)((GAS float*)dst + (size_t)row * D + col) = o0; *(GAS f32x4*)((GAS float*)dst + (size_t)row * D + col + 4) = o1;
            *(GAS u32x4*)((GAS bf16_t*)xbout + (size_t)row * D + col) = u32x4{cvtpk(o0[0], o0[1]), cvtpk(o0[2], o0[3]), cvtpk(o1[0], o1[1]), cvtpk(o1[2], o1[3])};
        }
    }
}

typedef float f32x2 __attribute__((ext_vector_type(2)));
__device__ __forceinline__ void convert_rows_fp8(const float* __restrict__ src, unsigned char* __restrict__ dst, float* __restrict__ scale, int nrows) {
    const int tid_ = opaque_tid(); const int wave = tid_ >> 6, lane = tid_ & 63;
    for (int row = blockIdx.x * 8 + wave; row < nrows; row += NBLK * 8) {
        f32x4 v[8]; float m = 0.f;
#pragma unroll
        for (int i = 0; i < 2; ++i)
#pragma unroll
            for (int q = 0; q < 4; ++q) {
                v[4 * i + q] = *(const GAS f32x4*)((const GAS float*)src + (size_t)row * D + i * 1024 + 256 * q + lane * 4);
#pragma unroll
                for (int k = 0; k < 4; ++k) m = fmaxf(m, fabsf(v[4 * i + q][k]));
            }
        m = wmaxf(m);
        int E = (int)((__float_as_uint(m) >> 23) & 0xffu) - 127;
        if (E < -100) E = -100;
        const float inv_s = __uint_as_float((unsigned)(127 + 7 - E) << 23), sc = __uint_as_float((unsigned)(127 + E - 7) << 23);
#pragma unroll
        for (int i = 0; i < 2; ++i) {
            unsigned w[4];
#pragma unroll
            for (int q = 0; q < 4; ++q) {
                int pk = __builtin_amdgcn_cvt_pk_fp8_f32(v[4 * i + q][0] * inv_s, v[4 * i + q][1] * inv_s, 0, false);
                pk = __builtin_amdgcn_cvt_pk_fp8_f32(v[4 * i + q][2] * inv_s, v[4 * i + q][3] * inv_s, pk, true);
                w[q] = (unsigned)pk;
            }
            *(GAS u32x4*)((GAS unsigned char*)dst + (size_t)row * D + i * 1024 + lane * 16) = u32x4{w[0], w[1], w[2], w[3]};
        }
        if (lane == 0) scale[row] = sc;
    }
}
#define F8_CVT_LO(dst, src) asm volatile("v_cvt_pk_f32_fp8_e32 %0, %1" : "=v"(dst) : "v"(src))
#define F8_CVT_HI(dst, src) asm volatile("v_cvt_pk_f32_fp8_sdwa %0, %1 src0_sel:WORD_1" : "=v"(dst) : "v"(src))
#define F8_PKFMA(acc, a, b) asm volatile("v_pk_fma_f32 %0, %1, %2, %0" : "+v"(acc) : "v"(a), "v"(b))
#define F8_PKFMA_S(acc, w, b) asm volatile("v_pk_fma_f32 %0, %1, %2, %0" : "+v"(acc) : "s"(w), "v"(b))
__device__ __forceinline__ void peer_gather_f8(const float* X, const int* __restrict__ IDX, const float* __restrict__ G,
                                               const unsigned char* __restrict__ U8, const unsigned char* __restrict__ V8,
                                               const float* __restrict__ SU, const float* __restrict__ SV,
                                               const float* __restrict__ g, const float* __restrict__ bb, float* dst, bf16_t* xbout) {
    const int tid_ = opaque_tid(); const int wave = tid_ >> 6;
    const GAS unsigned char* Ug = (const GAS unsigned char*)U8; const GAS unsigned char* Vg = (const GAS unsigned char*)V8;
    for (int row = blockIdx.x * 8 + wave; row < T; row += NBLK * 8) {
        int lane = tid_ & 63; asm volatile("" : "+v"(lane));
        f32x2 xr[16], acc[16];
#pragma unroll
        for (int i = 0; i < 2; ++i)
#pragma unroll
            for (int q = 0; q < 4; ++q) {
                const f32x4 t4 = *(const GAS f32x4*)((const GAS float*)X + (size_t)row * D + i * 1024 + 256 * q + lane * 4);
                xr[8 * i + 2 * q] = f32x2{t4[0], t4[1]}; xr[8 * i + 2 * q + 1] = f32x2{t4[2], t4[3]};
            }
#pragma unroll
        for (int k = 0; k < 16; ++k) acc[k] = f32x2{0.f, 0.f};
        int k0 = (IDX[(size_t)row * 128 + lane] << 7) | lane, k1 = (IDX[(size_t)row * 128 + 64 + lane] << 7) | (64 + lane);
#define GS_STEP(SIZE, STRIDE) do { const int p0_ = swz_xor_i<STRIDE>(k0), p1_ = swz_xor_i<STRIDE>(k1); const bool lo_ = (lane & STRIDE) == 0; \
            const bool up0_ = (SIZE == 128) ? true : ((SIZE == 64) ? true : ((lane & SIZE) == 0)), up1_ = (SIZE == 128) ? true : ((SIZE == 64) ? false : ((lane & SIZE) == 0)); \
            k0 = (up0_ == lo_) ? imin(k0, p0_) : imax(k0, p0_); k1 = (up1_ == lo_) ? imin(k1, p1_) : imax(k1, p1_); } while (0)
#define GS_STEP32(SIZE) do { auto r0_ = __builtin_amdgcn_permlane32_swap((unsigned)k0, (unsigned)k0, false, false); auto r1_ = __builtin_amdgcn_permlane32_swap((unsigned)k1, (unsigned)k1, false, false); \
            const bool lo_ = (lane & 32) == 0; const int p0_ = lo_ ? (int)r0_[1] : (int)r0_[0], p1_ = lo_ ? (int)r1_[1] : (int)r1_[0]; \
            const bool up0_ = true, up1_ = (SIZE == 128); \
            k0 = (up0_ == lo_) ? imin(k0, p0_) : imax(k0, p0_); k1 = (up1_ == lo_) ? imin(k1, p1_) : imax(k1, p1_); } while (0)
        GS_STEP(2, 1);
        GS_STEP(4, 2); GS_STEP(4, 1);
        GS_STEP(8, 4); GS_STEP(8, 2); GS_STEP(8, 1);
        GS_STEP(16, 8); GS_STEP(16, 4); GS_STEP(16, 2); GS_STEP(16, 1);
        GS_STEP(32, 16); GS_STEP(32, 8); GS_STEP(32, 4); GS_STEP(32, 2); GS_STEP(32, 1);
        GS_STEP32(64); GS_STEP(64, 16); GS_STEP(64, 8); GS_STEP(64, 4); GS_STEP(64, 2); GS_STEP(64, 1);
        { const int a_ = imin(k0, k1), b_ = imax(k0, k1); k0 = a_; k1 = b_; }
        GS_STEP32(128); GS_STEP(128, 16); GS_STEP(128, 8); GS_STEP(128, 4); GS_STEP(128, 2); GS_STEP(128, 1);
#undef GS_STEP
#undef GS_STEP32
#pragma unroll 1
        for (int bt = 0; bt < 8; ++bt) {
            const int ksel = (bt & 4) ? k1 : k0;
            const int key = __builtin_amdgcn_ds_bpermute(4 * (16 * (bt & 3) + (lane & 15)), ksel);
            const int idxv = key >> 7;
            const float gv = G[(size_t)row * 128 + (key & 127)];
            const float suv = SU[idxv], svv = SV[idxv];
            float part[16];
            u32x4 ra[8], rb[8];
#define F8_LOADG(buf, base, gq) do { _Pragma("unroll") for (int e_ = 0; e_ < 4; ++e_) { \
                const int ix_ = __builtin_amdgcn_readlane(idxv, 4 * (gq) + e_); const GAS unsigned char* p_ = (base) + (size_t)ix_ * D + lane * 16; \
                buf[2 * e_] = *(const GAS u32x4*)(p_); buf[2 * e_ + 1] = *(const GAS u32x4*)(p_ + 1024); } } while (0)
#define F8_DOTG(buf, gq) do { _Pragma("unroll") for (int e_ = 0; e_ < 4; ++e_) { \
                f32x2 s0_ = f32x2{0.f, 0.f}, s1_ = f32x2{0.f, 0.f}; \
                _Pragma("unroll") for (int i_ = 0; i_ < 2; ++i_) { \
                    f32x2 c0_, c1_, c2_, c3_, c4_, c5_, c6_, c7_; const u32x4 w_ = buf[2 * e_ + i_]; \
                    F8_CVT_LO(c0_, w_[0]); F8_CVT_HI(c1_, w_[0]); F8_CVT_LO(c2_, w_[1]); F8_CVT_HI(c3_, w_[1]); \
                    F8_CVT_LO(c4_, w_[2]); F8_CVT_HI(c5_, w_[2]); F8_CVT_LO(c6_, w_[3]); F8_CVT_HI(c7_, w_[3]); \
                    F8_PKFMA(s0_, c0_, xr[8 * i_ + 0]); F8_PKFMA(s1_, c1_, xr[8 * i_ + 1]); F8_PKFMA(s0_, c2_, xr[8 * i_ + 2]); F8_PKFMA(s1_, c3_, xr[8 * i_ + 3]); \
                    F8_PKFMA(s0_, c4_, xr[8 * i_ + 4]); F8_PKFMA(s1_, c5_, xr[8 * i_ + 5]); F8_PKFMA(s0_, c6_, xr[8 * i_ + 6]); F8_PKFMA(s1_, c7_, xr[8 * i_ + 7]); } \
                part[4 * (gq) + e_] = (s0_[0] + s0_[1]) + (s1_[0] + s1_[1]); } } while (0)
#define F8_ACCG(buf, gq) do { _Pragma("unroll") for (int e_ = 0; e_ < 4; ++e_) { \
                const unsigned wu_ = (unsigned)__builtin_amdgcn_readlane((int)__float_as_uint(w), 4 * (gq) + e_); \
                const unsigned long long wp_ = ((unsigned long long)wu_ << 32) | wu_; \
                _Pragma("unroll") for (int i_ = 0; i_ < 2; ++i_) { \
                    f32x2 c0_, c1_, c2_, c3_, c4_, c5_, c6_, c7_; const u32x4 w_ = buf[2 * e_ + i_]; \
                    F8_CVT_LO(c0_, w_[0]); F8_CVT_HI(c1_, w_[0]); F8_CVT_LO(c2_, w_[1]); F8_CVT_HI(c3_, w_[1]); \
                    F8_CVT_LO(c4_, w_[2]); F8_CVT_HI(c5_, w_[2]); F8_CVT_LO(c6_, w_[3]); F8_CVT_HI(c7_, w_[3]); \
                    F8_PKFMA_S(acc[8 * i_ + 0], wp_, c0_); F8_PKFMA_S(acc[8 * i_ + 1], wp_, c1_); F8_PKFMA_S(acc[8 * i_ + 2], wp_, c2_); F8_PKFMA_S(acc[8 * i_ + 3], wp_, c3_); \
                    F8_PKFMA_S(acc[8 * i_ + 4], wp_, c4_); F8_PKFMA_S(acc[8 * i_ + 5], wp_, c5_); F8_PKFMA_S(acc[8 * i_ + 6], wp_, c6_); F8_PKFMA_S(acc[8 * i_ + 7], wp_, c7_); } } } while (0)
            F8_LOADG(ra, Ug, 0);
            F8_LOADG(rb, Ug, 1); F8_DOTG(ra, 0);
            F8_LOADG(ra, Ug, 2); F8_DOTG(rb, 1);
            F8_LOADG(rb, Ug, 3); F8_DOTG(ra, 2);
            F8_LOADG(ra, Vg, 0); F8_DOTG(rb, 3);
            float r8[8], r4[4], r2[2], h;
            { const bool hb = (lane & 8) != 0;
#pragma unroll
              for (int k = 0; k < 8; ++k) { const float keep = hb ? part[8 + k] : part[k], send = hb ? part[k] : part[8 + k]; r8[k] = keep + swz_xor<8>(send); } }
            { const bool hb = (lane & 4) != 0;
#pragma unroll
              for (int k = 0; k < 4; ++k) { const float keep = hb ? r8[4 + k] : r8[k], send = hb ? r8[k] : r8[4 + k]; r4[k] = keep + swz_xor<4>(send); } }
            { const bool hb = (lane & 2) != 0;
#pragma unroll
              for (int k = 0; k < 2; ++k) { const float keep = hb ? r4[2 + k] : r4[k], send = hb ? r4[k] : r4[2 + k]; r2[k] = keep + swz_xor<2>(send); } }
            { const bool hb = (lane & 1) != 0; const float keep = hb ? r2[1] : r2[0], send = hb ? r2[0] : r2[1]; h = keep + swz_xor<1>(send); }
            h += swz_xor<16>(h);
            { auto rr = __builtin_amdgcn_permlane32_swap(__float_as_uint(h), __float_as_uint(h), false, false); h = __uint_as_float(rr[0]) + __uint_as_float(rr[1]); }
            const float w = gv * gelu_tanh(h * suv) * svv;
            F8_LOADG(rb, Vg, 1); F8_ACCG(ra, 0);
            F8_LOADG(ra, Vg, 2); F8_ACCG(rb, 1);
            F8_LOADG(rb, Vg, 3); F8_ACCG(ra, 2);
            F8_ACCG(rb, 3);
#undef F8_LOADG
#undef F8_DOTG
#undef F8_ACCG
        }
        asm volatile("" : "+v"(lane));
        float s1 = 0.f;
#pragma unroll
        for (int k = 0; k < 16; ++k) { acc[k][0] = fmaf(ALPHA, xr[k][0], acc[k][0]); acc[k][1] = fmaf(ALPHA, xr[k][1], acc[k][1]); s1 += acc[k][0] + acc[k][1]; }
        const float mu = wsum(s1) * (1.f / D);
        float s2 = 0.f;
#pragma unroll
        for (int k = 0; k < 16; ++k) { const float d0 = acc[k][0] - mu, d1 = acc[k][1] - mu; s2 = fmaf(d0, d0, s2); s2 = fmaf(d1, d1, s2); }
        const float rstd = rsqrtf(wsum(s2) * (1.f / D) + LN_EPS);
        const float* gl_ = g; const float* bl_ = bb;
        asm volatile("" : "+s"(gl_), "+s"(bl_));
#pragma unroll
        for (int i = 0; i < 2; ++i) {
#pragma unroll
            for (int q = 0; q < 4; ++q) {
                const int col = i * 1024 + 256 * q + lane * 4;
                const f32x4 g4 = *(const GAS f32x4*)((const GAS float*)gl_ + col), b4 = *(const GAS f32x4*)((const GAS float*)bl_ + col);
                f32x4 o4;
                o4[0] = (acc[8 * i + 2 * q][0] - mu) * rstd * g4[0] + b4[0]; o4[1] = (acc[8 * i + 2 * q][1] - mu) * rstd * g4[1] + b4[1];
                o4[2] = (acc[8 * i + 2 * q + 1][0] - mu) * rstd * g4[2] + b4[2]; o4[3] = (acc[8 * i + 2 * q + 1][1] - mu) * rstd * g4[3] + b4[3];
                *(GAS f32x4*)((GAS float*)dst + (size_t)row * D + col) = o4;
                *(GAS u32x2*)((GAS bf16_t*)xbout + (size_t)row * D + col) = u32x2{cvtpk(o4[0], o4[1]), cvtpk(o4[2], o4[3])};
            }
        }
    }
}

typedef unsigned u32x6 __attribute__((ext_vector_type(6)));
typedef float f32x32 __attribute__((ext_vector_type(32)));
constexpr int F6_ROW = 1536;
__device__ __forceinline__ void convert_rows_fp6(const float* __restrict__ src, unsigned char* __restrict__ dst, float* __restrict__ scale, int nrows) {
    const int tid_ = opaque_tid(); const int wave = __builtin_amdgcn_readfirstlane(tid_ >> 6), lane = tid_ & 63;
    for (int row = blockIdx.x * 8 + wave; row < nrows; row += NBLK * 8) {
        f32x4 v[8]; float m = 0.f;
#pragma unroll
        for (int i = 0; i < 2; ++i)
#pragma unroll
            for (int q = 0; q < 4; ++q) {
                v[4 * i + q] = *(const GAS f32x4*)((const GAS float*)src + (size_t)row * D + i * 1024 + 256 * q + lane * 4);
#pragma unroll
                for (int k = 0; k < 4; ++k) m = fmaxf(m, fabsf(v[4 * i + q][k]));
            }
        m = wmaxf(m);
        int E = (int)((__float_as_uint(m) >> 23) & 0xffu) - 127;
        if (E < -100) E = -100;
        const float inv_s = __uint_as_float((unsigned)(127 + 2 - E) << 23), sc = __uint_as_float((unsigned)(127 + E - 2) << 23);
        unsigned long long W0 = 0ull, W1 = 0ull, W2 = 0ull;
#pragma unroll
        for (int e = 0; e < 32; ++e) {
            const float xv = v[e >> 2][e & 3] * inv_s, a = fabsf(xv);
            float cf;
            if (a < 1.f) cf = a * 8.f; else if (a < 2.f) cf = 8.f + (a - 1.f) * 8.f; else if (a < 4.f) cf = 16.f + (a - 2.f) * 4.f; else cf = 24.f + (a - 4.f) * 2.f;
            unsigned code = (unsigned)__float2int_rn(cf); if (code > 31u) code = 31u;
            code |= (xv < 0.f) ? 32u : 0u;
            const int bp = 6 * e, wi = bp >> 6, sh = bp & 63;
            const unsigned long long c64 = (unsigned long long)code;
            if (wi == 0) W0 |= c64 << sh; else if (wi == 1) W1 |= c64 << sh; else W2 |= c64 << sh;
            if (sh > 58) { if (wi == 0) W1 |= c64 >> (64 - sh); else if (wi == 1) W2 |= c64 >> (64 - sh); }
        }
        const u32x6 w = u32x6{(unsigned)W0, (unsigned)(W0 >> 32), (unsigned)W1, (unsigned)(W1 >> 32), (unsigned)W2, (unsigned)(W2 >> 32)};
        *(GAS u32x4*)((GAS unsigned char*)dst + (size_t)row * F6_ROW + lane * 16) = u32x4{w[0], w[1], w[2], w[3]};
        *(GAS u32x2*)((GAS unsigned char*)dst + (size_t)row * F6_ROW + 1024 + lane * 8) = u32x2{w[4], w[5]};
        if (lane == 0) scale[row] = sc;
    }
}
#define F6_CVT(dst, src) asm volatile("v_cvt_scalef32_pk32_f32_fp6 %0, %1, 1.0" : "=&v"(dst) : "v"(src))
__device__ __forceinline__ void peer_gather_f6(const float* X, const int* __restrict__ IDX, const float* __restrict__ G,
                                               const unsigned char* __restrict__ U6, const unsigned char* __restrict__ V6,
                                               const float* __restrict__ SU, const float* __restrict__ SV,
                                               const float* __restrict__ g, const float* __restrict__ bb, float* dst, bf16_t* xbout) {
    const int tid_ = opaque_tid(); const int wave = __builtin_amdgcn_readfirstlane(tid_ >> 6);
    const GAS unsigned char* Ug = (const GAS unsigned char*)U6; const GAS unsigned char* Vg = (const GAS unsigned char*)V6;
    for (int row = blockIdx.x * 8 + wave; row < T; row += NBLK * 8) {
        int lane = tid_ & 63; asm volatile("" : "+v"(lane));
        f32x2 xr[16], acc[16];
#pragma unroll
        for (int i = 0; i < 2; ++i)
#pragma unroll
            for (int q = 0; q < 4; ++q) {
                const f32x4 t4 = *(const GAS f32x4*)((const GAS float*)X + (size_t)row * D + i * 1024 + 256 * q + lane * 4);
                xr[8 * i + 2 * q] = f32x2{t4[0], t4[1]}; xr[8 * i + 2 * q + 1] = f32x2{t4[2], t4[3]};
            }
#pragma unroll
        for (int k = 0; k < 16; ++k) acc[k] = f32x2{0.f, 0.f};
        int k0 = (IDX[(size_t)row * 128 + lane] << 7) | lane, k1 = (IDX[(size_t)row * 128 + 64 + lane] << 7) | (64 + lane);
#define GS_STEP(SIZE, STRIDE) do { const int p0_ = swz_xor_i<STRIDE>(k0), p1_ = swz_xor_i<STRIDE>(k1); const bool lo_ = (lane & STRIDE) == 0; \
            const bool up0_ = (SIZE == 128) ? true : ((SIZE == 64) ? true : ((lane & SIZE) == 0)), up1_ = (SIZE == 128) ? true : ((SIZE == 64) ? false : ((lane & SIZE) == 0)); \
            k0 = (up0_ == lo_) ? imin(k0, p0_) : imax(k0, p0_); k1 = (up1_ == lo_) ? imin(k1, p1_) : imax(k1, p1_); } while (0)
#define GS_STEP32(SIZE) do { auto r0_ = __builtin_amdgcn_permlane32_swap((unsigned)k0, (unsigned)k0, false, false); auto r1_ = __builtin_amdgcn_permlane32_swap((unsigned)k1, (unsigned)k1, false, false); \
            const bool lo_ = (lane & 32) == 0; const int p0_ = lo_ ? (int)r0_[1] : (int)r0_[0], p1_ = lo_ ? (int)r1_[1] : (int)r1_[0]; \
            const bool up0_ = true, up1_ = (SIZE == 128); \
            k0 = (up0_ == lo_) ? imin(k0, p0_) : imax(k0, p0_); k1 = (up1_ == lo_) ? imin(k1, p1_) : imax(k1, p1_); } while (0)
        GS_STEP(2, 1);
        GS_STEP(4, 2); GS_STEP(4, 1);
        GS_STEP(8, 4); GS_STEP(8, 2); GS_STEP(8, 1);
        GS_STEP(16, 8); GS_STEP(16, 4); GS_STEP(16, 2); GS_STEP(16, 1);
        GS_STEP(32, 16); GS_STEP(32, 8); GS_STEP(32, 4); GS_STEP(32, 2); GS_STEP(32, 1);
        GS_STEP32(64); GS_STEP(64, 16); GS_STEP(64, 8); GS_STEP(64, 4); GS_STEP(64, 2); GS_STEP(64, 1);
        { const int a_ = imin(k0, k1), b_ = imax(k0, k1); k0 = a_; k1 = b_; }
        GS_STEP32(128); GS_STEP(128, 16); GS_STEP(128, 8); GS_STEP(128, 4); GS_STEP(128, 2); GS_STEP(128, 1);
#undef GS_STEP
#undef GS_STEP32
#pragma unroll 1
        for (int bt = 0; bt < 8; ++bt) {
            const int ksel = (bt & 4) ? k1 : k0;
            const int key = __builtin_amdgcn_ds_bpermute(4 * (16 * (bt & 3) + (lane & 15)), ksel);
            const int idxv = key >> 7;
            const float gv = G[(size_t)row * 128 + (key & 127)];
            const float suv = SU[idxv], svv = SV[idxv];
            float part[16];
            u32x6 ra[4], rb[4];
#define F6_LOADG(buf, base, gq) do { _Pragma("unroll") for (int e_ = 0; e_ < 4; ++e_) { \
                const int ix_ = __builtin_amdgcn_readlane(idxv, 4 * (gq) + e_); const GAS unsigned char* p_ = (base) + (size_t)ix_ * F6_ROW; \
                const u32x4 a_ = *(const GAS u32x4*)(p_ + lane * 16); const u32x2 b_ = *(const GAS u32x2*)(p_ + 1024 + lane * 8); \
                buf[e_] = u32x6{a_[0], a_[1], a_[2], a_[3], b_[0], b_[1]}; } } while (0)
#define F6_DOTG(buf, gq) do { _Pragma("unroll") for (int e_ = 0; e_ < 4; ++e_) { \
                f32x32 c_; F6_CVT(c_, buf[e_]); f32x2 s0_ = f32x2{0.f, 0.f}, s1_ = f32x2{0.f, 0.f}; \
                _Pragma("unroll") for (int k_ = 0; k_ < 16; k_ += 2) { \
                    const f32x2 ca_ = f32x2{c_[2 * k_], c_[2 * k_ + 1]}, cb_ = f32x2{c_[2 * k_ + 2], c_[2 * k_ + 3]}; \
                    F8_PKFMA(s0_, ca_, xr[k_]); F8_PKFMA(s1_, cb_, xr[k_ + 1]); } \
                part[4 * (gq) + e_] = (s0_[0] + s0_[1]) + (s1_[0] + s1_[1]); } } while (0)
#define F6_ACCG(buf, gq) do { _Pragma("unroll") for (int e_ = 0; e_ < 4; ++e_) { \
                const unsigned wu_ = (unsigned)__builtin_amdgcn_readlane((int)__float_as_uint(w), 4 * (gq) + e_); \
                const unsigned long long wp_ = ((unsigned long long)wu_ << 32) | wu_; \
                f32x32 c_; F6_CVT(c_, buf[e_]); \
                _Pragma("unroll") for (int k_ = 0; k_ < 16; ++k_) { const f32x2 ca_ = f32x2{c_[2 * k_], c_[2 * k_ + 1]}; F8_PKFMA_S(acc[k_], wp_, ca_); } } } while (0)
            F6_LOADG(ra, Ug, 0);
            F6_LOADG(rb, Ug, 1); F6_DOTG(ra, 0);
            F6_LOADG(ra, Ug, 2); F6_DOTG(rb, 1);
            F6_LOADG(rb, Ug, 3); F6_DOTG(ra, 2);
            F6_LOADG(ra, Vg, 0); F6_DOTG(rb, 3);
            float r8[8], r4[4], r2[2], h;
            { const bool hb = (lane & 8) != 0;
#pragma unroll
              for (int k = 0; k < 8; ++k) { const float keep = hb ? part[8 + k] : part[k], send = hb ? part[k] : part[8 + k]; r8[k] = keep + swz_xor<8>(send); } }
            { const bool hb = (lane & 4) != 0;
#pragma unroll
              for (int k = 0; k < 4; ++k) { const float keep = hb ? r8[4 + k] : r8[k], send = hb ? r8[k] : r8[4 + k]; r4[k] = keep + swz_xor<4>(send); } }
            { const bool hb = (lane & 2) != 0;
#pragma unroll
              for (int k = 0; k < 2; ++k) { const float keep = hb ? r4[2 + k] : r4[k], send = hb ? r4[k] : r4[2 + k]; r2[k] = keep + swz_xor<2>(send); } }
            { const bool hb = (lane & 1) != 0; const float keep = hb ? r2[1] : r2[0], send = hb ? r2[0] : r2[1]; h = keep + swz_xor<1>(send); }
            h += swz_xor<16>(h);
            { auto rr = __builtin_amdgcn_permlane32_swap(__float_as_uint(h), __float_as_uint(h), false, false); h = __uint_as_float(rr[0]) + __uint_as_float(rr[1]); }
            const float w = gv * gelu_tanh(h * suv) * svv;
            F6_LOADG(rb, Vg, 1); F6_ACCG(ra, 0);
            F6_LOADG(ra, Vg, 2); F6_ACCG(rb, 1);
            F6_LOADG(rb, Vg, 3); F6_ACCG(ra, 2);
            F6_ACCG(rb, 3);
#undef F6_LOADG
#undef F6_DOTG
#undef F6_ACCG
        }
        asm volatile("" : "+v"(lane));
        float s1 = 0.f;
#pragma unroll
        for (int k = 0; k < 16; ++k) { acc[k][0] = fmaf(ALPHA, xr[k][0], acc[k][0]); acc[k][1] = fmaf(ALPHA, xr[k][1], acc[k][1]); s1 += acc[k][0] + acc[k][1]; }
        const float mu = wsum(s1) * (1.f / D);
        float s2 = 0.f;
#pragma unroll
        for (int k = 0; k < 16; ++k) { const float d0 = acc[k][0] - mu, d1 = acc[k][1] - mu; s2 = fmaf(d0, d0, s2); s2 = fmaf(d1, d1, s2); }
        const float rstd = rsqrtf(wsum(s2) * (1.f / D) + LN_EPS);
        const float* gl_ = g; const float* bl_ = bb;
        asm volatile("" : "+s"(gl_), "+s"(bl_));
#pragma unroll
        for (int i = 0; i < 2; ++i) {
#pragma unroll
            for (int q = 0; q < 4; ++q) {
                const int col = i * 1024 + 256 * q + lane * 4;
                const f32x4 g4 = *(const GAS f32x4*)((const GAS float*)gl_ + col), b4 = *(const GAS f32x4*)((const GAS float*)bl_ + col);
                f32x4 o4;
                o4[0] = (acc[8 * i + 2 * q][0] - mu) * rstd * g4[0] + b4[0]; o4[1] = (acc[8 * i + 2 * q][1] - mu) * rstd * g4[1] + b4[1];
                o4[2] = (acc[8 * i + 2 * q + 1][0] - mu) * rstd * g4[2] + b4[2]; o4[3] = (acc[8 * i + 2 * q + 1][1] - mu) * rstd * g4[3] + b4[3];
                *(GAS f32x4*)((GAS float*)dst + (size_t)row * D + col) = o4;
                *(GAS u32x2*)((GAS bf16_t*)xbout + (size_t)row * D + col) = u32x2{cvtpk(o4[0], o4[1]), cvtpk(o4[2], o4[3])};
            }
        }
    }
}

constexpr int F4_ROW = 1024;
constexpr float F4_CLIP = 0.8f;
__device__ __forceinline__ void convert_rows_fp4(const float* __restrict__ src, unsigned char* __restrict__ dst, float* __restrict__ scale, int nrows) {
    const int tid_ = opaque_tid(); const int wave = __builtin_amdgcn_readfirstlane(tid_ >> 6), lane = tid_ & 63;
    f32x4 v[8], vn[8];
    {
        const int row = blockIdx.x * 8 + wave;
#pragma unroll
        for (int j = 0; j < 8; ++j) vn[j] = __builtin_nontemporal_load((const GAS f32x4*)((const GAS float*)src + (size_t)row * D + 256 * j + lane * 4));
    }
    for (int row = blockIdx.x * 8 + wave; row < nrows; row += NBLK * 8) {
        float m = 0.f;
        const int rown = (row + NBLK * 8 < nrows) ? row + NBLK * 8 : row;
#pragma unroll
        for (int j = 0; j < 8; ++j) {
            v[j] = vn[j];
            vn[j] = __builtin_nontemporal_load((const GAS f32x4*)((const GAS float*)src + (size_t)rown * D + 256 * j + lane * 4));
#pragma unroll
            for (int k = 0; k < 4; ++k) m = fmaxf(m, fabsf(v[j][k]));
        }
        m = fmaxf(wmaxf(m), 1e-30f);
        const float sc = m * (F4_CLIP / 6.f), inv_s = 1.f / sc;
        unsigned w[4];
#pragma unroll
        for (int j = 0; j < 4; ++j) w[j] = 0u;
#pragma unroll
        for (int e = 0; e < 32; e += 2) {
            const float x0 = v[e >> 2][e & 3] * inv_s, x1 = v[(e + 1) >> 2][(e + 1) & 3] * inv_s;
            switch ((e & 7) >> 1) {
                case 0: w[e >> 3] = __builtin_amdgcn_cvt_scalef32_pk_fp4_f32(w[e >> 3], x0, x1, 1.0f, 0); break;
                case 1: w[e >> 3] = __builtin_amdgcn_cvt_scalef32_pk_fp4_f32(w[e >> 3], x0, x1, 1.0f, 1); break;
                case 2: w[e >> 3] = __builtin_amdgcn_cvt_scalef32_pk_fp4_f32(w[e >> 3], x0, x1, 1.0f, 2); break;
                default: w[e >> 3] = __builtin_amdgcn_cvt_scalef32_pk_fp4_f32(w[e >> 3], x0, x1, 1.0f, 3); break;
            }
        }
        *(GAS u32x4*)((GAS unsigned char*)dst + (size_t)row * F4_ROW + lane * 16) = u32x4{w[0], w[1], w[2], w[3]};
        if (lane == 0) scale[row] = sc;
    }
}
#define F4_CVT0(dst, src) asm volatile("v_cvt_scalef32_pk_f32_fp4 %0, %1, 1.0" : "=v"(dst) : "v"(src))
#define F4_CVT1(dst, src) asm volatile("v_cvt_scalef32_pk_f32_fp4 %0, %1, 1.0 op_sel:[1,0,0]" : "=v"(dst) : "v"(src))
#define F4_CVT2(dst, src) asm volatile("v_cvt_scalef32_pk_f32_fp4 %0, %1, 1.0 op_sel:[0,1,0]" : "=v"(dst) : "v"(src))
#define F4_CVT3(dst, src) asm volatile("v_cvt_scalef32_pk_f32_fp4 %0, %1, 1.0 op_sel:[1,1,0]" : "=v"(dst) : "v"(src))
__device__ __forceinline__ void peer_gather_f4(const float* X, const int* __restrict__ IDX, const float* __restrict__ G,
                                               const unsigned char* __restrict__ U4, const unsigned char* __restrict__ V4,
                                               const float* __restrict__ SU, const float* __restrict__ SV,
                                               const float* __restrict__ g, const float* __restrict__ bb, float* dst, bf16_t* xbout) {
    const int tid_ = opaque_tid(); const int wave = __builtin_amdgcn_readfirstlane(tid_ >> 6);
    const GAS unsigned char* Ug = (const GAS unsigned char*)U4; const GAS unsigned char* Vg = (const GAS unsigned char*)V4;
    for (int row = blockIdx.x * 8 + wave; row < T; row += NBLK * 8) {
        int lane = tid_ & 63; asm volatile("" : "+v"(lane));
        f32x2 xr[16], acc[16];
#pragma unroll
        for (int j = 0; j < 8; ++j) {
            const f32x4 t4 = *(const GAS f32x4*)((const GAS float*)X + (size_t)row * D + 256 * j + lane * 4);
            xr[2 * j] = f32x2{t4[0], t4[1]}; xr[2 * j + 1] = f32x2{t4[2], t4[3]};
        }
#pragma unroll
        for (int k = 0; k < 16; ++k) acc[k] = f32x2{0.f, 0.f};
        int k0 = (IDX[(size_t)row * 128 + lane] << 7) | lane, k1 = (IDX[(size_t)row * 128 + 64 + lane] << 7) | (64 + lane);
#define GS_STEP(SIZE, STRIDE) do { const int p0_ = swz_xor_i<STRIDE>(k0), p1_ = swz_xor_i<STRIDE>(k1); const bool lo_ = (lane & STRIDE) == 0; \
            const bool up0_ = (SIZE == 128) ? true : ((SIZE == 64) ? true : ((lane & SIZE) == 0)), up1_ = (SIZE == 128) ? true : ((SIZE == 64) ? false : ((lane & SIZE) == 0)); \
            k0 = (up0_ == lo_) ? imin(k0, p0_) : imax(k0, p0_); k1 = (up1_ == lo_) ? imin(k1, p1_) : imax(k1, p1_); } while (0)
#define GS_STEP32(SIZE) do { auto r0_ = __builtin_amdgcn_permlane32_swap((unsigned)k0, (unsigned)k0, false, false); auto r1_ = __builtin_amdgcn_permlane32_swap((unsigned)k1, (unsigned)k1, false, false); \
            const bool lo_ = (lane & 32) == 0; const int p0_ = lo_ ? (int)r0_[1] : (int)r0_[0], p1_ = lo_ ? (int)r1_[1] : (int)r1_[0]; \
            const bool up0_ = true, up1_ = (SIZE == 128); \
            k0 = (up0_ == lo_) ? imin(k0, p0_) : imax(k0, p0_); k1 = (up1_ == lo_) ? imin(k1, p1_) : imax(k1, p1_); } while (0)
        GS_STEP(2, 1);
        GS_STEP(4, 2); GS_STEP(4, 1);
        GS_STEP(8, 4); GS_STEP(8, 2); GS_STEP(8, 1);
        GS_STEP(16, 8); GS_STEP(16, 4); GS_STEP(16, 2); GS_STEP(16, 1);
        GS_STEP(32, 16); GS_STEP(32, 8); GS_STEP(32, 4); GS_STEP(32, 2); GS_STEP(32, 1);
        GS_STEP32(64); GS_STEP(64, 16); GS_STEP(64, 8); GS_STEP(64, 4); GS_STEP(64, 2); GS_STEP(64, 1);
        { const int a_ = imin(k0, k1), b_ = imax(k0, k1); k0 = a_; k1 = b_; }
        GS_STEP32(128); GS_STEP(128, 16); GS_STEP(128, 8); GS_STEP(128, 4); GS_STEP(128, 2); GS_STEP(128, 1);
#undef GS_STEP
#undef GS_STEP32
#pragma unroll 1
        for (int bt = 0; bt < 8; ++bt) {
            const int ksel = (bt & 4) ? k1 : k0;
            const int key = __builtin_amdgcn_ds_bpermute(4 * (16 * (bt & 3) + (lane & 15)), ksel);
            const int idxv = key >> 7;
            const float gv = G[(size_t)row * 128 + (key & 127)];
            const float suv = SU[idxv], svv = SV[idxv];
            float part[16];
            u32x4 ra[4], rb[4];
#define F4_LOADG(buf, base, gq) do { _Pragma("unroll") for (int e_ = 0; e_ < 4; ++e_) { \
                const int ix_ = __builtin_amdgcn_readlane(idxv, 4 * (gq) + e_); \
                buf[e_] = *(const GAS u32x4*)((base) + (size_t)ix_ * F4_ROW + lane * 16); } } while (0)
#define F4_DOTG(buf, gq) do { _Pragma("unroll") for (int e_ = 0; e_ < 4; ++e_) { \
                f32x2 s0_ = f32x2{0.f, 0.f}, s1_ = f32x2{0.f, 0.f}; \
                _Pragma("unroll") for (int w_ = 0; w_ < 4; ++w_) { \
                    const unsigned d_ = buf[e_][w_]; f32x2 c0_, c1_, c2_, c3_; \
                    F4_CVT0(c0_, d_); F4_CVT1(c1_, d_); F4_CVT2(c2_, d_); F4_CVT3(c3_, d_); \
                    F8_PKFMA(s0_, c0_, xr[4 * w_]); F8_PKFMA(s1_, c1_, xr[4 * w_ + 1]); F8_PKFMA(s0_, c2_, xr[4 * w_ + 2]); F8_PKFMA(s1_, c3_, xr[4 * w_ + 3]); } \
                part[4 * (gq) + e_] = (s0_[0] + s0_[1]) + (s1_[0] + s1_[1]); } } while (0)
#define F4_ACCG(buf, gq) do { _Pragma("unroll") for (int e_ = 0; e_ < 4; ++e_) { \
                const unsigned wu_ = (unsigned)__builtin_amdgcn_readlane((int)__float_as_uint(w), 4 * (gq) + e_); \
                const unsigned long long wp_ = ((unsigned long long)wu_ << 32) | wu_; \
                _Pragma("unroll") for (int w_ = 0; w_ < 4; ++w_) { \
                    const unsigned d_ = buf[e_][w_]; f32x2 c0_, c1_, c2_, c3_; \
                    F4_CVT0(c0_, d_); F4_CVT1(c1_, d_); F4_CVT2(c2_, d_); F4_CVT3(c3_, d_); \
                    F8_PKFMA_S(acc[4 * w_], wp_, c0_); F8_PKFMA_S(acc[4 * w_ + 1], wp_, c1_); F8_PKFMA_S(acc[4 * w_ + 2], wp_, c2_); F8_PKFMA_S(acc[4 * w_ + 3], wp_, c3_); } } } while (0)
            F4_LOADG(ra, Ug, 0);
            F4_LOADG(rb, Ug, 1); F4_DOTG(ra, 0);
            F4_LOADG(ra, Ug, 2); F4_DOTG(rb, 1);
            F4_LOADG(rb, Ug, 3); F4_DOTG(ra, 2);
            F4_LOADG(ra, Vg, 0); F4_DOTG(rb, 3);
            float r8[8], r4[4], r2[2], h;
            { const bool hb = (lane & 8) != 0;
#pragma unroll
              for (int k = 0; k < 8; ++k) { const float keep = hb ? part[8 + k] : part[k], send = hb ? part[k] : part[8 + k]; r8[k] = keep + swz_xor<8>(send); } }
            { const bool hb = (lane & 4) != 0;
#pragma unroll
              for (int k = 0; k < 4; ++k) { const float keep = hb ? r8[4 + k] : r8[k], send = hb ? r8[k] : r8[4 + k]; r4[k] = keep + swz_xor<4>(send); } }
            { const bool hb = (lane & 2) != 0;
#pragma unroll
              for (int k = 0; k < 2; ++k) { const float keep = hb ? r4[2 + k] : r4[k], send = hb ? r4[k] : r4[2 + k]; r2[k] = keep + swz_xor<2>(send); } }
            { const bool hb = (lane & 1) != 0; const float keep = hb ? r2[1] : r2[0], send = hb ? r2[0] : r2[1]; h = keep + swz_xor<1>(send); }
            h += swz_xor<16>(h);
            { auto rr = __builtin_amdgcn_permlane32_swap(__float_as_uint(h), __float_as_uint(h), false, false); h = __uint_as_float(rr[0]) + __uint_as_float(rr[1]); }
            const float w = gv * gelu_tanh(h * suv) * svv;
            F4_LOADG(rb, Vg, 1); F4_ACCG(ra, 0);
            F4_LOADG(ra, Vg, 2); F4_ACCG(rb, 1);
            F4_LOADG(rb, Vg, 3); F4_ACCG(ra, 2);
            F4_ACCG(rb, 3);
#undef F4_LOADG
#undef F4_DOTG
#undef F4_ACCG
        }
        asm volatile("" : "+v"(lane));
        float s1 = 0.f;
#pragma unroll
        for (int k = 0; k < 16; ++k) { acc[k][0] = fmaf(ALPHA, xr[k][0], acc[k][0]); acc[k][1] = fmaf(ALPHA, xr[k][1], acc[k][1]); s1 += acc[k][0] + acc[k][1]; }
        const float mu = wsum(s1) * (1.f / D);
        float s2 = 0.f;
#pragma unroll
        for (int k = 0; k < 16; ++k) { const float d0 = acc[k][0] - mu, d1 = acc[k][1] - mu; s2 = fmaf(d0, d0, s2); s2 = fmaf(d1, d1, s2); }
        const float rstd = rsqrtf(wsum(s2) * (1.f / D) + LN_EPS);
        const float* gl_ = g; const float* bl_ = bb;
        asm volatile("" : "+s"(gl_), "+s"(bl_));
#pragma unroll
        for (int j = 0; j < 8; ++j) {
            const int col = 256 * j + lane * 4;
            const f32x4 g4 = *(const GAS f32x4*)((const GAS float*)gl_ + col), b4 = *(const GAS f32x4*)((const GAS float*)bl_ + col);
            f32x4 o4;
            o4[0] = (acc[2 * j][0] - mu) * rstd * g4[0] + b4[0]; o4[1] = (acc[2 * j][1] - mu) * rstd * g4[1] + b4[1];
            o4[2] = (acc[2 * j + 1][0] - mu) * rstd * g4[2] + b4[2]; o4[3] = (acc[2 * j + 1][1] - mu) * rstd * g4[3] + b4[3];
            *(GAS f32x4*)((GAS float*)dst + (size_t)row * D + col) = o4;
            *(GAS u32x2*)((GAS bf16_t*)xbout + (size_t)row * D + col) = u32x2{cvtpk(o4[0], o4[1]), cvtpk(o4[2], o4[3])};
        }
    }
}

__device__ __forceinline__ void peer_gather_f4s(const float* X, const int* __restrict__ IDX, const float* __restrict__ G,
                                               const unsigned char* __restrict__ U4, const unsigned char* __restrict__ V4,
                                               const float* __restrict__ SU, const float* __restrict__ SV,
                                               const float* __restrict__ g, const float* __restrict__ bb, float* dst, bf16_t* xbout) {
    const int tid_ = opaque_tid(); const int wave = __builtin_amdgcn_readfirstlane(tid_ >> 6);
    const GAS unsigned char* Ug = (const GAS unsigned char*)U4; const GAS unsigned char* Vg = (const GAS unsigned char*)V4;
    extern __shared__ __attribute__((aligned(16))) unsigned char gs_lds[];
    LAS int* kbuf = (LAS int*)((LAS unsigned char*)gs_lds + wave * 4096);
    LAS float* wbuf = (LAS float*)((LAS unsigned char*)gs_lds + wave * 4096 + 2048);
#pragma unroll 1
    for (int kt = 0; kt < 4; ++kt) {
        const int row = blockIdx.x * 8 + wave + kt * NBLK * 8;
        int lane = tid_ & 63; asm volatile("" : "+v"(lane));
        f32x2 xr[16];
#pragma unroll
        for (int j = 0; j < 8; ++j) {
            const f32x4 t4 = *(const GAS f32x4*)((const GAS float*)X + (size_t)row * D + 256 * j + lane * 4);
            xr[2 * j] = f32x2{t4[0], t4[1]}; xr[2 * j + 1] = f32x2{t4[2], t4[3]};
        }
        int k0 = (IDX[(size_t)row * 128 + lane] << 7) | lane, k1 = (IDX[(size_t)row * 128 + 64 + lane] << 7) | (64 + lane);
#define GS_STEP(SIZE, STRIDE) do { const int p0_ = swz_xor_i<STRIDE>(k0), p1_ = swz_xor_i<STRIDE>(k1); const bool lo_ = (lane & STRIDE) == 0; \
            const bool up0_ = (SIZE == 128) ? true : ((SIZE == 64) ? true : ((lane & SIZE) == 0)), up1_ = (SIZE == 128) ? true : ((SIZE == 64) ? false : ((lane & SIZE) == 0)); \
            k0 = (up0_ == lo_) ? imin(k0, p0_) : imax(k0, p0_); k1 = (up1_ == lo_) ? imin(k1, p1_) : imax(k1, p1_); } while (0)
#define GS_STEP32(SIZE) do { auto r0_ = __builtin_amdgcn_permlane32_swap((unsigned)k0, (unsigned)k0, false, false); auto r1_ = __builtin_amdgcn_permlane32_swap((unsigned)k1, (unsigned)k1, false, false); \
            const bool lo_ = (lane & 32) == 0; const int p0_ = lo_ ? (int)r0_[1] : (int)r0_[0], p1_ = lo_ ? (int)r1_[1] : (int)r1_[0]; \
            const bool up0_ = true, up1_ = (SIZE == 128); \
            k0 = (up0_ == lo_) ? imin(k0, p0_) : imax(k0, p0_); k1 = (up1_ == lo_) ? imin(k1, p1_) : imax(k1, p1_); } while (0)
        GS_STEP(2, 1);
        GS_STEP(4, 2); GS_STEP(4, 1);
        GS_STEP(8, 4); GS_STEP(8, 2); GS_STEP(8, 1);
        GS_STEP(16, 8); GS_STEP(16, 4); GS_STEP(16, 2); GS_STEP(16, 1);
        GS_STEP(32, 16); GS_STEP(32, 8); GS_STEP(32, 4); GS_STEP(32, 2); GS_STEP(32, 1);
        GS_STEP32(64); GS_STEP(64, 16); GS_STEP(64, 8); GS_STEP(64, 4); GS_STEP(64, 2); GS_STEP(64, 1);
        { const int a_ = imin(k0, k1), b_ = imax(k0, k1); k0 = a_; k1 = b_; }
        GS_STEP32(128); GS_STEP(128, 16); GS_STEP(128, 8); GS_STEP(128, 4); GS_STEP(128, 2); GS_STEP(128, 1);
#undef GS_STEP
#undef GS_STEP32
#pragma unroll 1
        for (int bt = 0; bt < 8; ++bt) {
            const int ksel = (bt & 4) ? k1 : k0;
            const int key = __builtin_amdgcn_ds_bpermute(4 * (16 * (bt & 3) + (lane & 15)), ksel);
            const int idxv = key >> 7;
            const float gv = G[(size_t)row * 128 + (key & 127)];
            const float suv = SU[idxv], svv = SV[idxv];
            float part[16];
            u32x4 ra[4], rb[4];
#define F4_LOADG(buf, base, gq) do { _Pragma("unroll") for (int e_ = 0; e_ < 4; ++e_) { \
                const int ix_ = __builtin_amdgcn_readlane(idxv, 4 * (gq) + e_); \
                buf[e_] = *(const GAS u32x4*)((base) + (size_t)ix_ * F4_ROW + lane * 16); } } while (0)
#define F4_DOTG(buf, gq) do { _Pragma("unroll") for (int e_ = 0; e_ < 4; ++e_) { \
                f32x2 s0_ = f32x2{0.f, 0.f}, s1_ = f32x2{0.f, 0.f}; \
                _Pragma("unroll") for (int w_ = 0; w_ < 4; ++w_) { \
                    const unsigned d_ = buf[e_][w_]; f32x2 c0_, c1_, c2_, c3_; \
                    F4_CVT0(c0_, d_); F4_CVT1(c1_, d_); F4_CVT2(c2_, d_); F4_CVT3(c3_, d_); \
                    F8_PKFMA(s0_, c0_, xr[4 * w_]); F8_PKFMA(s1_, c1_, xr[4 * w_ + 1]); F8_PKFMA(s0_, c2_, xr[4 * w_ + 2]); F8_PKFMA(s1_, c3_, xr[4 * w_ + 3]); } \
                part[4 * (gq) + e_] = (s0_[0] + s0_[1]) + (s1_[0] + s1_[1]); } } while (0)
#define F4_ACCG(buf, gq) do { _Pragma("unroll") for (int e_ = 0; e_ < 4; ++e_) { \
                const unsigned wu_ = (unsigned)__builtin_amdgcn_readlane((int)__float_as_uint(w), 4 * (gq) + e_); \
                const unsigned long long wp_ = ((unsigned long long)wu_ << 32) | wu_; \
                _Pragma("unroll") for (int w_ = 0; w_ < 4; ++w_) { \
                    const unsigned d_ = buf[e_][w_]; f32x2 c0_, c1_, c2_, c3_; \
                    F4_CVT0(c0_, d_); F4_CVT1(c1_, d_); F4_CVT2(c2_, d_); F4_CVT3(c3_, d_); \
                    F8_PKFMA_S(acc[4 * w_], wp_, c0_); F8_PKFMA_S(acc[4 * w_ + 1], wp_, c1_); F8_PKFMA_S(acc[4 * w_ + 2], wp_, c2_); F8_PKFMA_S(acc[4 * w_ + 3], wp_, c3_); } } } while (0)
            F4_LOADG(ra, Ug, 0);
            F4_LOADG(rb, Ug, 1); F4_DOTG(ra, 0);
            F4_LOADG(ra, Ug, 2); F4_DOTG(rb, 1);
            F4_LOADG(rb, Ug, 3); F4_DOTG(ra, 2);
            F4_DOTG(rb, 3);
            float r8[8], r4[4], r2[2], h;
            { const bool hb = (lane & 8) != 0;
#pragma unroll
              for (int k = 0; k < 8; ++k) { const float keep = hb ? part[8 + k] : part[k], send = hb ? part[k] : part[8 + k]; r8[k] = keep + swz_xor<8>(send); } }
            { const bool hb = (lane & 4) != 0;
#pragma unroll
              for (int k = 0; k < 4; ++k) { const float keep = hb ? r8[4 + k] : r8[k], send = hb ? r8[k] : r8[4 + k]; r4[k] = keep + swz_xor<4>(send); } }
            { const bool hb = (lane & 2) != 0;
#pragma unroll
              for (int k = 0; k < 2; ++k) { const float keep = hb ? r4[2 + k] : r4[k], send = hb ? r4[k] : r4[2 + k]; r2[k] = keep + swz_xor<2>(send); } }
            { const bool hb = (lane & 1) != 0; const float keep = hb ? r2[1] : r2[0], send = hb ? r2[0] : r2[1]; h = keep + swz_xor<1>(send); }
            h += swz_xor<16>(h);
            { auto rr = __builtin_amdgcn_permlane32_swap(__float_as_uint(h), __float_as_uint(h), false, false); h = __uint_as_float(rr[0]) + __uint_as_float(rr[1]); }
            const float w = gv * gelu_tanh(h * suv) * svv;
            if (lane < 16) { kbuf[kt * 128 + bt * 16 + lane] = idxv; wbuf[kt * 128 + bt * 16 + lane] = w; }
        }
    }
#pragma unroll 1
    for (int kt = 0; kt < 4; ++kt) {
        const int row = blockIdx.x * 8 + wave + kt * NBLK * 8;
        int lane = tid_ & 63; asm volatile("" : "+v"(lane));
        f32x2 acc[16];
#pragma unroll
        for (int k = 0; k < 16; ++k) acc[k] = f32x2{0.f, 0.f};
#pragma unroll 1
        for (int bt = 0; bt < 8; ++bt) {
            const int idxv = kbuf[kt * 128 + bt * 16 + (lane & 15)];
            const float w = wbuf[kt * 128 + bt * 16 + (lane & 15)];
            u32x4 ra[4], rb[4];
            F4_LOADG(ra, Vg, 0);
            F4_LOADG(rb, Vg, 1); F4_ACCG(ra, 0);
            F4_LOADG(ra, Vg, 2); F4_ACCG(rb, 1);
            F4_LOADG(rb, Vg, 3); F4_ACCG(ra, 2);
            F4_ACCG(rb, 3);
        }
#undef F4_LOADG
#undef F4_DOTG
#undef F4_ACCG
        asm volatile("" : "+v"(lane));
        f32x2 xr[16];
#pragma unroll
        for (int j = 0; j < 8; ++j) {
            const f32x4 t4 = *(const GAS f32x4*)((const GAS float*)X + (size_t)row * D + 256 * j + lane * 4);
            xr[2 * j] = f32x2{t4[0], t4[1]}; xr[2 * j + 1] = f32x2{t4[2], t4[3]};
        }
        float s1 = 0.f;
#pragma unroll
        for (int k = 0; k < 16; ++k) { acc[k][0] = fmaf(ALPHA, xr[k][0], acc[k][0]); acc[k][1] = fmaf(ALPHA, xr[k][1], acc[k][1]); s1 += acc[k][0] + acc[k][1]; }
        const float mu = wsum(s1) * (1.f / D);
        float s2 = 0.f;
#pragma unroll
        for (int k = 0; k < 16; ++k) { const float d0 = acc[k][0] - mu, d1 = acc[k][1] - mu; s2 = fmaf(d0, d0, s2); s2 = fmaf(d1, d1, s2); }
        const float rstd = rsqrtf(wsum(s2) * (1.f / D) + LN_EPS);
        const float* gl_ = g; const float* bl_ = bb;
        asm volatile("" : "+s"(gl_), "+s"(bl_));
#pragma unroll
        for (int j = 0; j < 8; ++j) {
            const int col = 256 * j + lane * 4;
            const f32x4 g4 = *(const GAS f32x4*)((const GAS float*)gl_ + col), b4 = *(const GAS f32x4*)((const GAS float*)bl_ + col);
            f32x4 o4;
            o4[0] = (acc[2 * j][0] - mu) * rstd * g4[0] + b4[0]; o4[1] = (acc[2 * j][1] - mu) * rstd * g4[1] + b4[1];
            o4[2] = (acc[2 * j + 1][0] - mu) * rstd * g4[2] + b4[2]; o4[3] = (acc[2 * j + 1][1] - mu) * rstd * g4[3] + b4[3];
            *(GAS f32x4*)((GAS float*)dst + (size_t)row * D + col) = o4;
            *(GAS u32x2*)((GAS bf16_t*)xbout + (size_t)row * D + col) = u32x2{cvtpk(o4[0], o4[1]), cvtpk(o4[2], o4[3])};
        }
    }
}

#define P4_LOAD(buf, base, key) buf = *(const GAS u32x4*)((base) + (size_t)((unsigned)(key) >> 7) * F4_ROW + lane * 16)
#define P4_DOT(B, res) do { f32x2 s0_ = f32x2{0.f, 0.f}, s1_ = f32x2{0.f, 0.f}; \
    _Pragma("unroll") for (int w_ = 0; w_ < 4; ++w_) { const unsigned d_ = B[w_]; f32x2 c0_, c1_, c2_, c3_; \
        F4_CVT0(c0_, d_); F4_CVT1(c1_, d_); F4_CVT2(c2_, d_); F4_CVT3(c3_, d_); \
        F8_PKFMA(s0_, c0_, xr[4 * w_]); F8_PKFMA(s1_, c1_, xr[4 * w_ + 1]); F8_PKFMA(s0_, c2_, xr[4 * w_ + 2]); F8_PKFMA(s1_, c3_, xr[4 * w_ + 3]); } \
    res = (s0_[0] + s0_[1]) + (s1_[0] + s1_[1]); } while (0)
#define P4_ACC(B, wp) do { \
    _Pragma("unroll") for (int w_ = 0; w_ < 4; ++w_) { const unsigned d_ = B[w_]; f32x2 c0_, c1_, c2_, c3_; \
        F4_CVT0(c0_, d_); F4_CVT1(c1_, d_); F4_CVT2(c2_, d_); F4_CVT3(c3_, d_); \
        F8_PKFMA_S(acc[4 * w_], wp, c0_); F8_PKFMA_S(acc[4 * w_ + 1], wp, c1_); F8_PKFMA_S(acc[4 * w_ + 2], wp, c2_); F8_PKFMA_S(acc[4 * w_ + 3], wp, c3_); } } while (0)
#define P4_FOR16(M) M(0) M(1) M(2) M(3) M(4) M(5) M(6) M(7) M(8) M(9) M(10) M(11) M(12) M(13) M(14) M(15)
__device__ __forceinline__ void peer_gather_f4p(const float* X, const int* __restrict__ IDX, const float* __restrict__ G,
                                                const unsigned char* __restrict__ U4, const unsigned char* __restrict__ V4,
                                                const float* __restrict__ SU, const float* __restrict__ SV,
                                                const float* __restrict__ g, const float* __restrict__ bb, float* dst, bf16_t* xbout) {
    extern __shared__ __attribute__((aligned(16))) unsigned char p4_lds[];
    const int tid_ = opaque_tid(); const int wave = __builtin_amdgcn_readfirstlane(tid_ >> 6);
    const GAS unsigned char* Ug = (const GAS unsigned char*)U4; const GAS unsigned char* Vg = (const GAS unsigned char*)V4;
    LAS int* keys = (LAS int*)((LAS unsigned char*)p4_lds + wave * 8192);
    LAS float* sub = (LAS float*)((LAS unsigned char*)p4_lds + wave * 8192 + 2048);
    LAS float* wbuf = (LAS float*)((LAS unsigned char*)p4_lds + wave * 8192 + 4096);
    u32x4 b0, b1, b2, b3, b4, b5, b6, b7, b8, b9, b10, b11, b12, b13, b14, b15;
#pragma unroll 1
    for (int kt = 0; kt < 4; ++kt) {
        const int row = blockIdx.x * 32 + wave * 4 + kt;
        int lane = tid_ & 63; asm volatile("" : "+v"(lane));
        int k0 = (IDX[(size_t)row * 128 + lane] << 7) | lane, k1 = (IDX[(size_t)row * 128 + 64 + lane] << 7) | (64 + lane);
#define GS_STEP(SIZE, STRIDE) do { const int p0_ = swz_xor_i<STRIDE>(k0), p1_ = swz_xor_i<STRIDE>(k1); const bool lo_ = (lane & STRIDE) == 0; \
            const bool up0_ = (SIZE == 128) ? true : ((SIZE == 64) ? true : ((lane & SIZE) == 0)), up1_ = (SIZE == 128) ? true : ((SIZE == 64) ? false : ((lane & SIZE) == 0)); \
            k0 = (up0_ == lo_) ? imin(k0, p0_) : imax(k0, p0_); k1 = (up1_ == lo_) ? imin(k1, p1_) : imax(k1, p1_); } while (0)
#define GS_STEP32(SIZE) do { auto r0_ = __builtin_amdgcn_permlane32_swap((unsigned)k0, (unsigned)k0, false, false); auto r1_ = __builtin_amdgcn_permlane32_swap((unsigned)k1, (unsigned)k1, false, false); \
            const bool lo_ = (lane & 32) == 0; const int p0_ = lo_ ? (int)r0_[1] : (int)r0_[0], p1_ = lo_ ? (int)r1_[1] : (int)r1_[0]; \
            const bool up0_ = true, up1_ = (SIZE == 128); \
            k0 = (up0_ == lo_) ? imin(k0, p0_) : imax(k0, p0_); k1 = (up1_ == lo_) ? imin(k1, p1_) : imax(k1, p1_); } while (0)
        GS_STEP(2, 1);
        GS_STEP(4, 2); GS_STEP(4, 1);
        GS_STEP(8, 4); GS_STEP(8, 2); GS_STEP(8, 1);
        GS_STEP(16, 8); GS_STEP(16, 4); GS_STEP(16, 2); GS_STEP(16, 1);
        GS_STEP(32, 16); GS_STEP(32, 8); GS_STEP(32, 4); GS_STEP(32, 2); GS_STEP(32, 1);
        GS_STEP32(64); GS_STEP(64, 16); GS_STEP(64, 8); GS_STEP(64, 4); GS_STEP(64, 2); GS_STEP(64, 1);
        { const int a_ = imin(k0, k1), b_ = imax(k0, k1); k0 = a_; k1 = b_; }
        GS_STEP32(128); GS_STEP(128, 16); GS_STEP(128, 8); GS_STEP(128, 4); GS_STEP(128, 2); GS_STEP(128, 1);
#undef GS_STEP
#undef GS_STEP32
        if (kt == 0) {
#define P4_L0(i) P4_LOAD(b##i, Ug, __builtin_amdgcn_readlane(k0, i));
            P4_FOR16(P4_L0)
#undef P4_L0
        }
        keys[kt * 128 + lane] = k0; keys[kt * 128 + 64 + lane] = k1;
        sub[kt * 128 + lane] = SU[k0 >> 7]; sub[kt * 128 + 64 + lane] = SU[k1 >> 7];
        wbuf[kt * 128 + lane] = G[(size_t)row * 128 + (k0 & 127)] * SV[k0 >> 7]; wbuf[kt * 128 + 64 + lane] = G[(size_t)row * 128 + (k1 & 127)] * SV[k1 >> 7];
    }
#pragma unroll 1
    for (int kt = 0; kt < 4; ++kt) {
        const int row = blockIdx.x * 32 + wave * 4 + kt;
        int lane = tid_ & 63; asm volatile("" : "+v"(lane));
        f32x2 xr[16];
#pragma unroll
        for (int j = 0; j < 8; ++j) {
            if (RES_BF16) {
                const u32x2 t2 = *(const GAS u32x2*)((const GAS bf16_t*)xbout + (size_t)row * D + 256 * j + lane * 4);
                xr[2 * j] = f32x2{__uint_as_float(t2[0] << 16), __uint_as_float(t2[0] & 0xffff0000u)}; xr[2 * j + 1] = f32x2{__uint_as_float(t2[1] << 16), __uint_as_float(t2[1] & 0xffff0000u)};
            } else {
                const f32x4 t4 = *(const GAS f32x4*)((const GAS float*)X + (size_t)row * D + 256 * j + lane * 4);
                xr[2 * j] = f32x2{t4[0], t4[1]}; xr[2 * j + 1] = f32x2{t4[2], t4[3]};
            }
        }
        const int k0 = keys[kt * 128 + lane], k1 = keys[kt * 128 + 64 + lane];
        const int kn = keys[((kt + 1) & 3) * 128 + lane];
        const GAS unsigned char* nbase = (kt < 3) ? Ug : Vg;
        float part[16];
#define P4_RED(bt_) do { float r8[8], r4[4], r2[2], h; \
            { const bool hb = (lane & 8) != 0; _Pragma("unroll") for (int k = 0; k < 8; ++k) { const float keep = hb ? part[8 + k] : part[k], send = hb ? part[k] : part[8 + k]; r8[k] = keep + swz_xor<8>(send); } } \
            { const bool hb = (lane & 4) != 0; _Pragma("unroll") for (int k = 0; k < 4; ++k) { const float keep = hb ? r8[4 + k] : r8[k], send = hb ? r8[k] : r8[4 + k]; r4[k] = keep + swz_xor<4>(send); } } \
            { const bool hb = (lane & 2) != 0; _Pragma("unroll") for (int k = 0; k < 2; ++k) { const float keep = hb ? r4[2 + k] : r4[k], send = hb ? r4[k] : r4[2 + k]; r2[k] = keep + swz_xor<2>(send); } } \
            { const bool hb = (lane & 1) != 0; const float keep = hb ? r2[1] : r2[0], send = hb ? r2[0] : r2[1]; h = keep + swz_xor<1>(send); } \
            h += swz_xor<16>(h); \
            { auto rr = __builtin_amdgcn_permlane32_swap(__float_as_uint(h), __float_as_uint(h), false, false); h = __uint_as_float(rr[0]) + __uint_as_float(rr[1]); } \
            const int pp_ = kt * 128 + (bt_) * 16 + (lane & 15); \
            const float wq_ = wbuf[pp_] * gelu_tanh(h * sub[pp_]); \
            if (lane < 16) wbuf[pp_] = wq_; } while (0)
#pragma unroll 1
        for (int bt = 0; bt < 7; ++bt) {
            const int ksel = (bt + 1 < 4) ? k0 : k1;
            const int nb = (16 * (bt + 1)) & 63;
#define P4_U(i) { P4_DOT(b##i, part[i]); const int nk_ = __builtin_amdgcn_readlane(ksel, nb + i); P4_LOAD(b##i, Ug, nk_); }
            P4_FOR16(P4_U)
#undef P4_U
            P4_RED(bt);
        }
        {
#define P4_U(i) { P4_DOT(b##i, part[i]); const int nk_ = __builtin_amdgcn_readlane(kn, i); P4_LOAD(b##i, nbase, nk_); }
            P4_FOR16(P4_U)
#undef P4_U
            P4_RED(7);
        }
#undef P4_RED
    }
#pragma unroll 1
    for (int kt = 0; kt < 4; ++kt) {
        const int row = blockIdx.x * 32 + wave * 4 + kt;
        int lane = tid_ & 63; asm volatile("" : "+v"(lane));
        const int k0 = keys[kt * 128 + lane], k1 = keys[kt * 128 + 64 + lane];
        const int kn = keys[((kt + 1) & 3) * 128 + lane];
        f32x2 acc[16];
#pragma unroll
        for (int k = 0; k < 16; ++k) acc[k] = f32x2{0.f, 0.f};
#pragma unroll 1
        for (int bt = 0; bt < 7; ++bt) {
            const int ksel = (bt + 1 < 4) ? k0 : k1;
            const int nb = (16 * (bt + 1)) & 63;
            const float wreg = wbuf[kt * 128 + bt * 16 + (lane & 15)];
#define P4_V(i) { const unsigned wu_ = (unsigned)__builtin_amdgcn_readlane((int)__float_as_uint(wreg), i); const unsigned long long wp_ = ((unsigned long long)wu_ << 32) | wu_; \
              P4_ACC(b##i, wp_); const int nk_ = __builtin_amdgcn_readlane(ksel, nb + i); P4_LOAD(b##i, Vg, nk_); }
            P4_FOR16(P4_V)
#undef P4_V
        }
        {
            const float wreg = wbuf[kt * 128 + 7 * 16 + (lane & 15)];
            if (kt < 3) {
#define P4_V(i) { const unsigned wu_ = (unsigned)__builtin_amdgcn_readlane((int)__float_as_uint(wreg), i); const unsigned long long wp_ = ((unsigned long long)wu_ << 32) | wu_; \
              P4_ACC(b##i, wp_); const int nk_ = __builtin_amdgcn_readlane(kn, i); P4_LOAD(b##i, Vg, nk_); }
                P4_FOR16(P4_V)
#undef P4_V
            } else {
#define P4_V(i) { const unsigned wu_ = (unsigned)__builtin_amdgcn_readlane((int)__float_as_uint(wreg), i); const unsigned long long wp_ = ((unsigned long long)wu_ << 32) | wu_; \
              P4_ACC(b##i, wp_); }
                P4_FOR16(P4_V)
#undef P4_V
            }
        }
        asm volatile("" : "+v"(lane));
        f32x2 xr[16];
#pragma unroll
        for (int j = 0; j < 8; ++j) {
            if (RES_BF16) {
                const u32x2 t2 = *(const GAS u32x2*)((const GAS bf16_t*)xbout + (size_t)row * D + 256 * j + lane * 4);
                xr[2 * j] = f32x2{__uint_as_float(t2[0] << 16), __uint_as_float(t2[0] & 0xffff0000u)}; xr[2 * j + 1] = f32x2{__uint_as_float(t2[1] << 16), __uint_as_float(t2[1] & 0xffff0000u)};
            } else {
                const f32x4 t4 = *(const GAS f32x4*)((const GAS float*)X + (size_t)row * D + 256 * j + lane * 4);
                xr[2 * j] = f32x2{t4[0], t4[1]}; xr[2 * j + 1] = f32x2{t4[2], t4[3]};
            }
        }
        float s1 = 0.f;
#pragma unroll
        for (int k = 0; k < 16; ++k) { acc[k][0] = fmaf(ALPHA, xr[k][0], acc[k][0]); acc[k][1] = fmaf(ALPHA, xr[k][1], acc[k][1]); s1 += acc[k][0] + acc[k][1]; }
        const float mu = wsum(s1) * (1.f / D);
        float s2 = 0.f;
#pragma unroll
        for (int k = 0; k < 16; ++k) { const float d0 = acc[k][0] - mu, d1 = acc[k][1] - mu; s2 = fmaf(d0, d0, s2); s2 = fmaf(d1, d1, s2); }
        const float rstd = rsqrtf(wsum(s2) * (1.f / D) + LN_EPS);
        const float* gl_ = g; const float* bl_ = bb;
        asm volatile("" : "+s"(gl_), "+s"(bl_));
#pragma unroll
        for (int j = 0; j < 8; ++j) {
            const int col = 256 * j + lane * 4;
            const f32x4 g4 = *(const GAS f32x4*)((const GAS float*)gl_ + col), b4 = *(const GAS f32x4*)((const GAS float*)bl_ + col);
            f32x4 o4;
            o4[0] = (acc[2 * j][0] - mu) * rstd * g4[0] + b4[0]; o4[1] = (acc[2 * j][1] - mu) * rstd * g4[1] + b4[1];
            o4[2] = (acc[2 * j + 1][0] - mu) * rstd * g4[2] + b4[2]; o4[3] = (acc[2 * j + 1][1] - mu) * rstd * g4[3] + b4[3];
            if (!RES_BF16 || dst != nullptr) *(GAS f32x4*)((GAS float*)dst + (size_t)row * D + col) = o4;
            *(GAS u32x2*)((GAS bf16_t*)xbout + (size_t)row * D + col) = u32x2{cvtpk(o4[0], o4[1]), cvtpk(o4[2], o4[3])};
        }
    }
}
#undef P4_LOAD
#undef P4_DOT
#undef P4_ACC
#undef P4_FOR16

template <int NR, int SIZE, int STRIDE> __device__ __forceinline__ void sort512_stage(int (&k)[NR], int lane) {
    if constexpr (STRIDE >= 64) {
        constexpr int RS = STRIDE / 64;
#pragma unroll
        for (int r = 0; r < NR; ++r) if ((r & RS) == 0) {
            const bool up = (((r * 64) & SIZE) == 0);
            const int a = k[r], b = k[r | RS], mn = imin(a, b), mx = imax(a, b);
            k[r] = up ? mn : mx; k[r | RS] = up ? mx : mn;
        }
    } else if constexpr (STRIDE == 32) {
        const bool lo = (lane & 32) == 0;
#pragma unroll
        for (int r = 0; r < NR; ++r) {
            auto rr = __builtin_amdgcn_permlane32_swap((unsigned)k[r], (unsigned)k[r], false, false);
            const int pv = lo ? (int)rr[1] : (int)rr[0];
            const bool up = (((r * 64) & SIZE) == 0);
            k[r] = (up == lo) ? imin(k[r], pv) : imax(k[r], pv);
        }
    } else {
        const bool lo = (lane & STRIDE) == 0;
#pragma unroll
        for (int r = 0; r < NR; ++r) {
            const int pv = swz_xor_i<STRIDE>(k[r]);
            const bool up = (SIZE >= 64) ? (((r * 64) & SIZE) == 0) : ((lane & SIZE) == 0);
            k[r] = (up == lo) ? imin(k[r], pv) : imax(k[r], pv);
        }
    }
}
template <int NR, int SIZE, int STRIDE> struct Sort512 {
    static __device__ __forceinline__ void run(int (&k)[NR], int lane) {
        sort512_stage<NR, SIZE, STRIDE>(k, lane);
        if constexpr (STRIDE > 1) Sort512<NR, SIZE, STRIDE / 2>::run(k, lane);
        else if constexpr (SIZE < NR * 64) Sort512<NR, SIZE * 2, SIZE>::run(k, lane);
    }
};
#define SW_CVT8(c, w) f32x2 c##0, c##1, c##2, c##3, c##4, c##5, c##6, c##7; \
    F8_CVT_LO(c##0, w[0]); F8_CVT_HI(c##1, w[0]); F8_CVT_LO(c##2, w[1]); F8_CVT_HI(c##3, w[1]); F8_CVT_LO(c##4, w[2]); F8_CVT_HI(c##5, w[2]); F8_CVT_LO(c##6, w[3]); F8_CVT_HI(c##7, w[3])
#define SW_DOT(XR, Ba, Bb, res) do { f32x2 s0_ = f32x2{0.f, 0.f}, s1_ = f32x2{0.f, 0.f}; \
    { SW_CVT8(ca_, Ba); F8_PKFMA(s0_, ca_0, XR[0]); F8_PKFMA(s1_, ca_1, XR[1]); F8_PKFMA(s0_, ca_2, XR[2]); F8_PKFMA(s1_, ca_3, XR[3]); \
      F8_PKFMA(s0_, ca_4, XR[4]); F8_PKFMA(s1_, ca_5, XR[5]); F8_PKFMA(s0_, ca_6, XR[6]); F8_PKFMA(s1_, ca_7, XR[7]); } \
    { SW_CVT8(cb_, Bb); F8_PKFMA(s0_, cb_0, XR[8]); F8_PKFMA(s1_, cb_1, XR[9]); F8_PKFMA(s0_, cb_2, XR[10]); F8_PKFMA(s1_, cb_3, XR[11]); \
      F8_PKFMA(s0_, cb_4, XR[12]); F8_PKFMA(s1_, cb_5, XR[13]); F8_PKFMA(s0_, cb_6, XR[14]); F8_PKFMA(s1_, cb_7, XR[15]); } \
    res = (s0_[0] + s0_[1]) + (s1_[0] + s1_[1]); } while (0)
#define SW_ACC(AC, Ba, Bb, wp) do { \
    { SW_CVT8(ca_, Ba); F8_PKFMA_S(AC[0], wp, ca_0); F8_PKFMA_S(AC[1], wp, ca_1); F8_PKFMA_S(AC[2], wp, ca_2); F8_PKFMA_S(AC[3], wp, ca_3); \
      F8_PKFMA_S(AC[4], wp, ca_4); F8_PKFMA_S(AC[5], wp, ca_5); F8_PKFMA_S(AC[6], wp, ca_6); F8_PKFMA_S(AC[7], wp, ca_7); } \
    { SW_CVT8(cb_, Bb); F8_PKFMA_S(AC[8], wp, cb_0); F8_PKFMA_S(AC[9], wp, cb_1); F8_PKFMA_S(AC[10], wp, cb_2); F8_PKFMA_S(AC[11], wp, cb_3); \
      F8_PKFMA_S(AC[12], wp, cb_4); F8_PKFMA_S(AC[13], wp, cb_5); F8_PKFMA_S(AC[14], wp, cb_6); F8_PKFMA_S(AC[15], wp, cb_7); } } while (0)
__device__ __forceinline__ void peer_gather_sweep(const float* X, const int* __restrict__ IDX, const float* __restrict__ G,
                                                  const unsigned char* __restrict__ U8, const unsigned char* __restrict__ V8,
                                                  const float* __restrict__ SU, const float* __restrict__ SV,
                                                  const float* __restrict__ g, const float* __restrict__ bb, float* dst, bf16_t* xbout) {
    extern __shared__ __attribute__((aligned(16))) unsigned char sw_lds[];
    const int tid_ = opaque_tid(); const int wave = __builtin_amdgcn_readfirstlane(tid_ >> 6);
    int* keys = (int*)(sw_lds + wave * 12800);
    float* wbuf = (float*)(sw_lds + wave * 12800 + 2048);
    float* part = (float*)(sw_lds + wave * 12800 + 4096);
    const GAS unsigned char* Ug = (const GAS unsigned char*)U8; const GAS unsigned char* Vg = (const GAS unsigned char*)V8;
    for (int tb = blockIdx.x * 8 + wave; tb < T / 2; tb += NBLK * 8) {
        int lane = tid_ & 63; asm volatile("" : "+v"(lane));
        const int row0 = tb * 2;
        {
            int k[4];
#pragma unroll
            for (int r = 0; r < 4; ++r) { const int t = r >> 1, slot = (r & 1) * 64 + lane; k[r] = (IDX[(size_t)(row0 + t) * 128 + slot] << 9) | (t << 7) | slot; }
            Sort512<4, 2, 1>::run(k, lane);
#pragma unroll
            for (int r = 0; r < 4; ++r) keys[r * 64 + lane] = k[r];
        }
#define SW_KEY(p) __builtin_amdgcn_readfirstlane(keys[p])
#define SW_LOAD(Ba, Bb, base, p) do { const int key_ = SW_KEY(p); const GAS unsigned char* p_ = (base) + (size_t)(key_ >> 9) * D + lane * 16; \
        Ba = *(const GAS u32x4*)(p_); Bb = *(const GAS u32x4*)(p_ + 1024); } while (0)
        {
            f32x2 xr0[16], xr1[16];
#define SW_LDX(XR, t) do { _Pragma("unroll") for (int i = 0; i < 2; ++i) _Pragma("unroll") for (int q = 0; q < 4; ++q) { \
                const f32x4 t4 = *(const GAS f32x4*)((const GAS float*)X + (size_t)(row0 + t) * D + i * 1024 + lane * 16 + 4 * q); \
                XR[8 * i + 2 * q] = f32x2{t4[0], t4[1]}; XR[8 * i + 2 * q + 1] = f32x2{t4[2], t4[3]}; } } while (0)
            __builtin_amdgcn_sched_barrier(0); SW_LDX(xr0, 0); SW_LDX(xr1, 1); __builtin_amdgcn_sched_barrier(0);
            u32x4 a0, b0, a1, b1, a2, b2, a3, b3;
            SW_LOAD(a0, b0, Ug, 0); SW_LOAD(a1, b1, Ug, 1); SW_LOAD(a2, b2, Ug, 2); SW_LOAD(a3, b3, Ug, 3);
#define SW_UPAIR(Ba, Bb, p) do { const int key_ = SW_KEY(p); const int t_ = (key_ >> 7) & 1; float res_; \
            if (t_ == 0) SW_DOT(xr0, Ba, Bb, res_); else SW_DOT(xr1, Ba, Bb, res_); \
            part[((p) & 31) * 65 + lane] = res_; } while (0)
#pragma unroll 1
            for (int p = 0; p < 256; p += 4) {
                SW_UPAIR(a0, b0, p);     if (p + 4 < 256) SW_LOAD(a0, b0, Ug, p + 4);
                SW_UPAIR(a1, b1, p + 1); if (p + 5 < 256) SW_LOAD(a1, b1, Ug, p + 5);
                SW_UPAIR(a2, b2, p + 2); if (p + 6 < 256) SW_LOAD(a2, b2, Ug, p + 6);
                SW_UPAIR(a3, b3, p + 3); if (p + 7 < 256) SW_LOAD(a3, b3, Ug, p + 7);
                if ((p & 31) == 28) {
                    const int q = lane & 31, hf = lane >> 5;
                    float sum = 0.f;
#pragma unroll
                    for (int kk = 0; kk < 32; ++kk) sum += part[q * 65 + 32 * hf + kk];
                    { auto rr = __builtin_amdgcn_permlane32_swap(__float_as_uint(sum), __float_as_uint(sum), false, false); sum = __uint_as_float(rr[0]) + __uint_as_float(rr[1]); }
                    const int pp = (p - 28) + q, kq = keys[pp], iq = kq >> 9;
                    const float gq = G[(size_t)(row0 + ((kq >> 7) & 1)) * 128 + (kq & 127)];
                    const float wq = gq * gelu_tanh(sum * SU[iq]) * SV[iq];
                    if (hf == 0) wbuf[pp] = wq;
                }
            }
#undef SW_UPAIR
#undef SW_LDX
        }
        f32x2 ac0[16], ac1[16];
#pragma unroll
        for (int k = 0; k < 16; ++k) { ac0[k] = f32x2{0.f, 0.f}; ac1[k] = f32x2{0.f, 0.f}; }
        {
            u32x4 a0, b0, a1, b1, a2, b2, a3, b3;
            SW_LOAD(a0, b0, Vg, 0); SW_LOAD(a1, b1, Vg, 1); SW_LOAD(a2, b2, Vg, 2); SW_LOAD(a3, b3, Vg, 3);
#define SW_VPAIR(Ba, Bb, p) do { const int key_ = SW_KEY(p); const int t_ = (key_ >> 7) & 1; \
            const unsigned wu_ = (unsigned)__builtin_amdgcn_readfirstlane((int)__float_as_uint(wbuf[p])); const unsigned long long wp_ = ((unsigned long long)wu_ << 32) | wu_; \
            if (t_ == 0) SW_ACC(ac0, Ba, Bb, wp_); else SW_ACC(ac1, Ba, Bb, wp_); } while (0)
#pragma unroll 1
            for (int p = 0; p < 256; p += 4) {
                SW_VPAIR(a0, b0, p);     if (p + 4 < 256) SW_LOAD(a0, b0, Vg, p + 4);
                SW_VPAIR(a1, b1, p + 1); if (p + 5 < 256) SW_LOAD(a1, b1, Vg, p + 5);
                SW_VPAIR(a2, b2, p + 2); if (p + 6 < 256) SW_LOAD(a2, b2, Vg, p + 6);
                SW_VPAIR(a3, b3, p + 3); if (p + 7 < 256) SW_LOAD(a3, b3, Vg, p + 7);
            }
#undef SW_VPAIR
        }
#define SW_LN(AC, t) do { asm volatile("" : "+v"(lane)); const int row = row0 + t; float s1 = 0.f; \
            _Pragma("unroll") for (int i = 0; i < 2; ++i) _Pragma("unroll") for (int q = 0; q < 4; ++q) { \
                const f32x4 t4 = *(const GAS f32x4*)((const GAS float*)X + (size_t)row * D + i * 1024 + lane * 16 + 4 * q); \
                AC[8 * i + 2 * q][0] = fmaf(ALPHA, t4[0], AC[8 * i + 2 * q][0]); AC[8 * i + 2 * q][1] = fmaf(ALPHA, t4[1], AC[8 * i + 2 * q][1]); \
                AC[8 * i + 2 * q + 1][0] = fmaf(ALPHA, t4[2], AC[8 * i + 2 * q + 1][0]); AC[8 * i + 2 * q + 1][1] = fmaf(ALPHA, t4[3], AC[8 * i + 2 * q + 1][1]); } \
            _Pragma("unroll") for (int k = 0; k < 16; ++k) s1 += AC[k][0] + AC[k][1]; \
            const float mu = wsum(s1) * (1.f / D); float s2 = 0.f; \
            _Pragma("unroll") for (int k = 0; k < 16; ++k) { const float d0 = AC[k][0] - mu, d1 = AC[k][1] - mu; s2 = fmaf(d0, d0, s2); s2 = fmaf(d1, d1, s2); } \
            const float rstd = rsqrtf(wsum(s2) * (1.f / D) + LN_EPS); \
            const float* gl_ = g; const float* bl_ = bb; asm volatile("" : "+s"(gl_), "+s"(bl_)); \
            _Pragma("unroll") for (int i = 0; i < 2; ++i) { float o[16]; \
                _Pragma("unroll") for (int q = 0; q < 4; ++q) { const int col = i * 1024 + lane * 16 + 4 * q; \
                    const f32x4 g4 = *(const GAS f32x4*)((const GAS float*)gl_ + col), b4 = *(const GAS f32x4*)((const GAS float*)bl_ + col); f32x4 o4; \
                    o4[0] = (AC[8 * i + 2 * q][0] - mu) * rstd * g4[0] + b4[0]; o4[1] = (AC[8 * i + 2 * q][1] - mu) * rstd * g4[1] + b4[1]; \
                    o4[2] = (AC[8 * i + 2 * q + 1][0] - mu) * rstd * g4[2] + b4[2]; o4[3] = (AC[8 * i + 2 * q + 1][1] - mu) * rstd * g4[3] + b4[3]; \
                    o[4 * q] = o4[0]; o[4 * q + 1] = o4[1]; o[4 * q + 2] = o4[2]; o[4 * q + 3] = o4[3]; \
                    *(GAS f32x4*)((GAS float*)dst + (size_t)row * D + col) = o4; } \
                *(GAS u32x4*)((GAS bf16_t*)xbout + (size_t)row * D + i * 1024 + lane * 16) = u32x4{cvtpk(o[0], o[1]), cvtpk(o[2], o[3]), cvtpk(o[4], o[5]), cvtpk(o[6], o[7])}; \
                *(GAS u32x4*)((GAS bf16_t*)xbout + (size_t)row * D + i * 1024 + lane * 16 + 8) = u32x4{cvtpk(o[8], o[9]), cvtpk(o[10], o[11]), cvtpk(o[12], o[13]), cvtpk(o[14], o[15])}; } } while (0)
        __builtin_amdgcn_sched_barrier(0); SW_LN(ac0, 0); __builtin_amdgcn_sched_barrier(0); SW_LN(ac1, 1); __builtin_amdgcn_sched_barrier(0);
#undef SW_LN
#undef SW_LOAD
#undef SW_KEY
    }
}

struct ColGate { __device__ __forceinline__ int operator()(int n) const { return n < 8 ? 3072 + n : -1; } };
struct ColKpe  { __device__ __forceinline__ int operator()(int n) const { return 1024 + n; } };
template <int NB_, int MODE>
__device__ __forceinline__ void skinny_mfma(const bf16_t* __restrict__ Xb, const bf16_t* __restrict__ Ws, float* __restrict__ GL,
                                            const float2* __restrict__ R64, bf16_t* __restrict__ km, float* __restrict__ tot_out = nullptr, const float* __restrict__ bfg = nullptr) {
    extern __shared__ __attribute__((aligned(16))) unsigned char sk_lds[];
    const int tid_ = opaque_tid(); const int wave = tid_ >> 6, lane = tid_ & 63, c = lane & 31, hi = lane >> 5;
    float* part = (float*)sk_lds;
    for (int tile = blockIdx.x; tile < T / 32; tile += NBLK) {
        const int tok = tile * 32 + c;
        f32x16 acc[NB_];
#pragma unroll
        for (int nb = 0; nb < NB_; ++nb)
#pragma unroll
            for (int r = 0; r < 16; ++r) acc[nb][r] = 0.f;
        const GAS bf16_t* xp = (const GAS bf16_t*)Xb + (size_t)tok * D + wave * 256 + 8 * hi;
        const GAS bf16_t* wp = (const GAS bf16_t*)Ws + (size_t)c * D + wave * 256 + 8 * hi;
#pragma unroll
        for (int s = 0; s < 16; ++s) {
            const bf16x8 xf = *(const GAS bf16x8*)(xp + 16 * s);
#pragma unroll
            for (int nb = 0; nb < NB_; ++nb)
                acc[nb] = __builtin_amdgcn_mfma_f32_32x32x16_bf16(*(const GAS bf16x8*)(wp + (size_t)nb * 32 * D + 16 * s), xf, acc[nb], 0, 0, 0);
        }
        if (wave != 0) {
#pragma unroll
            for (int nb = 0; nb < NB_; ++nb)
#pragma unroll
                for (int r = 0; r < 16; ++r) part[((wave * NB_ + nb) * 16 + r) * 64 + lane] = acc[nb][r];
        }
        __syncthreads();
        if (wave == 0) {
#pragma unroll 1
            for (int w = 1; w < 8; ++w)
#pragma unroll
                for (int nb = 0; nb < NB_; ++nb)
#pragma unroll
                    for (int r = 0; r < 16; ++r) acc[nb][r] += part[((w * NB_ + nb) * 16 + r) * 64 + lane];
            if (MODE == 0) {
                const int sq = tok & 4095, b = tok >> 12;
                float ls[4];
#pragma unroll
                for (int e = 0; e < 4; ++e) { const float z = acc[0][e] + bfg[4 * hi + e]; ls[e] = fminf(z, 0.f) - log1pf(expf(-fabsf(z))); }
#pragma unroll
                for (int d_ = 1; d_ < 32; d_ <<= 1)
#pragma unroll
                    for (int e = 0; e < 4; ++e) {
                        const float t_ = __int_as_float(__builtin_amdgcn_ds_bpermute((lane - d_) * 4, __float_as_int(ls[e])));
                        if (c >= d_) ls[e] += t_;
                    }
#pragma unroll
                for (int e = 0; e < 4; ++e) {
                    GL[(size_t)(b * 8 + 4 * hi + e) * S + sq] = ls[e] * LOG2E;
                    if (c == 31) tot_out[(b * 8 + 4 * hi + e) * 128 + (sq >> 5)] = ls[e] * LOG2E;
                }
            } else {
                const int sq = tok & 4095, b = tok >> 12;
#pragma unroll
                for (int gq = 0; gq < 4; ++gq) {
                    float o1[4], o2[4];
#pragma unroll
                    for (int e = 0; e < 4; ++e) {
                        const int i = 4 * hi + 8 * gq + e;
                        const float2 cs = R64[sq * 32 + i];
                        const float x1 = acc[0][4 * gq + e], x2 = acc[NB_ - 1][4 * gq + e];
                        o1[e] = x1 * cs.x - x2 * cs.y; o2[e] = x2 * cs.x + x1 * cs.y;
                    }
                    const u32x2 p1 = u32x2{cvtpk(o1[0], o1[1]), cvtpk(o1[2], o1[3])}, p2 = u32x2{cvtpk(o2[0], o2[1]), cvtpk(o2[2], o2[3])};
#pragma unroll
                    for (int h = 0; h < 8; ++h) {
                        GAS bf16_t* kp = (GAS bf16_t*)km + ((size_t)(b * 8 + h) * S + sq) * 192 + 128 + 4 * hi + 8 * gq;
                        *(GAS u32x2*)kp = p1; *(GAS u32x2*)(kp + 32) = p2;
                    }
                }
            }
        }
        __syncthreads();
    }
}

struct EpiBf16 {
    bf16_t* C; int ldc;
    __device__ __forceinline__ void operator()(const f32x4 (&acc)[2][2][4][2], int brow, int bcol, int wr, int wc, int fr, int fq) const {
#pragma unroll
        for (int ai = 0; ai < 2; ++ai)
#pragma unroll
            for (int m = 0; m < 4; ++m)
#pragma unroll
                for (int j = 0; j < 4; ++j)
#pragma unroll
                    for (int bj = 0; bj < 2; ++bj)
                        *(GAS unsigned*)(C + (size_t)(brow + ai * 128 + wr * 64 + m * 16 + fq * 4 + j) * ldc + bcol + bj * 128 + wc * 32 + 2 * fr) = cvtpk(acc[ai][bj][m][0][j], acc[ai][bj][m][1][j]);
    }
};
template <int N, int M> __device__ __forceinline__ void rs_step(const float (&in)[N], float (&out)[N / 2], bool hb) {
#pragma unroll
    for (int k = 0; k < N / 2; ++k) { const float keep = hb ? in[N / 2 + k] : in[k], send = hb ? in[k] : in[N / 2 + k]; out[k] = keep + swz_xor<M>(send); }
}
template <bool XIN_F32>
struct EpiLnResT {
    const float* Xin; float* X; bf16_t* Xb; const float* g; const float* b; unsigned long long* stats; unsigned* cnt; unsigned* tmo;
    __device__ __forceinline__ void operator()(f32x4 (&acc)[2][2][4][2], int brow, int bcol, int wr, int wc, int fr, int fq) const {
        extern __shared__ __attribute__((aligned(16))) unsigned char e_lds[];
        GAS float* Xg = (GAS float*)X; const GAS float* Xi = (const GAS float*)Xin;
#pragma unroll
        for (int ai = 0; ai < 2; ++ai)
#pragma unroll
            for (int m = 0; m < 4; ++m)
#pragma unroll
                for (int j = 0; j < 4; ++j)
#pragma unroll
                    for (int bj = 0; bj < 2; ++bj) {
                        f32x2 xv;
                        if (!XIN_F32) { const unsigned w_ = *(const GAS unsigned*)((const GAS bf16_t*)Xb + (size_t)(brow + ai * 128 + wr * 64 + m * 16 + fq * 4 + j) * D + bcol + bj * 128 + wc * 32 + 2 * fr);
                                                          xv = f32x2{__uint_as_float(w_ << 16), __uint_as_float(w_ & 0xffff0000u)}; }
                        else xv = *(const GAS f32x2*)(Xi + (size_t)(brow + ai * 128 + wr * 64 + m * 16 + fq * 4 + j) * D + bcol + bj * 128 + wc * 32 + 2 * fr);
                        acc[ai][bj][m][0][j] = fmaf(ALPHA, xv[0], acc[ai][bj][m][0][j]); acc[ai][bj][m][1][j] = fmaf(ALPHA, xv[1], acc[ai][bj][m][1][j]);
                    }
        float s2[2], q2[2];
        {
            float s[32], q[32];
#pragma unroll
            for (int ai = 0; ai < 2; ++ai)
#pragma unroll
                for (int m = 0; m < 4; ++m)
#pragma unroll
                    for (int j = 0; j < 4; ++j) {
                        const float a0 = acc[ai][0][m][0][j], a1 = acc[ai][0][m][1][j], a2 = acc[ai][1][m][0][j], a3 = acc[ai][1][m][1][j];
                        s[(ai * 4 + m) * 4 + j] = (a0 + a1) + (a2 + a3); q[(ai * 4 + m) * 4 + j] = fmaf(a0, a0, fmaf(a1, a1, fmaf(a2, a2, a3 * a3)));
                    }
            float s16[16], q16[16], s8[8], q8[8], s4[4], q4[4];
            rs_step<32, 8>(s, s16, (fr & 8) != 0); rs_step<32, 8>(q, q16, (fr & 8) != 0);
            rs_step<16, 4>(s16, s8, (fr & 4) != 0); rs_step<16, 4>(q16, q8, (fr & 4) != 0);
            rs_step<8, 2>(s8, s4, (fr & 2) != 0); rs_step<8, 2>(q8, q4, (fr & 2) != 0);
            rs_step<4, 1>(s4, s2, (fr & 1) != 0); rs_step<4, 1>(q4, q2, (fr & 1) != 0);
        }
#pragma unroll
        for (int k = 0; k < 2; ++k) {
            const int R = (fr >> 3) * 128 + wr * 64 + ((fr >> 1) & 3) * 16 + fq * 4 + 2 * (fr & 1) + k;
            *(LAS f32x2*)((LAS unsigned char*)e_lds + (R * 4 + wc) * 8) = f32x2{s2[k], q2[k]};
        }
        __syncthreads();
        const int tid = (wr * 4 + wc) * 64 + fq * 16 + fr;
        GAS unsigned long long* sg = (GAS unsigned long long*)stats + (size_t)(brow + (tid & 255)) * 8;
        if (tid < 256) {
            const f32x4 a = *(const LAS f32x4*)((LAS unsigned char*)e_lds + tid * 32), c = *(const LAS f32x4*)((LAS unsigned char*)e_lds + tid * 32 + 16);
            const float S = (a[0] + a[2]) + (c[0] + c[2]), Q = (a[1] + a[3]) + (c[1] + c[3]);
            __hip_atomic_store(sg + (bcol >> 8), ((unsigned long long)__float_as_uint(Q) << 32) | (unsigned long long)__float_as_uint(S), __ATOMIC_RELAXED, __HIP_MEMORY_SCOPE_AGENT);
        }
        asm volatile("s_waitcnt vmcnt(0)" ::: "memory");
        __syncthreads();
        if (tid == 0) {
            unsigned* c_ = cnt + (brow >> 8) * 16;
            (void)xb_add(c_, 1u);
            unsigned sp = 0;
            while (xb_ld(c_) < 8u) {
                __builtin_amdgcn_s_sleep(1);
                if ((++sp & 255u) == 0u) { if (xb_ld(tmo)) break; if (sp > XB_SPIN_CAP) { atomicAdd(tmo, 1u); break; } }
            }
        }
        __syncthreads();
        if (tid < 256) {
            float S = 0.f, Q = 0.f;
#pragma unroll
            for (int c = 0; c < 8; ++c) {
                const unsigned long long v = __hip_atomic_load(sg + c, __ATOMIC_RELAXED, __HIP_MEMORY_SCOPE_AGENT);
                S += __uint_as_float((unsigned)v); Q += __uint_as_float((unsigned)(v >> 32));
            }
            const float mu = S * (1.f / D), var = fmaxf(Q * (1.f / D) - mu * mu, 0.f);
            *(LAS f32x2*)((LAS unsigned char*)e_lds + 8192 + tid * 8) = f32x2{mu, rsqrtf(var + LN_EPS)};
        }
        __syncthreads();
        f32x2 g2[2], b2[2];
#pragma unroll
        for (int bj = 0; bj < 2; ++bj) {
            g2[bj] = *(const GAS f32x2*)((const GAS float*)g + bcol + bj * 128 + wc * 32 + 2 * fr);
            b2[bj] = *(const GAS f32x2*)((const GAS float*)b + bcol + bj * 128 + wc * 32 + 2 * fr);
        }
#pragma unroll
        for (int ai = 0; ai < 2; ++ai)
#pragma unroll
            for (int m = 0; m < 4; ++m)
#pragma unroll
                for (int j = 0; j < 4; ++j) {
                    const int R = ai * 128 + wr * 64 + m * 16 + fq * 4 + j;
                    const f32x2 mr = *(const LAS f32x2*)((LAS unsigned char*)e_lds + 8192 + R * 8);
#pragma unroll
                    for (int bj = 0; bj < 2; ++bj) {
                        const float o0 = (acc[ai][bj][m][0][j] - mr[0]) * mr[1] * g2[bj][0] + b2[bj][0], o1 = (acc[ai][bj][m][1][j] - mr[0]) * mr[1] * g2[bj][1] + b2[bj][1];
                        const size_t off = (size_t)(brow + R) * D + bcol + bj * 128 + wc * 32 + 2 * fr;
                        if (!RES_BF16) *(GAS f32x2*)(Xg + off) = f32x2{o0, o1};
                        *(GAS unsigned*)((GAS bf16_t*)Xb + off) = cvtpk(o0, o1);
                    }
                }
    }
};
template <int MASK> __device__ __forceinline__ int f2key(float f, int payload) { int b = __float_as_int(f); b ^= (b >> 31) & 0x7fffffff; return (b & ~MASK) | payload; }
template <int MASK> __device__ __forceinline__ float key2f(int k) { int b = k & ~MASK; b ^= (b >> 31) & 0x7fffffff; return __int_as_float(b); }
template <int N, int MAXSZ> __device__ __forceinline__ void bitonic_blocks(int (&k)[N]) {
#pragma unroll
    for (int size = 2; size <= MAXSZ; size <<= 1)
#pragma unroll
        for (int stride = size >> 1; stride > 0; stride >>= 1)
#pragma unroll
            for (int i = 0; i < N; ++i) {
                const int j = i ^ stride;
                if (j > i) { const bool desc = ((i & size) == 0); const int a = k[i], b = k[j], mx = imax(a, b), mn = imin(a, b); k[i] = desc ? mx : mn; k[j] = desc ? mn : mx; }
            }
}
template <bool DESC> __device__ __forceinline__ void bitonic_sort16(int (&k)[16]) {
#pragma unroll
    for (int size = 2; size <= 16; size <<= 1)
#pragma unroll
        for (int stride = size >> 1; stride > 0; stride >>= 1)
#pragma unroll
            for (int i = 0; i < 16; ++i) {
                const int j = i ^ stride;
                if (j > i) { const bool dd = (((i & size) == 0) == DESC);
                             const int a = k[i], b = k[j], mx = imax(a, b), mn = imin(a, b); k[i] = dd ? mx : mn; k[j] = dd ? mn : mx; }
            }
}
template <bool DESC> __device__ __forceinline__ void bitonic_merge16(int (&k)[16]) {
#pragma unroll
    for (int stride = 8; stride > 0; stride >>= 1)
#pragma unroll
        for (int i = 0; i < 16; ++i) {
            const int j = i ^ stride;
            if (j > i) { const int a = k[i], b = k[j], mx = imax(a, b), mn = imin(a, b); k[i] = DESC ? mx : mn; k[j] = DESC ? mn : mx; }
        }
}
__device__ __forceinline__ void partner_merge16(int (&k)[16], int hi) {
    int pr[16];
#pragma unroll
    for (int i = 0; i < 16; ++i) { auto rr = __builtin_amdgcn_permlane32_swap((unsigned)k[i], (unsigned)k[i], false, false); pr[i] = hi ? (int)rr[0] : (int)rr[1]; }
#pragma unroll
    for (int i = 0; i < 16; ++i) k[i] = imax(k[i], pr[15 - i]);
    bitonic_merge16<true>(k);
}
__device__ __forceinline__ void route_mfma(const bf16_t* __restrict__ PQb, const bf16_t* __restrict__ SKb, int* __restrict__ IDX, float* __restrict__ G) {
    extern __shared__ __attribute__((aligned(16))) unsigned char r_lds[];
    const int tid_ = opaque_tid(); const int h = tid_ >> 6, lane = tid_ & 63, c = lane & 31, hi = lane >> 5;
    unsigned char* myslot = r_lds + (size_t)tid_ * 32;
    for (int tile = blockIdx.x; tile < T / 32; tile += NBLK) {
        const int tok = tile * 32 + c;
        int sv[2][16];
#pragma unroll
        for (int p = 0; p < 2; ++p) {
            const GAS bf16_t* qp = (const GAS bf16_t*)PQb + (size_t)tok * D + h * 256 + p * 128 + 8 * hi;
            const GAS bf16_t* kp = (const GAS bf16_t*)SKb + ((size_t)(h * 2 + p) * 128 + c) * 128 + 8 * hi;
            bf16x8 qf[8];
#pragma unroll
            for (int s = 0; s < 8; ++s) qf[s] = *(const GAS bf16x8*)(qp + 16 * s);
            int t0[16];
#pragma unroll
            for (int i = 0; i < 16; ++i) t0[i] = (int)0x80000000;
#pragma unroll 1
            for (int blk = 0; blk < 4; ++blk) {
                f32x16 acc;
#pragma unroll
                for (int r = 0; r < 16; ++r) acc[r] = 0.f;
#pragma unroll
                for (int s = 0; s < 8; ++s)
                    acc = __builtin_amdgcn_mfma_f32_32x32x16_bf16(*(const GAS bf16x8*)(kp + (size_t)blk * 32 * 128 + 16 * s), qf[s], acc, 0, 0, 0);
                int nk[16];
                const int pay = (32 * blk) | (hi << 2);
#pragma unroll
                for (int r = 0; r < 16; ++r) nk[r] = f2key<0x7f>(acc[r], pay | ((r & 3) + 8 * (r >> 2)));
                bitonic_sort16<false>(nk);
#pragma unroll
                for (int i = 0; i < 16; ++i) t0[i] = imax(t0[i], nk[i]);
                bitonic_merge16<true>(t0);
            }
            partner_merge16(t0, hi);
#pragma unroll
            for (int i = 0; i < 16; ++i) sv[p][i] = t0[i];
#pragma unroll
            for (int q4 = 0; q4 < 4; ++q4)
                *(unsigned*)(myslot + p * 16 + q4 * 4) = (unsigned)(t0[4 * q4] & 0x7f) | ((unsigned)(t0[4 * q4 + 1] & 0x7f) << 8) | ((unsigned)(t0[4 * q4 + 2] & 0x7f) << 16) | ((unsigned)(t0[4 * q4 + 3] & 0x7f) << 24);
        }
        float f0[16], f1[16];
#pragma unroll
        for (int i = 0; i < 16; ++i) { f0[i] = key2f<0x7f>(sv[0][i]); f1[i] = key2f<0x7f>(sv[1][i]); }
        int cd[32];
        {
            constexpr int PA[50] = {0,0,0,0,0,0,0,0,0,0,0,0,0,0,0,0, 1,1,1,1,1,1,1,1, 2,2,2,2,2, 3,3,3,3, 4,4,4, 5,5, 6,6, 7,7, 8,9,10,11,12,13,14,15};
            constexpr int PB[50] = {0,1,2,3,4,5,6,7,8,9,10,11,12,13,14,15, 0,1,2,3,4,5,6,7, 0,1,2,3,4, 0,1,2,3, 0,1,2, 0,1, 0,1, 0,1, 0,0,0,0,0,0,0,0};
#pragma unroll
            for (int q = 0; q < 25; ++q) {
                const int a0 = PA[2 * q], b0 = PB[2 * q], a1 = PA[2 * q + 1], b1 = PB[2 * q + 1];
                const float s0 = f0[a0] + f1[b0], s1 = f0[a1] + f1[b1];
                cd[q] = hi ? f2key<0xff>(s1, a1 * 16 + b1) : f2key<0xff>(s0, a0 * 16 + b0);
            }
#pragma unroll
            for (int q = 25; q < 32; ++q) cd[q] = (int)0x80000000;
        }
        bitonic_blocks<32, 16>(cd);
        int top[16];
#pragma unroll
        for (int i = 0; i < 16; ++i) top[i] = imax(cd[i], cd[16 + i]);
        bitonic_merge16<true>(top);
        partner_merge16(top, hi);
        float e[16]; float sum = 0.f;
        const float mx = key2f<0xff>(top[0]);
#pragma unroll
        for (int i = 0; i < 16; ++i) { e[i] = __expf(key2f<0xff>(top[i]) - mx); sum += e[i]; }
        const float inv = 1.f / sum;
        if (hi == 0) {
            int id[16];
#pragma unroll
            for (int i = 0; i < 16; ++i) { const int cc = top[i] & 0xff; id[i] = (int)myslot[cc >> 4] * 128 + (int)myslot[16 + (cc & 15)]; }
#pragma unroll
            for (int q4 = 0; q4 < 4; ++q4)
                *(GAS u32x4*)((GAS int*)IDX + (size_t)tok * 128 + h * 16 + 4 * q4) = u32x4{(unsigned)id[4 * q4], (unsigned)id[4 * q4 + 1], (unsigned)id[4 * q4 + 2], (unsigned)id[4 * q4 + 3]};
        } else {
#pragma unroll
            for (int q4 = 0; q4 < 4; ++q4)
                *(GAS f32x4*)((GAS float*)G + (size_t)tok * 128 + h * 16 + 4 * q4) = f32x4{e[4 * q4] * inv, e[4 * q4 + 1] * inv, e[4 * q4 + 2] * inv, e[4 * q4 + 3] * inv};
        }
    }
}

#define KARG_U64(off) ({ unsigned long long _v; asm volatile("s_load_dwordx2 %0, %1, %2\n\ts_waitcnt lgkmcnt(0)" : "=s"(_v) : "s"(__builtin_amdgcn_kernarg_segment_ptr()), "n"(off) : "memory"); _v; })
#define KARG_U32(off) ({ unsigned _v; asm volatile("s_load_dword %0, %1, %2\n\ts_waitcnt lgkmcnt(0)" : "=s"(_v) : "s"(__builtin_amdgcn_kernarg_segment_ptr()), "n"(off) : "memory"); _v; })
#define IN(k) ((const float*)KARG_U64((k) * 8))
#define bX   ((float*)(ws + OFF_X))
#define bP   ((float*)(ws + OFF_P))
#define bQ2  ((float*)(ws + OFF_Q2))
#define bKV2 ((float*)(ws + OFF_KV2))
#define bY   ((float*)(ws + OFF_Y))
#define bPQ  ((float*)(ws + OFF_PQ))
#define bA12 ((float*)(ws + OFF_A12))
#define bR128 ((float2*)(ws + OFF_R128))
#define bR64 ((float2*)(ws + OFF_R64))
#define bIDX ((int*)(ws + OFF_IDX))
#define bG   ((float*)(ws + OFF_G))
#define bCUM ((float*)(ws + OFF_CUM))
#define bWT  ((bf16_t*)(ws + OFF_WT))
#define bXb  ((bf16_t*)(ws + OFF_XB))
#define bOb  ((bf16_t*)(ws + OFF_OB))
#define bCQb ((bf16_t*)(ws + OFF_CQB))
#define bATT ((bf16_t*)(ws + OFF_ATT))
#define bGL  ((float*)(ws + OFF_GL))
#define bCUMH ((float*)(ws + OFF_CUMH))
#define bSSQ ((float*)(ws + OFF_SSQ))
#define bKPE ((float*)(ws + OFF_KPE))
#define bUb  ((bf16_t*)(ws + OFF_UB))
#define bVb  ((bf16_t*)(ws + OFF_VB))
#define bPQb ((bf16_t*)(ws + OFF_PQB))
#define bU8  ((unsigned char*)(ws + OFF_UB))
#define bV8  ((unsigned char*)(ws + OFF_VB))
#define bSU  ((float*)(ws + OFF_SU))
#define bSV  ((float*)(ws + OFF_SV))
#define bSKb ((bf16_t*)(ws + OFF_SKB))

__global__ void __launch_bounds__(NTHR, 2) fwd_kernel(Params p_unused) {
    extern __shared__ __attribute__((aligned(16))) unsigned char lds_raw[];
    float* lds = (float*)lds_raw;
    volatile LAS unsigned* bst = (volatile LAS unsigned*)(lds_raw + LDS_BYTES - 16);
    if (threadIdx.x == 0) { bst[0] = 0u; bst[1] = 0u; bst[2] = 0u; bst[3] = 0u; }
    __syncthreads();
    const int lo = (int)KARG_U32(184), hi = (int)KARG_U32(188);
    XcdBarrier bar; bar.bar = (unsigned*)((unsigned char*)KARG_U64(176) + OFF_BAR); bar.x = 0; bar.st = bst;
    if (hi - lo > 1) bar = xcd_barrier_post(bar.bar, bst);
    constexpr int NOSPLIT = 1 << 30;

    int ph = 0;
#define PH_BEGIN if (ph >= lo && ph < hi) { unsigned char* const ws = (unsigned char*)KARG_U64(176);
#define PH_END   if (ph + 1 < hi) xcd_barrier(bar); } ++ph;

    PH_BEGIN
#pragma unroll 1
      for (int rep = 0; rep < ((PROBE == 1 || PROBE == 8 || PROBE == 9) ? 2 : 1); ++rep) {
        if (rep == 0 || PROBE == 1) { convert_rows_bf16(IN(0), bXb, (size_t)T * D); rope_tables(bR128, bR64);
        convert_rows_bf16(IN(14), bSKb, (size_t)4 * 8 * 2 * 128 * 128); }
        if (rep == 1 && PROBE == 9) {} else if (PEER_FP8 && PEER_FP4) { convert_rows_fp4(IN(15), bU8, bSU, 4 * 16384); convert_rows_fp4(IN(16), bV8, bSV, 4 * 16384); }
        else if (PEER_FP8 && PEER_FP6) { convert_rows_fp6(IN(15), bU8, bSU, 4 * 16384); convert_rows_fp6(IN(16), bV8, bSV, 4 * 16384); }
        else if (PEER_FP8) { convert_rows_fp8(IN(15), bU8, bSU, 4 * 16384); convert_rows_fp8(IN(16), bV8, bSV, 4 * 16384); }
        else { convert_rows_bf16(IN(15), bUb, (size_t)4 * 16384 * D); convert_rows_bf16(IN(16), bVb, (size_t)4 * 16384 * D); }
        int gb = 0;
        if (rep == 1 && PROBE == 8) continue;
#pragma unroll 1
        for (int i = 0; i < 2; ++i) {
            transpose_convert(IN(1) + (size_t)i * D * NEV, NEV, D, 6144, ColEven{}, nullptr, bWT + WT_EIN + (size_t)i * 6144 * 2048, gb);
            transpose_convert(IN(4) + (size_t)i * D * D, D, D, 2048, ColPair{}, nullptr, bWT + WT_EOUT + (size_t)i * 2048 * 2048, gb);
            transpose_convert(IN(5) + (size_t)i * D * NOD, NOD, D, 4096, ColOddIn{}, nullptr, bWT + WT_OIN + (size_t)i * 4096 * 2048, gb);
            transpose_convert(IN(8) + (size_t)i * 512 * 1536, 1536, 512, 1536, ColUq{}, IN(6) + i * 512, bWT + WT_UQ + (size_t)i * 1536 * 512, gb);
            transpose_convert(IN(9) + (size_t)i * 512 * 2048, 2048, 512, 2048, ColUkv{}, IN(7) + i * 512, bWT + WT_UKV + (size_t)i * 2048 * 512, gb);
            transpose_convert(IN(12) + (size_t)i * D * D, D, D, 2048, ColPair{}, nullptr, bWT + WT_OOUT + (size_t)i * 2048 * 2048, gb);
            transpose_convert(IN(1) + (size_t)i * D * NEV, NEV, D, 64, ColGate{}, nullptr, bWT + WT_GATE + (size_t)i * 64 * 2048, gb);
            transpose_convert(IN(5) + (size_t)i * D * NOD, NOD, D, 64, ColKpe{}, nullptr, bWT + WT_KPE + (size_t)i * 64 * 2048, gb);
        }
#pragma unroll 1
        for (int l = 0; l < 4; ++l)
            transpose_convert(IN(13) + (size_t)l * D * D, D, D, 2048, ColPair{}, nullptr, bWT + WT_PQ + (size_t)l * 2048 * 2048, gb);
      }
    PH_END

#pragma unroll 1
    for (int pr = 0; pr < 2; ++pr) {
        {
            const int l = 2 * pr, i = pr;
            PH_BEGIN
                gemm_phase(bXb, bWT + WT_EIN + (size_t)i * 6144 * 2048, T, 6144, D, 0, EpiEven{bATT});
                if (PROBE == 5) { __syncthreads(); gemm_phase(bXb, bWT + WT_EIN + (size_t)i * 6144 * 2048, T, 6144, D, 0, EpiEven{bATT}); }
                __syncthreads();
                skinny_mfma<1, 0>(bXb, bWT + WT_GATE + (size_t)i * 64 * 2048, bCUMH, nullptr, nullptr, bGL, IN(2) + i * 8);
            PH_END
            PH_BEGIN attn_even_phase<ATT_NAIVE>(bATT, bCUMH, IN(3) + i * 8 * 257, bOb, (unsigned*)(ws + OFF_BAR) + CTR_WORD0 + 64 * l, lds, bGL);
                     if (PROBE == 3) { __syncthreads(); attn_even_phase<ATT_NAIVE>(bATT, bCUMH, IN(3) + i * 8 * 257, bOb, (unsigned*)(ws + OFF_BAR) + CTR_WORD0 + 64 * l + 8, lds, bGL); } PH_END
            PH_BEGIN if (l == 0) { gemm_phase(bOb, bWT + WT_EOUT + (size_t)i * 2048 * 2048, T, 2048, D, 0,
                                EpiLnResT<true>{IN(0), bX, bXb, IN(17) + l * D, IN(18) + l * D, (unsigned long long*)(ws + OFF_LNS) + (size_t)l * T * 8,
                                         (unsigned*)(ws + OFF_BAR) + LNC_WORD0 + l * 512, (unsigned*)(ws + OFF_BAR) + XB_TMO}); } else { gemm_phase(bOb, bWT + WT_EOUT + (size_t)i * 2048 * 2048, T, 2048, D, 0,
                                EpiLnResT<!RES_BF16>{bX, bX, bXb, IN(17) + l * D, IN(18) + l * D, (unsigned long long*)(ws + OFF_LNS) + (size_t)l * T * 8,
                                         (unsigned*)(ws + OFF_BAR) + LNC_WORD0 + l * 512, (unsigned*)(ws + OFF_BAR) + XB_TMO}); } PH_END
            PH_BEGIN gemm_phase(bXb, bWT + WT_PQ + (size_t)l * 2048 * 2048, T, 2048, D, 0, EpiBf16{bPQb, D});
                     if (PROBE == 6) { __syncthreads(); gemm_phase(bXb, bWT + WT_PQ + (size_t)l * 2048 * 2048, T, 2048, D, 0, EpiBf16{bPQb, D}); } PH_END
            PH_BEGIN route_mfma(bPQb, bSKb + (size_t)l * 8 * 2 * 128 * 128, bIDX, bG);
                asm volatile("s_waitcnt vmcnt(0)" ::: "memory"); __builtin_amdgcn_fence(__ATOMIC_RELEASE, "workgroup"); __syncthreads(); __builtin_amdgcn_fence(__ATOMIC_ACQUIRE, "workgroup");
                if (PROBE == 2) peer_gather_f4(bX, bIDX, bG, bU8 + (size_t)l * 16384 * F4_ROW, bV8 + (size_t)l * 16384 * F4_ROW, bSU + l * 16384, bSV + l * 16384,
                                             IN(19) + l * D, IN(20) + l * D, bY, bPQb);
                if (PEER_FP8 && PEER_SWEEP) peer_gather_sweep(bX, bIDX, bG, bU8 + (size_t)l * 16384 * D, bV8 + (size_t)l * 16384 * D, bSU + l * 16384, bSV + l * 16384,
                                             IN(19) + l * D, IN(20) + l * D, bX, bXb);
                else if (PEER_FP8 && PEER_FP4 && PEER_SPLIT && PEER_PIPE) peer_gather_f4p(bX, bIDX, bG, bU8 + (size_t)l * 16384 * F4_ROW, bV8 + (size_t)l * 16384 * F4_ROW, bSU + l * 16384, bSV + l * 16384,
                                             IN(19) + l * D, IN(20) + l * D, RES_BF16 ? (float*)nullptr : bX, bXb);
                else if (PEER_FP8 && PEER_FP4 && PEER_SPLIT) peer_gather_f4s(bX, bIDX, bG, bU8 + (size_t)l * 16384 * F4_ROW, bV8 + (size_t)l * 16384 * F4_ROW, bSU + l * 16384, bSV + l * 16384,
                                             IN(19) + l * D, IN(20) + l * D, bX, bXb);
                else if (PEER_FP8 && PEER_FP4) peer_gather_f4(bX, bIDX, bG, bU8 + (size_t)l * 16384 * F4_ROW, bV8 + (size_t)l * 16384 * F4_ROW, bSU + l * 16384, bSV + l * 16384,
                                             IN(19) + l * D, IN(20) + l * D, bX, bXb);
                else if (PEER_FP8 && PEER_FP6) peer_gather_f6(bX, bIDX, bG, bU8 + (size_t)l * 16384 * F6_ROW, bV8 + (size_t)l * 16384 * F6_ROW, bSU + l * 16384, bSV + l * 16384,
                                             IN(19) + l * D, IN(20) + l * D, bX, bXb);
                else if (PEER_FP8) peer_gather_f8(bX, bIDX, bG, bU8 + (size_t)l * 16384 * D, bV8 + (size_t)l * 16384 * D, bSU + l * 16384, bSV + l * 16384,
                                             IN(19) + l * D, IN(20) + l * D, bX, bXb);
                else peer_gather_b(bX, bXb, bIDX, bG, bUb + (size_t)l * 16384 * D, bVb + (size_t)l * 16384 * D, IN(19) + l * D, IN(20) + l * D, bX, bXb);
            PH_END
        }
        {
            const int l = 2 * pr + 1, i = pr;
            PH_BEGIN
                gemm_phase(bXb, bWT + WT_OIN + (size_t)i * 4096 * 2048, T, 4096, D, 0, EpiOddIn{bCQb, bSSQ, bATT, bR128});
                if (PROBE == 5) { __syncthreads(); gemm_phase(bXb, bWT + WT_OIN + (size_t)i * 4096 * 2048, T, 4096, D, 0, EpiOddIn{bCQb, bSSQ, bATT, bR128}); }
                __syncthreads();
                skinny_mfma<2, 1>(bXb, bWT + WT_KPE + (size_t)i * 64 * 2048, nullptr, bR64, bATT + MHSZ);
            PH_END
            PH_BEGIN
                gemm_phase(bCQb, bWT + WT_UQ + (size_t)i * 1536 * 512, T, 1536, 512, 0, EpiUq{bSSQ, bATT, bR64});
                gemm_phase(bCQb + (size_t)T * 512, bWT + WT_UKV + (size_t)i * 2048 * 512, T, 2048, 512, 192, EpiUkv{bSSQ + (size_t)T * 8, bATT + MHSZ, bATT + 2 * MHSZ});
            PH_END
            PH_BEGIN attn_odd_phase(bATT, bOb, bA12, (unsigned*)(ws + OFF_BAR) + CTR_WORD0 + 64 * l);
                     if (PROBE == 4) { __syncthreads(); attn_odd_phase(bATT, bOb, bA12, (unsigned*)(ws + OFF_BAR) + CTR_WORD0 + 64 * l + 8); } PH_END
            PH_BEGIN diff_combine_naive(bA12, IN(10) + i * 512, IN(11) + i * 256, 0.8f - 0.6f * expf(-0.3f * (float)l), bOb); PH_END
            PH_BEGIN gemm_phase(bOb, bWT + WT_OOUT + (size_t)i * 2048 * 2048, T, 2048, D, 0,
                                EpiLnResT<!RES_BF16>{bX, bX, bXb, IN(17) + l * D, IN(18) + l * D, (unsigned long long*)(ws + OFF_LNS) + (size_t)l * T * 8,
                                         (unsigned*)(ws + OFF_BAR) + LNC_WORD0 + l * 512, (unsigned*)(ws + OFF_BAR) + XB_TMO}); PH_END
            PH_BEGIN gemm_phase(bXb, bWT + WT_PQ + (size_t)l * 2048 * 2048, T, 2048, D, 0, EpiBf16{bPQb, D});
                     if (PROBE == 6) { __syncthreads(); gemm_phase(bXb, bWT + WT_PQ + (size_t)l * 2048 * 2048, T, 2048, D, 0, EpiBf16{bPQb, D}); } PH_END
            PH_BEGIN route_mfma(bPQb, bSKb + (size_t)l * 8 * 2 * 128 * 128, bIDX, bG);
                asm volatile("s_waitcnt vmcnt(0)" ::: "memory"); __builtin_amdgcn_fence(__ATOMIC_RELEASE, "workgroup"); __syncthreads(); __builtin_amdgcn_fence(__ATOMIC_ACQUIRE, "workgroup");
                if (PROBE == 2) peer_gather_f4(bX, bIDX, bG, bU8 + (size_t)l * 16384 * F4_ROW, bV8 + (size_t)l * 16384 * F4_ROW, bSU + l * 16384, bSV + l * 16384,
                                             IN(19) + l * D, IN(20) + l * D, bY, bPQb);
                if (PEER_FP8 && PEER_SWEEP) peer_gather_sweep(bX, bIDX, bG, bU8 + (size_t)l * 16384 * D, bV8 + (size_t)l * 16384 * D, bSU + l * 16384, bSV + l * 16384,
                                             IN(19) + l * D, IN(20) + l * D, (l == 3) ? (float*)KARG_U64(168) : bX, bXb);
                else if (PEER_FP8 && PEER_FP4 && PEER_SPLIT && PEER_PIPE) peer_gather_f4p(bX, bIDX, bG, bU8 + (size_t)l * 16384 * F4_ROW, bV8 + (size_t)l * 16384 * F4_ROW, bSU + l * 16384, bSV + l * 16384,
                                             IN(19) + l * D, IN(20) + l * D, (l == 3) ? (float*)KARG_U64(168) : (RES_BF16 ? (float*)nullptr : bX), bXb);
                else if (PEER_FP8 && PEER_FP4 && PEER_SPLIT) peer_gather_f4s(bX, bIDX, bG, bU8 + (size_t)l * 16384 * F4_ROW, bV8 + (size_t)l * 16384 * F4_ROW, bSU + l * 16384, bSV + l * 16384,
                                             IN(19) + l * D, IN(20) + l * D, (l == 3) ? (float*)KARG_U64(168) : bX, bXb);
                else if (PEER_FP8 && PEER_FP4) peer_gather_f4(bX, bIDX, bG, bU8 + (size_t)l * 16384 * F4_ROW, bV8 + (size_t)l * 16384 * F4_ROW, bSU + l * 16384, bSV + l * 16384,
                                             IN(19) + l * D, IN(20) + l * D, (l == 3) ? (float*)KARG_U64(168) : bX, bXb);
                else if (PEER_FP8 && PEER_FP6) peer_gather_f6(bX, bIDX, bG, bU8 + (size_t)l * 16384 * F6_ROW, bV8 + (size_t)l * 16384 * F6_ROW, bSU + l * 16384, bSV + l * 16384,
                                             IN(19) + l * D, IN(20) + l * D, (l == 3) ? (float*)KARG_U64(168) : bX, bXb);
                else if (PEER_FP8) peer_gather_f8(bX, bIDX, bG, bU8 + (size_t)l * 16384 * D, bV8 + (size_t)l * 16384 * D, bSU + l * 16384, bSV + l * 16384,
                                             IN(19) + l * D, IN(20) + l * D, (l == 3) ? (float*)KARG_U64(168) : bX, bXb);
                else peer_gather_b(bX, bXb, bIDX, bG, bUb + (size_t)l * 16384 * D, bVb + (size_t)l * 16384 * D, IN(19) + l * D, IN(20) + l * D,
                                   (l == 3) ? (float*)KARG_U64(168) : bX, bXb);
            PH_END
        }
    }
#undef PH_BEGIN
#undef PH_END
}
constexpr int N_PHASES = 1 + 2 * (5 + 7);
}

extern "C" void kernel_launch(void* const* d_in, const int* in_sizes, int n_in, void* d_out, int out_size, void* d_ws, size_t ws_size,
                              hipStream_t stream) {
    static int grid = 0;
    if (grid == 0) {
        if (n_in != 21 || out_size != T * D || ws_size < WS_END) { fprintf(stderr, "kernel_launch: unexpected shapes (n_in %d out %d ws %zu need %zu)\n", n_in, out_size, ws_size, (size_t)WS_END); grid = -1; return; }
        int dev = 0, cus = 0;
        if (hipGetDevice(&dev) != hipSuccess || hipDeviceGetAttribute(&cus, hipDeviceAttributeMultiprocessorCount, dev) != hipSuccess || cus <= 0) cus = 256;
        if (hipFuncSetAttribute((const void*)fwd_kernel, hipFuncAttributeMaxDynamicSharedMemorySize, LDS_BYTES) != hipSuccess) { fprintf(stderr, "kernel_launch: hipFuncSetAttribute failed\n"); grid = -1; return; }
        int per_cu = 0;
        if (hipOccupancyMaxActiveBlocksPerMultiprocessor(&per_cu, (const void*)fwd_kernel, NTHR, LDS_BYTES) != hipSuccess || per_cu < 1)
            fprintf(stderr, "kernel_launch: occupancy query says %d\n", per_cu);
        (void)hipGetLastError();
        if (cus < NBLK) { fprintf(stderr, "kernel_launch: needs %d CUs for a resident grid, device has %d\n", NBLK, cus); grid = -1; return; }
        grid = NBLK;
    }
    if (grid < 0) return;
    (void)hipMemsetAsync((char*)d_ws + OFF_BAR, 0, CTL_WORDS * sizeof(unsigned), stream);
    Params p{};
    for (int i = 0; i < 21; ++i) p.in[i] = (const float*)d_in[i];
    p.out = (float*)d_out; p.ws = (unsigned char*)d_ws;
    if (N_LAUNCH_SPLIT) {
        for (int ph = 0; ph < N_PHASES; ++ph) {
            p.ph_lo = ph; p.ph_hi = ph + 1;
            hipLaunchKernelGGL(fwd_kernel, dim3(grid), dim3(NTHR), LDS_BYTES, stream, p);
        }
    } else {
        p.ph_lo = 0; p.ph_hi = N_PHASES;
        hipLaunchKernelGGL(fwd_kernel, dim3(grid), dim3(NTHR), LDS_BYTES, stream, p);
    }
}
```
